# Optimizing an MI355X kernel written in HIP

```python
import math, functools
import jax, jax.numpy as jnp
from jax import lax
import numpy as np

D_MODEL = 1024
BATCH = 32
SEQ = 2048
DEPTH = 1
DEC_BATCH = 32
DEC_SEQ = 32
PAST_LEN = 4096

CHUNK = 64
N_META = 16
NORM_EPS = 1e-6
D_INNER = 2 * D_MODEL
SSD_HEAD_DIM = 64
N_SSD_HEADS = D_INNER // SSD_HEAD_DIM
SSD_GROUPS = 8
SSD_HEADS_PER_GROUP = N_SSD_HEADS // SSD_GROUPS
D_STATE = 128
CONV_W = 4
CONV_DIM = D_INNER + 2 * SSD_GROUPS * D_STATE
SSD_BLOCK = 64
N_ATT_HEADS = 8
ATT_QK_DIM = 64
ATT_V_DIM = 2 * ATT_QK_DIM
QK_WIDTH = N_ATT_HEADS * 2 * ATT_QK_DIM
ATT_WIDTH = N_ATT_HEADS * ATT_V_DIM
Q_BLOCK = 128
REL_BUCKETS = 32
REL_MAX_DIST = 128
D_FF = (8 * D_MODEL + 3 * 256 - 1) // (3 * 256) * 256
OFF_XBC = D_INNER
OFF_DT = OFF_XBC + CONV_DIM
OFF_Q = OFF_DT + N_SSD_HEADS
OFF_K = OFF_Q + QK_WIDTH
OFF_V = OFF_K + QK_WIDTH
OFF_G_SSD = OFF_V + ATT_WIDTH
OFF_G_ATT = OFF_G_SSD + D_MODEL
D_IN_PROJ = OFF_G_ATT + D_MODEL

kernel_name = "hybrid_ssd_diffattn_streaming_step"


def rmsnorm(x, g):
    xf = x.astype(jnp.float32)
    y = xf * lax.rsqrt(jnp.mean(xf * xf, axis=-1, keepdims=True) + NORM_EPS)
    return y.astype(x.dtype) * g


def gated_rmsnorm(y, z, g):
    u = (y * jax.nn.silu(z)).reshape(*y.shape[:-1], SSD_GROUPS, D_INNER // SSD_GROUPS)
    return rmsnorm(u, g.reshape(SSD_GROUPS, D_INNER // SSD_GROUPS)).reshape(y.shape)


def rel_bucket(rel):
    nb = REL_BUCKETS // 2
    max_exact = nb // 2
    n = jnp.abs(rel)
    nf = jnp.maximum(n, 1).astype(jnp.float32)
    large = max_exact + (jnp.log(nf / max_exact) / math.log(REL_MAX_DIST / max_exact)
                         * (nb - max_exact)).astype(jnp.int32)
    large = jnp.minimum(large, nb - 1)
    return jnp.where(rel > 0, nb, 0) + jnp.where(n < max_exact, n, large)


def chunk_id(pos):
    return jnp.where(pos < N_META, 0, 1 + (pos - N_META) // CHUNK)


def causal_conv(x_ext, w, bias, L):
    return bias + sum(x_ext[:, i:i + L] * w[i] for i in range(CONV_W))


def ssd_scan(x, dt, a, bm, cm, h0):
    b, L = x.shape[:2]
    qb = math.gcd(L, SSD_BLOCK)
    nc = L // qb

    def blocks(t):
        return jnp.moveaxis(t.reshape(b, nc, qb, *t.shape[2:]), 1, 0)

    causal = jnp.tril(jnp.ones((qb, qb), bool))[None, :, :, None, None]

    def step(h, inp):
        xc, dtc, bc, cc = inp
        acs = jnp.cumsum(dtc * a, axis=1)
        decay = jnp.exp(jnp.where(causal, acs[:, :, None] - acs[:, None, :], -jnp.inf))
        xdt = xc * dtc[..., None]
        cb = jnp.einsum("btgn,bsgn->btsg", cc, bc)
        y = (jnp.einsum("btsg,btsgr,bsgrp->btgrp", cb, decay, xdt)
             + jnp.einsum("btgn,bgrpn,btgr->btgrp", cc, h, jnp.exp(acs)))
        h = (h * jnp.exp(acs[:, -1])[..., None, None]
             + jnp.einsum("bsgn,bsgr,bsgrp->bgrpn", bc, jnp.exp(acs[:, -1:] - acs), xdt))
        return h, y

    h_final, ys = lax.scan(step, h0, (blocks(x), blocks(dt), blocks(bm), blocks(cm)))
    return jnp.moveaxis(ys, 0, 1).reshape(x.shape), h_final


def diff_attention(q, k, v, q_pos, k_pos, lam, rel_bias):
    bias = jnp.transpose(rel_bias[rel_bucket(k_pos[None, :] - q_pos[:, None])], (2, 0, 1)).astype(jnp.float32)
    visible = chunk_id(k_pos)[None, :] <= chunk_id(q_pos)[:, None]
    s = jnp.einsum("bqhcd,bkhcd->bchqk", q, k, preferred_element_type=jnp.float32) * (ATT_QK_DIM ** -0.5)
    s = jnp.where(visible, s + bias[None, None], -jnp.inf)
    p = jax.nn.softmax(s, axis=-1)
    attn = p[:, 0] - lam * p[:, 1]
    return jnp.einsum("bhqk,bkhd->bqhd", attn.astype(v.dtype), v)


def prompt_attention(q, k, v, lam, rel_bias):
    b, L = q.shape[:2]
    S = L - N_META
    k_pos = jnp.arange(L, dtype=jnp.int32)
    meta_pos = k_pos[:N_META]
    o_meta = diff_attention(q[:, :N_META], k[:, :N_META], v[:, :N_META], meta_pos, meta_pos, lam, rel_bias)
    if S == 0:
        return o_meta
    nb = S // Q_BLOCK
    qb = jnp.moveaxis(q[:, N_META:].reshape(b, nb, Q_BLOCK, *q.shape[2:]), 1, 0)

    def block(args):
        qj, j = args
        q_pos = N_META + j * Q_BLOCK + jnp.arange(Q_BLOCK, dtype=jnp.int32)
        return diff_attention(qj, k, v, q_pos, k_pos, lam, rel_bias)

    ob = lax.map(block, (qb, jnp.arange(nb, dtype=jnp.int32)))
    o_frames = jnp.moveaxis(ob, 0, 1).reshape(b, S, N_ATT_HEADS, ATT_V_DIM)
    return jnp.concatenate([o_meta, o_frames], axis=1)


def sample_attention(q, k, v, lam, rel_bias, cache_k, cache_v, meta_k, meta_v):
    b, t = q.shape[:2]
    past = cache_k.shape[1]
    kk = jnp.concatenate([jnp.broadcast_to(meta_k, (b,) + meta_k.shape[1:]).astype(k.dtype),
                          cache_k.reshape(b, past, N_ATT_HEADS, 2, ATT_QK_DIM).astype(k.dtype), k], axis=1)
    vv = jnp.concatenate([jnp.broadcast_to(meta_v, (b,) + meta_v.shape[1:]).astype(v.dtype),
                          cache_v.astype(v.dtype), v], axis=1)
    k_pos = jnp.arange(N_META + past + t, dtype=jnp.int32)
    return diff_attention(q, kk, vv, k_pos[N_META + past:], k_pos, lam, rel_bias)


def meta_kv(meta_h, w):
    kv = rmsnorm(meta_h, w["norm_mix_pre"]) @ w["w_in"][:, OFF_K:OFF_G_SSD]
    mk, mv = jnp.split(kv, [QK_WIDTH], axis=-1)
    n = meta_h.shape[0]
    return (mk.reshape(n, N_META, N_ATT_HEADS, 2, ATT_QK_DIM),
            mv.reshape(n, N_META, N_ATT_HEADS, ATT_V_DIM))


def layer(h, conv_in, ssm_in, attend, w, layer_idx, rel_bias):
    f32 = jnp.float32
    b, L, _ = h.shape
    xn = rmsnorm(h, w["norm_mix_pre"])
    z, xbc, dt, q, k, v, g_ssd, g_att = jnp.split(
        xn @ w["w_in"], [OFF_XBC, OFF_DT, OFF_Q, OFF_K, OFF_V, OFF_G_SSD, OFF_G_ATT], axis=-1)
    xbc_ext = jnp.concatenate([conv_in.astype(xbc.dtype), xbc], axis=1)
    conv_out = xbc_ext[:, -(CONV_W - 1):]
    xbc = jax.nn.silu(causal_conv(xbc_ext, w["conv_w"], w["conv_b"], L))
    xs, bm, cm = jnp.split(xbc, [D_INNER, D_INNER + SSD_GROUPS * D_STATE], axis=-1)
    xs = xs.reshape(b, L, SSD_GROUPS, SSD_HEADS_PER_GROUP, SSD_HEAD_DIM).astype(f32)
    dt = jax.nn.softplus(dt.astype(f32) + w["dt_bias"].astype(f32)).reshape(
        b, L, SSD_GROUPS, SSD_HEADS_PER_GROUP)
    a = -jnp.exp(w["a_log"].astype(f32)).reshape(SSD_GROUPS, SSD_HEADS_PER_GROUP)
    y, ssm_out = ssd_scan(
        xs, dt, a,
        bm.reshape(b, L, SSD_GROUPS, D_STATE).astype(f32),
        cm.reshape(b, L, SSD_GROUPS, D_STATE).astype(f32),
        ssm_in.reshape(b, SSD_GROUPS, SSD_HEADS_PER_GROUP, SSD_HEAD_DIM, D_STATE).astype(f32))
    y = y + w["d_skip"].astype(f32).reshape(SSD_GROUPS, SSD_HEADS_PER_GROUP, 1) * xs
    y = gated_rmsnorm(y.reshape(b, L, D_INNER).astype(h.dtype), z, w["ssd_norm"])
    y_ssd = y @ w["w_ssd_out"]
    q = q.reshape(b, L, N_ATT_HEADS, 2, ATT_QK_DIM)
    k = k.reshape(b, L, N_ATT_HEADS, 2, ATT_QK_DIM)
    v = v.reshape(b, L, N_ATT_HEADS, ATT_V_DIM)
    lam_init = 0.8 - 0.6 * math.exp(-0.3 * layer_idx)
    lam = (jnp.exp(jnp.sum(w["lam_q1"].astype(f32) * w["lam_k1"].astype(f32)))
           - jnp.exp(jnp.sum(w["lam_q2"].astype(f32) * w["lam_k2"].astype(f32))) + lam_init)
    o = attend(q, k, v, lam, rel_bias)
    o = rmsnorm(o, w["subln"]) * (1.0 - lam_init)
    y_att = o.reshape(b, L, ATT_WIDTH) @ w["w_att_out"]
    mix = (jax.nn.sigmoid(g_ssd) * y_ssd + jax.nn.sigmoid(g_att) * y_att) @ w["w_o"]
    h = h + rmsnorm(mix, w["norm_mix_post"])
    gate, up = jnp.split(rmsnorm(h, w["norm_ffn_pre"]) @ w["w_ffn_in"], 2, axis=-1)
    h = h + rmsnorm((jax.nn.silu(gate) * up) @ w["w_ffn_out"], w["norm_ffn_post"])
    k_rows = k.reshape(b, L, N_ATT_HEADS, 2 * ATT_QK_DIM)
    ssm_out = ssm_out.reshape(b, N_SSD_HEADS, SSD_HEAD_DIM, D_STATE).astype(h.dtype)
    return h, k_rows, v, conv_out, ssm_out


def setup_inputs(seed: int = 0) -> dict:
    key = jax.random.key(seed)
    ks = jax.random.split(key, 32)
    f32 = jnp.float32

    def nrm(k, shape, scale):
        return jax.random.normal(k, shape, f32) * scale

    def gain(k, n):
        return 1.0 + nrm(k, (DEPTH, n), 0.05)

    dt0 = jnp.exp(jax.random.uniform(ks[12], (DEPTH, N_SSD_HEADS), f32, math.log(1e-3), math.log(1e-1)))
    return {
        "x_prompt": nrm(ks[0], (BATCH, SEQ, D_MODEL), 1.0),
        "x_sample": nrm(ks[1], (DEC_BATCH, DEC_SEQ, D_MODEL), 1.0),
        "cache_k": nrm(ks[2], (DEPTH, DEC_BATCH, PAST_LEN, N_ATT_HEADS, 2 * ATT_QK_DIM), 1.0),
        "cache_v": nrm(ks[3], (DEPTH, DEC_BATCH, PAST_LEN, N_ATT_HEADS, ATT_V_DIM), 1.0),
        "state_ssm": nrm(ks[4], (DEPTH, DEC_BATCH, N_SSD_HEADS, SSD_HEAD_DIM, D_STATE), 0.5),
        "state_conv": nrm(ks[5], (DEPTH, DEC_BATCH, CONV_W - 1, CONV_DIM), 1.0),
        "meta_tokens": nrm(ks[6], (N_META, D_MODEL), 1.0),
        "rel_bias": nrm(ks[7], (REL_BUCKETS, N_ATT_HEADS), 0.2),
        "norm_mix_pre": gain(ks[8], D_MODEL),
        "w_in": nrm(ks[9], (DEPTH, D_MODEL, D_IN_PROJ), D_MODEL ** -0.5),
        "conv_w": nrm(ks[10], (DEPTH, CONV_W, CONV_DIM), CONV_W ** -0.5),
        "conv_b": nrm(ks[11], (DEPTH, CONV_DIM), 0.02),
        "dt_bias": dt0 + jnp.log(-jnp.expm1(-dt0)),
        "a_log": jnp.log(jax.random.uniform(ks[13], (DEPTH, N_SSD_HEADS), f32, 1.0, 16.0)),
        "d_skip": gain(ks[14], N_SSD_HEADS),
        "ssd_norm": gain(ks[15], D_INNER),
        "w_ssd_out": nrm(ks[16], (DEPTH, D_INNER, D_MODEL), D_INNER ** -0.5),
        "lam_q1": nrm(ks[17], (DEPTH, ATT_QK_DIM), 0.1),
        "lam_k1": nrm(ks[18], (DEPTH, ATT_QK_DIM), 0.1),
        "lam_q2": nrm(ks[19], (DEPTH, ATT_QK_DIM), 0.1),
        "lam_k2": nrm(ks[20], (DEPTH, ATT_QK_DIM), 0.1),
        "subln": gain(ks[21], ATT_V_DIM),
        "w_att_out": nrm(ks[22], (DEPTH, ATT_WIDTH, D_MODEL), ATT_WIDTH ** -0.5),
        "w_o": nrm(ks[23], (DEPTH, D_MODEL, D_MODEL), D_MODEL ** -0.5),
        "norm_mix_post": gain(ks[24], D_MODEL),
        "norm_ffn_pre": gain(ks[25], D_MODEL),
        "w_ffn_in": nrm(ks[26], (DEPTH, D_MODEL, 2 * D_FF), D_MODEL ** -0.5),
        "w_ffn_out": nrm(ks[27], (DEPTH, D_FF, D_MODEL), D_FF ** -0.5),
        "norm_ffn_post": gain(ks[28], D_MODEL),
    }


def reference(x_prompt, x_sample, cache_k, cache_v, state_ssm, state_conv, meta_tokens, rel_bias,
              norm_mix_pre, w_in, conv_w, conv_b, dt_bias, a_log, d_skip, ssd_norm, w_ssd_out,
              lam_q1, lam_k1, lam_q2, lam_k2, subln, w_att_out, w_o, norm_mix_post,
              norm_ffn_pre, w_ffn_in, w_ffn_out, norm_ffn_post):
    b = x_prompt.shape[0]
    h = jnp.concatenate([jnp.broadcast_to(meta_tokens.astype(x_prompt.dtype)[None], (b, N_META, D_MODEL)),
                         x_prompt], axis=1)
    hs = x_sample
    meta_h = meta_tokens[None]
    kp, vp, cp, sp, kd, vd, cd, sd = [], [], [], [], [], [], [], []
    for l in range(DEPTH):
        w = dict(norm_mix_pre=norm_mix_pre[l], w_in=w_in[l], conv_w=conv_w[l], conv_b=conv_b[l],
                 dt_bias=dt_bias[l], a_log=a_log[l], d_skip=d_skip[l], ssd_norm=ssd_norm[l],
                 w_ssd_out=w_ssd_out[l], lam_q1=lam_q1[l], lam_k1=lam_k1[l], lam_q2=lam_q2[l],
                 lam_k2=lam_k2[l], subln=subln[l], w_att_out=w_att_out[l], w_o=w_o[l],
                 norm_mix_post=norm_mix_post[l], norm_ffn_pre=norm_ffn_pre[l], w_ffn_in=w_ffn_in[l],
                 w_ffn_out=w_ffn_out[l], norm_ffn_post=norm_ffn_post[l])
        zero_conv = jnp.zeros((b, CONV_W - 1, CONV_DIM), h.dtype)
        zero_ssm = jnp.zeros((b, N_SSD_HEADS, SSD_HEAD_DIM, D_STATE), h.dtype)
        h, k_new, v_new, c_new, s_new = layer(h, zero_conv, zero_ssm, prompt_attention, w, l, rel_bias)
        kp.append(k_new); vp.append(v_new); cp.append(c_new); sp.append(s_new)
        mk, mv = meta_kv(meta_h, w)
        attend_s = functools.partial(sample_attention, cache_k=cache_k[l], cache_v=cache_v[l],
                                     meta_k=mk, meta_v=mv)
        hs, k_new, v_new, c_new, s_new = layer(hs, state_conv[l], state_ssm[l], attend_s, w, l, rel_bias)
        kd.append(k_new); vd.append(v_new); cd.append(c_new); sd.append(s_new)
        if l + 1 < DEPTH:
            meta_h = layer(meta_h, jnp.zeros((1, CONV_W - 1, CONV_DIM), meta_h.dtype),
                           jnp.zeros((1, N_SSD_HEADS, SSD_HEAD_DIM, D_STATE), meta_h.dtype),
                           prompt_attention, w, l, rel_bias)[0]
    y_prompt = h[:, N_META:]
    return (y_prompt, hs, jnp.stack(kp), jnp.stack(vp), jnp.stack(cp), jnp.stack(sp),
            jnp.stack(kd), jnp.stack(vd), jnp.stack(cd), jnp.stack(sd))
```

```cpp
#ifndef EMU
#include <hip/hip_runtime.h>
#endif
#include <cstdio>
#include <cstdint>
#include <cmath>

#ifdef EMU
#define PG8_LAS
#define LAS
#define GAS
#define WAVE_LDS_SYNC() emu::wave_sync()
#define RDFL(x) (x)
#else
#define PG8_LAS __attribute__((address_space(3)))
#define LAS __attribute__((address_space(3)))
#define GAS __attribute__((address_space(1)))
#define WAVE_LDS_SYNC() asm volatile("s_waitcnt lgkmcnt(0)" ::: "memory")
#define RDFL(x) __builtin_amdgcn_readfirstlane(x)
#endif
namespace pg8 {
typedef unsigned short bf16_t;
typedef short bf16x8 __attribute__((ext_vector_type(8)));
typedef float f32x4 __attribute__((ext_vector_type(4)));
typedef unsigned u32x4 __attribute__((ext_vector_type(4)));
constexpr int BM = 256, BK = 64, HALF = 128, HTB = HALF * BK * 2  , STAGE_BYTES = 8 * HTB, NXCD = 8, WGM = 8;

__host__ __device__ __forceinline__ int lds_byte(int r, int c) { const int st = (r >> 4) * 2 + (c >> 5), rr = r & 15, cc = c & 31, ob = rr * 64 + cc * 2; return st * 1024 + (ob ^ (((ob >> 9) & 1) << 5)); }
__host__ __device__ __forceinline__ void stage_rc(int b, int& R, int& C) { const int st = b / 1024, sb = b % 1024, swz = sb ^ (((sb >> 9) & 1) << 5); R = (st >> 1) * 16 + swz / 64; C = (st & 1) * 32 + (swz % 64) / 2; }
__host__ __device__ __forceinline__ int perm32(int rho) { const int n = rho >> 4, i = rho & 15; return 8 * (i >> 2) + 4 * n + (i & 3); }

struct Unit { int pm, pn; };
struct Gemm { const bf16_t* A; const bf16_t* Bt; int M, N, K; };

struct StaticOrder {
    int nM, nN, nwg, G, c;
    __host__ __device__ void init(int M, int N, int G_, int c_) { nM = M / BM; nN = N / BM; nwg = nM * nN; G = G_; c = c_; }
    __host__ __device__ bool next(int i, Unit& u) const {
        const long L = (long)i * G + c; if (L >= nwg) return false;
        int wgid = (int)L; { const int q = nwg / NXCD, r = nwg % NXCD, xcd = wgid % NXCD, off = wgid / NXCD; wgid = (xcd < r ? xcd * (q + 1) : r * (q + 1) + (xcd - r) * q) + off; }
        const int nig = WGM * nN, gid = wgid / nig, fm = gid * WGM, gsz = (nM - fm) < WGM ? (nM - fm) : WGM;
        u.pm = fm + ((wgid % nig) % gsz); u.pn = (wgid % nig) / gsz; return true;
    }
    __device__ __forceinline__ void a_ready(const Unit&) const {}
    __device__ __forceinline__ void done(const Unit&) const {}
};
typedef float f32x2 __attribute__((ext_vector_type(2)));
#ifdef EMU
__device__ __forceinline__ unsigned cvt_pk_bf16(float lo, float hi) { return (unsigned)emu_f2bf(lo) | ((unsigned)emu_f2bf(hi) << 16); }
inline void emu_host_tile(const Gemm& g, const Unit& u, float* C) {
    const int K = g.K; std::vector<float> a((size_t)256 * K), b((size_t)256 * K);
    for (int r = 0; r < 256; ++r) for (int k = 0; k < K; ++k) { a[(size_t)r * K + k] = emu_bf2f(g.A[(size_t)(u.pm * 256 + r) * K + k]); b[(size_t)r * K + k] = emu_bf2f(g.Bt[(size_t)(u.pn * 256 + r) * K + k]); }
    for (int r = 0; r < 256; ++r) for (int c = 0; c < 256; ++c) { const float* ap = &a[(size_t)r * K]; const float* bp = &b[(size_t)c * K]; float s0 = 0.f, s1 = 0.f, s2 = 0.f, s3 = 0.f;
        for (int k = 0; k < K; k += 4) { s0 += ap[k] * bp[k]; s1 += ap[k + 1] * bp[k + 1]; s2 += ap[k + 2] * bp[k + 2]; s3 += ap[k + 3] * bp[k + 3]; } C[r * 256 + c] = (s0 + s1) + (s2 + s3); }
}
template <class Epi, class Sched, bool ALIGN_EPI = false, bool SP2 = false>
inline void gemm_phase(unsigned char* lds, const Gemm g, const Sched& S, const Epi& E) {
    const int tid = threadIdx.x, wid = tid >> 6, lane = tid & 63, wr = wid >> 2, wc = wid & 3, fr = lane & 15, fq = lane >> 4;
    Unit cur;
    for (int ui = 0; S.next(ui, cur); ++ui) {
        __syncthreads();
        if (tid == 0) emu_host_tile(g, cur, emu::B->gemm_tile);
        __syncthreads();
        f32x4 acc[2][2][4][2];
        for (int ai = 0; ai < 2; ++ai) for (int bj = 0; bj < 2; ++bj) for (int m = 0; m < 4; ++m) for (int n = 0; n < 2; ++n) for (int e = 0; e < 4; ++e) {
            const int row = 128 * ai + 64 * wr + 16 * m + fr, col = 128 * bj + 32 * wc + (Epi::PERM ? 8 * fq + 4 * n + e : 16 * n + 4 * fq + e);
            acc[ai][bj][m][n][e] = emu::B->gemm_tile[row * 256 + col]; }
        E(acc, cur, wr, wc, fr, fq);
    }
    __syncthreads();
}
#else
__device__ __forceinline__ unsigned cvt_pk_bf16(float lo, float hi) { unsigned r; asm volatile("v_cvt_pk_bf16_f32 %0, %1, %2" : "=v"(r) : "v"(lo), "v"(hi)); return r; }
template <class Epi, class Sched, bool ALIGN_EPI = false, bool SP2 = false>
__device__ __forceinline__ void gemm_phase(PG8_LAS unsigned char* lds, const Gemm g, const Sched& S, const Epi& E) {
    const int tid = threadIdx.x, wid = __builtin_amdgcn_readfirstlane(tid >> 6), lane = tid & 63, wr = wid >> 2, wc = wid & 3, fr = lane & 15, fq = lane >> 4;
    const int K = g.K, nt = K / BK;
    unsigned voffA[2], voffB[2];
#pragma unroll
    for (int i = 0; i < 2; ++i) { int R, C; stage_rc(tid * 16 + i * 8192, R, C); const int Rb = Epi::PERM ? ((R & ~31) + perm32(R & 31)) : R;
        voffA[i] = (unsigned)(R * K + C) * 2u; voffB[i] = (unsigned)(Rb * K + C) * 2u; }
    const size_t kstep = (size_t)(BK * 2);
    const size_t hstep = (size_t)HALF * K * 2;
    const size_t tstep = 2 * hstep;
    const unsigned ldsw = (unsigned)wid * 1024u;
    const int aoff = lds_byte(wr * 64 + fr, fq * 8), boff = lds_byte(wc * 32 + fr, fq * 8);
#define PG8_SA(b, h) (((b) * 2 + (h)) * HTB)
#define PG8_SB(b, h) ((4 + (b) * 2 + (h)) * HTB)
#define PG8_STAGE(bufoff, gbase, voff) do { _Pragma("unroll") for (int _i = 0; _i < 2; ++_i) \
        __builtin_amdgcn_global_load_lds((const unsigned*)((const char*)(gbase) + (voff)[_i]), (PG8_LAS unsigned*)(lds + (bufoff) + ldsw + _i * 8192), 16, 0, 0); } while (0)
#define PG8_LDA(dst, b, h) do { _Pragma("unroll") for (int m = 0; m < 4; ++m) _Pragma("unroll") for (int k = 0; k < 2; ++k) dst[m][k] = *(const PG8_LAS bf16x8*)(lds + PG8_SA(b, h) + aoff + m * 2048 + k * 1024); } while (0)
#define PG8_LDB(dst, b, h) do { _Pragma("unroll") for (int n = 0; n < 2; ++n) _Pragma("unroll") for (int k = 0; k < 2; ++k) dst[n][k] = *(const PG8_LAS bf16x8*)(lds + PG8_SB(b, h) + boff + n * 2048 + k * 1024); } while (0)
#define PG8_MMA(ai, bj, At, Bt) do { __builtin_amdgcn_s_setprio(1); _Pragma("unroll") for (int m = 0; m < 4; ++m) _Pragma("unroll") for (int n = 0; n < 2; ++n) _Pragma("unroll") for (int k = 0; k < 2; ++k) \
        acc[ai][bj][m][n] = __builtin_amdgcn_mfma_f32_16x16x32_bf16(Bt[n][k], At[m][k], acc[ai][bj][m][n], 0, 0, 0); __builtin_amdgcn_s_setprio(0); } while (0)
#define PG8_WAIT_V(n) asm volatile("s_waitcnt vmcnt(" #n ")" ::: "memory")
#define PG8_WAIT_L(n) asm volatile("s_waitcnt lgkmcnt(" #n ")" ::: "memory")
#define PG8_BAR __builtin_amdgcn_s_barrier()
#define PG8_SCHED __builtin_amdgcn_sched_barrier(0)
    Unit cur, nxt; int ui = 0;
    if (!S.next(0, cur)) return;
    f32x4 acc[2][2][4][2];
#pragma unroll
    for (int a = 0; a < 2; ++a)
#pragma unroll
        for (int b = 0; b < 2; ++b)
#pragma unroll
            for (int m = 0; m < 4; ++m)
#pragma unroll
                for (int n = 0; n < 2; ++n) acc[a][b][m][n] = (f32x4){0.f, 0.f, 0.f, 0.f};
    bf16x8 At[4][2], B0[2][2], B1[2][2];
    const char* cA = (const char*)g.A + (size_t)cur.pm * tstep; const char* cB = (const char*)g.Bt + (size_t)cur.pn * tstep;
    S.a_ready(cur);
    if constexpr (SP2) {
        PG8_STAGE(PG8_SB(0, 0), cB, voffB); PG8_STAGE(PG8_SB(0, 1), cB + hstep, voffB); PG8_STAGE(PG8_SA(0, 0), cA, voffA); PG8_STAGE(PG8_SA(0, 1), cA + hstep, voffA);
        if (wr == 1) PG8_BAR;
        PG8_WAIT_V(2); PG8_BAR;
        PG8_STAGE(PG8_SB(1, 0), cB + kstep, voffB); PG8_STAGE(PG8_SA(1, 0), cA + kstep, voffA); PG8_STAGE(PG8_SB(1, 1), cB + hstep + kstep, voffB);
        PG8_WAIT_V(6); PG8_BAR;
    } else {
        PG8_STAGE(PG8_SB(0, 0), cB, voffB); PG8_STAGE(PG8_SA(0, 0), cA, voffA); PG8_STAGE(PG8_SB(0, 1), cB + hstep, voffB); PG8_STAGE(PG8_SA(0, 1), cA + hstep, voffA);
        if (wr == 1) PG8_BAR;
        PG8_WAIT_V(4); PG8_BAR;
        PG8_STAGE(PG8_SB(1, 0), cB + kstep, voffB); PG8_STAGE(PG8_SA(1, 0), cA + kstep, voffA); PG8_STAGE(PG8_SB(1, 1), cB + hstep + kstep, voffB);
        PG8_WAIT_V(6); PG8_BAR;
    }
    for (;;) {
        const bool has_next = S.next(ui + 1, nxt);
        const char* nA = has_next ? (const char*)g.A + (size_t)nxt.pm * tstep : cA; const char* nB = has_next ? (const char*)g.Bt + (size_t)nxt.pn * tstep : cB;
        for (int t = 0; t < nt; t += 2) {
            const bool last = (t == nt - 2);
            const char* a1 = cA + (size_t)(t + 1) * kstep;
            const char* a2 = last ? nA : cA + (size_t)(t + 2) * kstep; const char* b2 = last ? nB : cB + (size_t)(t + 2) * kstep;
            const char* a3 = a2 + kstep; const char* b3 = b2 + kstep;
            if (last && has_next) S.a_ready(nxt);
            if constexpr (SP2) {
            PG8_LDB(B0, 0, 0); PG8_LDB(B1, 0, 1); PG8_SCHED; PG8_LDA(At, 0, 0); PG8_STAGE(PG8_SA(1, 1), a1 + hstep, voffA);
            PG8_WAIT_V(8); PG8_WAIT_L(0); PG8_BAR; PG8_MMA(0, 0, At, B0); PG8_MMA(0, 1, At, B1); PG8_BAR; PG8_SCHED;
            PG8_LDA(At, 0, 1); PG8_STAGE(PG8_SB(0, 0), b2, voffB); PG8_STAGE(PG8_SB(0, 1), b2 + hstep, voffB); PG8_STAGE(PG8_SA(0, 0), a2, voffA);
            PG8_WAIT_V(8); PG8_WAIT_L(0); PG8_BAR; PG8_MMA(1, 0, At, B0); PG8_MMA(1, 1, At, B1); PG8_BAR; PG8_SCHED;
            PG8_LDB(B0, 1, 0); PG8_LDB(B1, 1, 1); PG8_SCHED; PG8_LDA(At, 1, 0); PG8_STAGE(PG8_SA(0, 1), a2 + hstep, voffA);
            PG8_WAIT_V(8); PG8_WAIT_L(0); PG8_BAR; PG8_MMA(0, 0, At, B0); PG8_MMA(0, 1, At, B1); PG8_BAR; PG8_SCHED;
            PG8_LDA(At, 1, 1); PG8_STAGE(PG8_SB(1, 0), b3, voffB); PG8_STAGE(PG8_SB(1, 1), b3 + hstep, voffB); PG8_STAGE(PG8_SA(1, 0), a3, voffA);
            PG8_WAIT_V(8); PG8_WAIT_L(0); PG8_BAR; PG8_MMA(1, 0, At, B0); PG8_MMA(1, 1, At, B1); PG8_BAR; PG8_SCHED;
            } else {
            PG8_LDB(B0, 0, 0); PG8_SCHED; PG8_LDA(At, 0, 0); PG8_STAGE(PG8_SA(1, 1), a1 + hstep, voffA);
            PG8_WAIT_L(8); PG8_BAR; PG8_WAIT_L(0); PG8_MMA(0, 0, At, B0); PG8_BAR; PG8_SCHED;
            PG8_LDB(B1, 0, 1); PG8_STAGE(PG8_SB(0, 0), b2, voffB);
            PG8_BAR; PG8_WAIT_L(0); PG8_MMA(0, 1, At, B1); PG8_BAR;
            PG8_LDA(At, 0, 1); PG8_STAGE(PG8_SA(0, 0), a2, voffA);
            PG8_BAR; PG8_WAIT_L(0); PG8_MMA(1, 0, At, B0); PG8_BAR; PG8_SCHED;
            PG8_STAGE(PG8_SB(0, 1), b2 + hstep, voffB);
            PG8_WAIT_V(6); PG8_BAR; PG8_MMA(1, 1, At, B1); PG8_BAR;
            PG8_LDB(B0, 1, 0); PG8_SCHED; PG8_LDA(At, 1, 0); PG8_STAGE(PG8_SA(0, 1), a2 + hstep, voffA);
            PG8_WAIT_L(8); PG8_BAR; PG8_WAIT_L(0); PG8_MMA(0, 0, At, B0); PG8_BAR; PG8_SCHED;
            PG8_LDB(B1, 1, 1); PG8_STAGE(PG8_SB(1, 0), b3, voffB);
            PG8_BAR; PG8_WAIT_L(0); PG8_MMA(0, 1, At, B1); PG8_BAR;
            PG8_LDA(At, 1, 1); PG8_STAGE(PG8_SA(1, 0), a3, voffA);
            PG8_BAR; PG8_WAIT_L(0); PG8_MMA(1, 0, At, B0); PG8_BAR; PG8_SCHED;
            PG8_STAGE(PG8_SB(1, 1), b3 + hstep, voffB);
            PG8_WAIT_V(6); PG8_BAR; PG8_MMA(1, 1, At, B1); PG8_BAR;
            }
        }
        if constexpr (ALIGN_EPI) { if (wr == 0) PG8_BAR; }
        if constexpr (!Epi::AFTER_DRAIN) { E(acc, cur, wr, wc, fr, fq); S.done(cur); }
        if (!has_next) break;
#pragma unroll
        for (int a = 0; a < 2; ++a)
#pragma unroll
            for (int b = 0; b < 2; ++b)
#pragma unroll
                for (int m = 0; m < 4; ++m)
#pragma unroll
                    for (int n = 0; n < 2; ++n) acc[a][b][m][n] = (f32x4){0.f, 0.f, 0.f, 0.f};
        cur = nxt; cA = nA; cB = nB; ++ui;
        if constexpr (ALIGN_EPI) { if (wr == 1) PG8_BAR; }
    }
    PG8_WAIT_V(0);
    if constexpr (!ALIGN_EPI) { if (wr == 0) PG8_BAR; }
    PG8_BAR;
    if constexpr (Epi::AFTER_DRAIN) { E.fused(acc, cur, wr, wc, fr, fq, lds, wid, lane); S.done(cur); }
#undef PG8_SA
#undef PG8_SB
#undef PG8_STAGE
#undef PG8_LDA
#undef PG8_LDB
#undef PG8_MMA
#undef PG8_WAIT_V
#undef PG8_WAIT_L
#undef PG8_BAR
#undef PG8_SCHED
}
#endif
}
#ifndef PG8_SP2
#define PG8_SP2 true
#endif
#ifndef PG8_ALIGN
#define PG8_ALIGN true
#endif

#ifndef CFG_BATCH
#define CFG_BATCH 32
#endif
#ifndef CFG_SEQ
#define CFG_SEQ 2048
#endif
#ifndef CFG_DECB
#define CFG_DECB 32
#endif
#ifndef CFG_PAST
#define CFG_PAST 4096
#endif
#ifndef MK_N_LAUNCHES
#define MK_N_LAUNCHES 1
#endif
constexpr int NWAVES = 8, NPHASE = 9;
constexpr int BATCH = CFG_BATCH, SEQ = CFG_SEQ, DECB = CFG_DECB, DSEQ = 32, PAST = CFG_PAST;
constexpr int D = 1024, NMETA = 16, DIN = 2048, CONVD = 4096, NSH = 32, NGRP = 8, DST = 128, NAH = 8, DFF = 2816;
constexpr int MP = BATCH * SEQ, MS = DECB * DSEQ, MMAIN = MP + MS, MALL = MMAIN + 256;
constexpr int NPROJ = 45 * 256, LEXT = NMETA + SEQ;
static_assert(MP % 256 == 0 && MS % 256 == 0 && SEQ % 128 == 0 && PAST % 64 == 0, "row panels");
constexpr float EPS = 1e-6f, LOG2E = 1.4426950408889634f, LN2 = 0.6931471805599453f, QSCALE = 0.125f * LOG2E;
constexpr size_t OUT_Y = 0, OUT_YS = OUT_Y + (size_t)MP * D, OUT_KP = OUT_YS + (size_t)MS * D, OUT_VP = OUT_KP + (size_t)BATCH * LEXT * 1024,
    OUT_CP = OUT_VP + (size_t)BATCH * LEXT * 1024, OUT_SP = OUT_CP + (size_t)BATCH * 3 * CONVD, OUT_KS = OUT_SP + (size_t)BATCH * NSH * 64 * DST,
    OUT_VS = OUT_KS + (size_t)MS * 1024, OUT_CS = OUT_VS + (size_t)MS * 1024, OUT_SS = OUT_CS + (size_t)DECB * 3 * CONVD, OUT_END = OUT_SS + (size_t)DECB * NSH * 64 * DST;
constexpr size_t MiB = 1u << 20;
constexpr size_t al(size_t x) { return (x + MiB - 1) & ~(MiB - 1); }
constexpr size_t WS_CTL = 0, CTL_ZERO_BYTES = MiB;
constexpr size_t WS_WIN = MiB, WS_WSSD = WS_WIN + al((size_t)NPROJ * D * 2), WS_WATT = WS_WSSD + al((size_t)D * DIN * 2), WS_WO = WS_WATT + al((size_t)D * D * 2),
    WS_WFF = WS_WO + al((size_t)D * D * 2), WS_WFF2 = WS_WFF + al((size_t)2 * DFF * D * 2), WS_XN = WS_WFF2 + al((size_t)D * DFF * 2);
constexpr size_t WS_Z = WS_XN + al((size_t)MALL * D * 2), WS_XBC = WS_Z + al((size_t)MALL * DIN * 2), WS_DT = WS_XBC + al((size_t)MALL * CONVD * 2), WS_Q = WS_DT + al((size_t)MALL * 32 * 4),
    WS_K = WS_Q + al((size_t)MALL * D * 2), WS_V = WS_K + al((size_t)MALL * D * 2), WS_GS = WS_V + al((size_t)MALL * D * 2), WS_GA = WS_GS + al((size_t)MALL * D * 2), WS_END = WS_GA + al((size_t)MALL * D * 2);
constexpr size_t WS_MIX = WS_XBC, WS_T1 = WS_XBC + (size_t)MMAIN * D * 2, WS_TMP = WS_T1 + (size_t)MMAIN * D * 4, WS_HB = WS_XBC, WS_T2 = WS_Z;
static_assert(WS_TMP + (size_t)MMAIN * D * 2 <= WS_DT && WS_HB + (size_t)MMAIN * DFF * 2 <= WS_DT && WS_T2 + (size_t)MMAIN * D * 4 <= WS_XBC, "overlays");
static_assert(WS_END <= ((size_t)2048 << 20), "workspace map fits 2 GiB");
constexpr int CW_TMO = 0, CW_BAR = 4096;
constexpr int RING_OFF = 0, RING_BYTES = 131072, LDSCTL_OFF = RING_BYTES, MISC_OFF = LDSCTL_OFF + 320, LDS_BYTES = 147456;

typedef unsigned short bf16;
typedef unsigned v4u __attribute__((ext_vector_type(4)));
typedef unsigned v2u __attribute__((ext_vector_type(2)));
typedef float f32x4 __attribute__((ext_vector_type(4)));
typedef float f32x16 __attribute__((ext_vector_type(16)));
typedef short bf16x8 __attribute__((ext_vector_type(8)));
typedef short s16x4 __attribute__((ext_vector_type(4)));

#ifdef EMU
#define DEV inline
DEV float EXP2(float x) { return exp2f(x); }
DEV float LOG2(float x) { return log2f(x); }
DEV float RCP(float x) { return 1.0f / x; }
DEV float RSQ(float x) { return 1.0f / sqrtf(x); }
DEV unsigned pk2(float lo, float hi) { return (unsigned)emu_f2bf(lo) | ((unsigned)emu_f2bf(hi) << 16); }
DEV f32x16 mfma32(bf16x8 a, bf16x8 b, f32x16 c) { return emu_mfma32(a, b, c); }
DEV float uaf(unsigned u) { float f; memcpy(&f, &u, 4); return f; }
#define LDS_WAIT() do {} while (0)
#define SCHED_BAR() do {} while (0)
DEV int opaque_v(int x) { return x; }
#define VM_WAIT() do {} while (0)
#else
#define DEV __device__ __forceinline__
DEV float EXP2(float x) { return __builtin_amdgcn_exp2f(x); }
DEV float LOG2(float x) { return __builtin_amdgcn_logf(x); }
DEV float RCP(float x) { return __builtin_amdgcn_rcpf(x); }
DEV float RSQ(float x) { return __builtin_amdgcn_rsqf(x); }
typedef float f32x2_t __attribute__((ext_vector_type(2))); typedef __bf16 bf16x2_t __attribute__((ext_vector_type(2)));
DEV unsigned pk2(float lo, float hi) { f32x2_t v = {lo, hi}; bf16x2_t b = __builtin_convertvector(v, bf16x2_t); return __builtin_bit_cast(unsigned, b); }
DEV f32x16 mfma32(bf16x8 a, bf16x8 b, f32x16 c) { return __builtin_amdgcn_mfma_f32_32x32x16_bf16(a, b, c, 0, 0, 0); }
DEV float uaf(unsigned u) { return __uint_as_float(u); }
#define LDS_WAIT() asm volatile("s_waitcnt lgkmcnt(0)" ::: "memory")
#define SCHED_BAR() __builtin_amdgcn_sched_barrier(0)
DEV int opaque_v(int x) { asm volatile("" : "+v"(x)); return x; }
#define VM_WAIT() asm volatile("s_waitcnt vmcnt(0)" ::: "memory")
#endif
DEV float bflo(unsigned w) { return uaf(w << 16); }
DEV float bfhi(unsigned w) { return uaf(w & 0xffff0000u); }
DEV float bf2f(bf16 b) { return uaf((unsigned)b << 16); }
DEV float sigmoidf_(float x) { return RCP(1.0f + EXP2(-x * LOG2E)); }
DEV float siluf_(float x) { return x * sigmoidf_(x); }
DEV float softplusf_(float x) { return fmaxf(x, 0.f) + LN2 * LOG2(1.0f + EXP2(-fabsf(x) * LOG2E)); }
DEV int crow(int reg, int h) { return (reg & 3) + 8 * (reg >> 2) + 4 * h; }
DEV float wave_sum(float v) {
#pragma unroll
    for (int o = 1; o < 64; o <<= 1) v += __shfl_xor(v, o);
    return v;
}
DEV bf16x8 pack_step(const f32x16& x, int s) {
    v4u p; p.x = pk2(x[8 * s], x[8 * s + 1]); p.y = pk2(x[8 * s + 2], x[8 * s + 3]); p.z = pk2(x[8 * s + 4], x[8 * s + 5]); p.w = pk2(x[8 * s + 6], x[8 * s + 7]);
    return __builtin_bit_cast(bf16x8, p);
}
DEV bf16x8 rd16(const LAS unsigned char* p) { return *(const LAS bf16x8*)p; }
DEV bf16x8 rd8x2(const LAS unsigned char* p) {
    const v2u a = *(const LAS v2u*)p, b = *(const LAS v2u*)(p + 16); v4u r; r.x = a.x; r.y = a.y; r.z = b.x; r.w = b.y; return __builtin_bit_cast(bf16x8, r);
}

struct Frame {
    LAS unsigned char* lds;
    unsigned* ctl;
    int tid, lane, wave, G, vcu;
    const float* const* in; float* out; unsigned char* ws;
#define WSP(T, NAME, OFF) DEV T* NAME() const { return (T*)(ws + OFF); }
    WSP(bf16, WinT, WS_WIN) WSP(bf16, WssdT, WS_WSSD) WSP(bf16, WattT, WS_WATT) WSP(bf16, WoT, WS_WO) WSP(bf16, WffT, WS_WFF) WSP(bf16, Wff2T, WS_WFF2)
    WSP(bf16, XN, WS_XN) WSP(bf16, Z, WS_Z) WSP(bf16, XBC, WS_XBC) WSP(bf16, Q, WS_Q) WSP(bf16, K, WS_K) WSP(bf16, V, WS_V) WSP(bf16, GS, WS_GS) WSP(bf16, GA, WS_GA)
    WSP(bf16, MIX, WS_MIX) WSP(bf16, TMP, WS_TMP) WSP(bf16, HB, WS_HB) WSP(float, DT, WS_DT) WSP(float, T1, WS_T1) WSP(float, T2, WS_T2)
#undef WSP
};
enum { I_XP = 0, I_XS, I_CK, I_CV, I_SSM, I_SCONV, I_META, I_RELB, I_NPRE, I_WIN, I_CONVW, I_CONVB, I_DTB, I_ALOG, I_DSKIP, I_SSDN, I_WSSD, I_LQ1, I_LK1, I_LQ2, I_LK2, I_SUBLN, I_WATT, I_WO, I_NPOST, I_NFFN, I_WFF, I_WFF2, I_NFFNP };

DEV void p0_transpose_item(const float* W, int K, int N, int src_col0, bf16* WT, int dst_row0, LAS float* scr, int kb, int lane) {
    const int k0 = 64 * kb;
#pragma unroll 8
    for (int i = 0; i < 32; ++i) { const int kk = 2 * i + (lane >> 5); scr[kk * 33 + (lane & 31)] = src_col0 >= 0 ? W[(size_t)(k0 + kk) * N + src_col0 + (lane & 31)] : 0.f; }
    WAVE_LDS_SYNC();
    const int c = lane & 7;
#pragma unroll
    for (int j = 0; j < 4; ++j) { const int n = (lane >> 3) + 8 * j; const LAS float* s = scr + (8 * c) * 33 + n;
        v4u o; o.x = pk2(s[0 * 33], s[1 * 33]); o.y = pk2(s[2 * 33], s[3 * 33]); o.z = pk2(s[4 * 33], s[5 * 33]); o.w = pk2(s[6 * 33], s[7 * 33]);
        *(v4u*)(WT + (size_t)(dst_row0 + n) * K + k0 + 8 * c) = o; }
    WAVE_LDS_SYNC();
}
DEV void rms_row_to_bf16(const float* xrow, const float* gain, bf16* orow, int lane) {
    unsigned long long* o8 = (unsigned long long*)orow + lane;
    if (!xrow) {
#pragma unroll
        for (int j = 0; j < 4; ++j) o8[64 * j] = 0ull;
        return; }
    const f32x4* xr = (const f32x4*)xrow + lane; const f32x4* gr = (const f32x4*)gain + lane;
    f32x4 v[4]; float s = 0.f;
#pragma unroll
    for (int j = 0; j < 4; ++j) { v[j] = xr[64 * j]; s += (v[j].x * v[j].x + v[j].y * v[j].y) + (v[j].z * v[j].z + v[j].w * v[j].w); }
    const float r = RSQ(wave_sum(s) * (1.f / D) + EPS);
#pragma unroll
    for (int j = 0; j < 4; ++j) { const f32x4 g = gr[64 * j]; o8[64 * j] = (unsigned long long)pk2(v[j].x * r * g.x, v[j].y * r * g.y) | ((unsigned long long)pk2(v[j].z * r * g.z, v[j].w * r * g.w) << 32); }
}
DEV const float* x_row_ptr(const Frame& F, int m) {
    if (m < MP) return F.in[I_XP] + (size_t)m * D;
    if (m < MMAIN) return F.in[I_XS] + (size_t)(m - MP) * D;
    if (m < MMAIN + NMETA) return F.in[I_META] + (size_t)(m - MMAIN) * D;
    return nullptr;
}
DEV void p0_prologue(Frame& F) {
    LAS float* scr = (LAS float*)(F.lds + RING_OFF + F.wave * 16384);
    const int gw = F.vcu * NWAVES + F.wave, NGW = F.G * NWAVES;
    constexpr int I_IN = (D / 64) * (NPROJ / 32), I_SSD = (DIN / 64) * (D / 32), I_ATT = (D / 64) * (D / 32), I_O = I_ATT, I_FF = (D / 64) * (2 * DFF / 32), I_FF2 = (DFF / 64) * (D / 32);
    constexpr int NITEMS = I_IN + I_SSD + I_ATT + I_O + I_FF + I_FF2;
    for (int it = gw; it < NITEMS; it += NGW) {
        int r = it;
        if (r < I_IN) {
            const int nblk = NPROJ / 32, kb = r / nblk, n0 = 32 * (r % nblk);
            const int src = n0 < 6144 ? n0 : (n0 < 11264 ? n0 + 32 : (n0 == 11264 ? 6144 : -1));
            p0_transpose_item(F.in[I_WIN], D, 11296, src, F.WinT(), n0, scr, kb, F.lane); continue; } r -= I_IN;
        if (r < I_SSD) { const int nblk = D / 32; p0_transpose_item(F.in[I_WSSD], DIN, D, 32 * (r % nblk), F.WssdT(), 32 * (r % nblk), scr, r / nblk, F.lane); continue; } r -= I_SSD;
        if (r < I_ATT) { const int nblk = D / 32; p0_transpose_item(F.in[I_WATT], D, D, 32 * (r % nblk), F.WattT(), 32 * (r % nblk), scr, r / nblk, F.lane); continue; } r -= I_ATT;
        if (r < I_O) { const int nblk = D / 32; p0_transpose_item(F.in[I_WO], D, D, 32 * (r % nblk), F.WoT(), 32 * (r % nblk), scr, r / nblk, F.lane); continue; } r -= I_O;
        if (r < I_FF) {
            const int nblk = 2 * DFF / 32, kb = r / nblk, n0 = 32 * (r % nblk), t = n0 / 256, w = n0 % 256;
            const int src = w < 128 ? 128 * t + w : DFF + 128 * t + (w - 128);
            p0_transpose_item(F.in[I_WFF], D, 2 * DFF, src, F.WffT(), n0, scr, kb, F.lane); continue; } r -= I_FF;
        { const int nblk = D / 32; p0_transpose_item(F.in[I_WFF2], DFF, D, 32 * (r % nblk), F.Wff2T(), 32 * (r % nblk), scr, r / nblk, F.lane); }
    }
    for (int m = gw; m < MALL; m += NGW) rms_row_to_bf16(x_row_ptr(F, m), F.in[I_NPRE], F.XN() + (size_t)m * D, F.lane);
}

namespace pg8 {
struct EpiProj {
    static constexpr bool PERM = true, AFTER_DRAIN = false;
    bf16 *Z, *XBC, *Q, *K, *V, *GS, *GA; float* DT; const float* dtb; float* out;
    __device__ __forceinline__ void operator()(const f32x4 (&acc)[2][2][4][2], const Unit& u, int wr, int wc, int fr, int fq) const {
        const int t = u.pn;
        if (t == 44) {
            if (wc != 0) return;
            const f32x4 b0 = *(const f32x4*)(dtb + 8 * fq), b1 = *(const f32x4*)(dtb + 8 * fq + 4);
#pragma unroll
            for (int ai = 0; ai < 2; ++ai)
#pragma unroll
                for (int m = 0; m < 4; ++m) { const int r = u.pm * 256 + ai * 128 + wr * 64 + m * 16 + fr; f32x4 v0 = acc[ai][0][m][0] + b0, v1 = acc[ai][0][m][1] + b1;
#pragma unroll
                    for (int e = 0; e < 4; ++e) { v0[e] = softplusf_(v0[e]); v1[e] = softplusf_(v1[e]); }
                    *(f32x4*)(DT + (size_t)r * 32 + 8 * fq) = v0; *(f32x4*)(DT + (size_t)r * 32 + 8 * fq + 4) = v1; }
            return; }
        bf16* base; int ld, c0; int kind;
        if (t < 8) { base = Z; ld = DIN; c0 = 256 * t; kind = 0; }
        else if (t < 24) { base = XBC; ld = CONVD; c0 = 256 * (t - 8); kind = 1; }
        else if (t < 28) { base = Q; ld = D; c0 = 256 * (t - 24); kind = 2; }
        else if (t < 32) { base = K; ld = D; c0 = 256 * (t - 28); kind = 3; }
        else if (t < 36) { base = V; ld = D; c0 = 256 * (t - 32); kind = 4; }
        else if (t < 40) { base = GS; ld = D; c0 = 256 * (t - 36); kind = 5; }
        else { base = GA; ld = D; c0 = 256 * (t - 40); kind = 5; }
#pragma unroll
        for (int ai = 0; ai < 2; ++ai)
#pragma unroll
            for (int m = 0; m < 4; ++m) { const int r = u.pm * 256 + ai * 128 + wr * 64 + m * 16 + fr;
#pragma unroll
                for (int bj = 0; bj < 2; ++bj) { const int col = c0 + bj * 128 + wc * 32 + 8 * fq; f32x4 v0 = acc[ai][bj][m][0], v1 = acc[ai][bj][m][1];
                    if (kind == 1) {
                        float* dst = nullptr;
                        if (r < MP) { const int tt = r % SEQ; if (tt >= SEQ - 3) dst = out + OUT_CP + ((size_t)(r / SEQ) * 3 + (tt - (SEQ - 3))) * CONVD + col; }
                        else if (r < MMAIN) { const int tt = (r - MP) % DSEQ; if (tt >= DSEQ - 3) dst = out + OUT_CS + ((size_t)((r - MP) / DSEQ) * 3 + (tt - (DSEQ - 3))) * CONVD + col; }
                        if (dst) { *(f32x4*)dst = v0; *(f32x4*)(dst + 4) = v1; } }
                    if (kind == 3 || kind == 4) {
                        const size_t op = kind == 3 ? OUT_KP : OUT_VP, os = kind == 3 ? OUT_KS : OUT_VS;
                        if (r < MP) { float* dst = out + op + ((size_t)(r / SEQ) * LEXT + NMETA + (r % SEQ)) * 1024 + col; *(f32x4*)dst = v0; *(f32x4*)(dst + 4) = v1; }
                        else if (r < MMAIN) { float* dst = out + os + (size_t)(r - MP) * 1024 + col; *(f32x4*)dst = v0; *(f32x4*)(dst + 4) = v1; }
                        else if (r < MMAIN + NMETA) { for (int b = 0; b < BATCH; ++b) { float* dst = out + op + ((size_t)b * LEXT + (r - MMAIN)) * 1024 + col; *(f32x4*)dst = v0; *(f32x4*)(dst + 4) = v1; } } }
                    if (kind == 2) { v0 = v0 * QSCALE; v1 = v1 * QSCALE; }
                    if (kind == 5) {
#pragma unroll
                        for (int e = 0; e < 4; ++e) { v0[e] = sigmoidf_(v0[e]); v1[e] = sigmoidf_(v1[e]); } }
                    u32x4 w; w.x = cvt_pk_bf16(v0[0], v0[1]); w.y = cvt_pk_bf16(v0[2], v0[3]); w.z = cvt_pk_bf16(v1[0], v1[1]); w.w = cvt_pk_bf16(v1[2], v1[3]);
                    *(u32x4*)(base + (size_t)r * ld + col) = w; } }
    }
};
template <int SECOND> struct EpiGate {
    static constexpr bool PERM = true, AFTER_DRAIN = false;
    const bf16* G; const bf16* T; bf16* O;
    __device__ __forceinline__ void operator()(const f32x4 (&acc)[2][2][4][2], const Unit& u, int wr, int wc, int fr, int fq) const {
#pragma unroll
        for (int ai = 0; ai < 2; ++ai)
#pragma unroll
            for (int m = 0; m < 4; ++m) { const int r = u.pm * 256 + ai * 128 + wr * 64 + m * 16 + fr;
#pragma unroll
                for (int bj = 0; bj < 2; ++bj) { const size_t off = (size_t)r * D + u.pn * 256 + bj * 128 + wc * 32 + 8 * fq;
                    const u32x4 g = *(const u32x4*)(G + off); const f32x4 a0 = acc[ai][bj][m][0], a1 = acc[ai][bj][m][1];
                    float v[8] = {a0[0] * bflo(g.x), a0[1] * bfhi(g.x), a0[2] * bflo(g.y), a0[3] * bfhi(g.y), a1[0] * bflo(g.z), a1[1] * bfhi(g.z), a1[2] * bflo(g.w), a1[3] * bfhi(g.w)};
                    if (SECOND) { const u32x4 tv = *(const u32x4*)(T + off);
                        v[0] += bflo(tv.x); v[1] += bfhi(tv.x); v[2] += bflo(tv.y); v[3] += bfhi(tv.y); v[4] += bflo(tv.z); v[5] += bfhi(tv.z); v[6] += bflo(tv.w); v[7] += bfhi(tv.w); }
                    u32x4 w; w.x = cvt_pk_bf16(v[0], v[1]); w.y = cvt_pk_bf16(v[2], v[3]); w.z = cvt_pk_bf16(v[4], v[5]); w.w = cvt_pk_bf16(v[6], v[7]);
                    *(u32x4*)(O + off) = w; } }
    }
};
struct EpiF32 {
    static constexpr bool PERM = false, AFTER_DRAIN = false;
    float* O; int ldc;
    __device__ __forceinline__ void operator()(const f32x4 (&acc)[2][2][4][2], const Unit& u, int wr, int wc, int fr, int fq) const {
#pragma unroll
        for (int ai = 0; ai < 2; ++ai)
#pragma unroll
            for (int m = 0; m < 4; ++m) { float* rowp = O + (size_t)(u.pm * 256 + ai * 128 + wr * 64 + m * 16 + fr) * ldc + u.pn * 256 + wc * 32 + 4 * fq;
#pragma unroll
                for (int bj = 0; bj < 2; ++bj)
#pragma unroll
                    for (int n = 0; n < 2; ++n) *(f32x4*)(rowp + bj * 128 + n * 16) = acc[ai][bj][m][n]; }
    }
};
struct EpiSwiglu {
    static constexpr bool PERM = true, AFTER_DRAIN = false;
    bf16* O;
    __device__ __forceinline__ void operator()(const f32x4 (&acc)[2][2][4][2], const Unit& u, int wr, int wc, int fr, int fq) const {
#pragma unroll
        for (int ai = 0; ai < 2; ++ai)
#pragma unroll
            for (int m = 0; m < 4; ++m) { const int r = u.pm * 256 + ai * 128 + wr * 64 + m * 16 + fr;
                const f32x4 g0 = acc[ai][0][m][0], g1 = acc[ai][0][m][1], u0 = acc[ai][1][m][0], u1 = acc[ai][1][m][1]; float v[8];
#pragma unroll
                for (int e = 0; e < 4; ++e) { v[e] = siluf_(g0[e]) * u0[e]; v[4 + e] = siluf_(g1[e]) * u1[e]; }
                u32x4 w; w.x = cvt_pk_bf16(v[0], v[1]); w.y = cvt_pk_bf16(v[2], v[3]); w.z = cvt_pk_bf16(v[4], v[5]); w.w = cvt_pk_bf16(v[6], v[7]);
                *(u32x4*)(O + (size_t)r * DFF + u.pn * 128 + wc * 32 + 8 * fq) = w; }
    }
};
}
constexpr int S_XT = 0, S_BM = 36864, S_BT = S_BM + 17408, S_CM = S_BT + 18432, S_ZU = S_CM + 17408, S_ACS = S_ZU + 33792, S_DTV = S_ACS + 1024, S_WSC = S_DTV + 1024, S_SSQ = S_WSC + 1024, S_END = S_SSQ + 2048;
constexpr int XT_P = 144, BM_P = 272, ZU_P = 528;
static_assert(S_END <= RING_BYTES, "SSD LDS map");
struct SsdChunk { int row0; int t0, t1, halo; bool store_y; };

DEV v4u ssd_raw_row(const Frame& F, const SsdChunk& ck, int sb, int tp, int col) {
    const v4u zero = {0u, 0u, 0u, 0u};
    if (tp >= ck.t0 && tp < ck.t1) return *(const v4u*)(F.XBC() + (int)(ck.row0 + tp) * CONVD + col);
    if (tp < ck.t0 && tp >= ck.t0 - 3) {
        if (ck.halo == 1) return *(const v4u*)(F.XBC() + (int)(ck.row0 + tp) * CONVD + col);
        if (ck.halo == 2) return *(const v4u*)(F.XBC() + (int)(MMAIN + NMETA + (tp - ck.t0)) * CONVD + col);
        if (ck.halo == 3) { const float* s = F.in[I_SCONV] + ((int)sb * 3 + (3 + tp - ck.t0)) * CONVD + col; const f32x4 a = *(const f32x4*)s, b = *(const f32x4*)(s + 4);
            v4u r; r.x = pk2(a.x, a.y); r.y = pk2(a.z, a.w); r.z = pk2(b.x, b.y); r.w = pk2(b.z, b.w); return r; }
    }
    return zero;
}
DEV unsigned hw_(unsigned w, int h) { return h ? (w >> 16) : (w & 0xffffu); }

DEV void ssd_chunk(Frame& F, const SsdChunk& ck, int sb, int g, f32x16 (&hacc)[4]) {
    LAS unsigned char* L = F.lds + RING_OFF;
    const int lane = opaque_v(F.lane), tid = opaque_v(F.tid), w = F.wave, l31 = lane & 31, hh = lane >> 5, h = w >> 1, j = w & 1;
    __syncthreads();
    if (w < 4) {
        const int t = lane; const bool valid = t >= ck.t0 && t < ck.t1;
        const float dtv = valid ? F.DT()[(int)(ck.row0 + t) * 32 + 4 * g + w] : 0.f;
        const float a = -EXP2(F.in[I_ALOG][4 * g + w] * LOG2E);
        float x = dtv * a;
#pragma unroll
        for (int d = 1; d < 64; d <<= 1) { const float v = __shfl_up(x, d); if (lane >= d) x += v; }
        const float last = __shfl(x, 63);
        ((LAS float*)(L + S_ACS))[w * 64 + t] = x; ((LAS float*)(L + S_DTV))[w * 64 + t] = dtv; ((LAS float*)(L + S_WSC))[w * 64 + t] = EXP2((last - x) * LOG2E) * dtv;
    }
    SCHED_BAR();
    {
        const int cg = lane, to = w;
        const int col = cg < 32 ? 256 * g + 8 * cg : (cg < 48 ? 2048 + 128 * g + 8 * (cg - 32) : 3072 + 128 * g + 8 * (cg - 48));
        v4u raw[11];
#pragma unroll
        for (int i = 0; i < 11; ++i) raw[i] = ssd_raw_row(F, ck, sb, 8 * to - 3 + i, col);
        const float* cw = F.in[I_CONVW] + col; const float* cb = F.in[I_CONVB] + col;
        unsigned pk[8][4];
#pragma unroll
        for (int e2 = 0; e2 < 4; ++e2) {
            float wgt[4][2], bias[2];
#pragma unroll
            for (int i = 0; i < 4; ++i) { wgt[i][0] = cw[i * CONVD + 2 * e2]; wgt[i][1] = cw[i * CONVD + 2 * e2 + 1]; }
            bias[0] = cb[2 * e2]; bias[1] = cb[2 * e2 + 1];
#pragma unroll
            for (int tt = 0; tt < 8; ++tt) { float a0 = bias[0], a1 = bias[1];
#pragma unroll
                for (int i = 0; i < 4; ++i) { const unsigned rw = raw[tt + i][e2]; a0 += wgt[i][0] * bflo(rw); a1 += wgt[i][1] * bfhi(rw); }
                pk[tt][e2] = pk2(siluf_(a0), siluf_(a1)); }
            SCHED_BAR();
        }
        if (cg < 48) {
            LAS unsigned char* base = cg < 32 ? L + S_XT + (8 * cg) * XT_P : L + S_BT + (8 * (cg - 32)) * XT_P;
#pragma unroll
            for (int e = 0; e < 8; ++e) { v4u o;
                o.x = hw_(pk[0][e >> 1], e & 1) | (hw_(pk[1][e >> 1], e & 1) << 16); o.y = hw_(pk[2][e >> 1], e & 1) | (hw_(pk[3][e >> 1], e & 1) << 16);
                o.z = hw_(pk[4][e >> 1], e & 1) | (hw_(pk[5][e >> 1], e & 1) << 16); o.w = hw_(pk[6][e >> 1], e & 1) | (hw_(pk[7][e >> 1], e & 1) << 16);
                *(LAS v4u*)(base + e * XT_P + 16 * to) = o; }
        }
        if (cg >= 32) {
            LAS unsigned char* base = cg < 48 ? L + S_BM + 16 * (cg - 32) : L + S_CM + 16 * (cg - 48);
#pragma unroll
            for (int tt = 0; tt < 8; ++tt) { v4u o; o.x = pk[tt][0]; o.y = pk[tt][1]; o.z = pk[tt][2]; o.w = pk[tt][3]; *(LAS v4u*)(base + (8 * to + tt) * BM_P) = o; }
        }
    }
    SCHED_BAR();
    {
        const int t = tid >> 3, seg = tid & 7; const bool valid = ck.store_y && t >= ck.t0 && t < ck.t1;
        const v4u zero = {0u, 0u, 0u, 0u};
#pragma unroll
        for (int i = 0; i < 4; ++i) *(LAS v4u*)(L + S_ZU + t * ZU_P + seg * 64 + 16 * i) = valid ? *(const v4u*)(F.Z() + (int)(ck.row0 + t) * DIN + 256 * g + 32 * seg + 8 * i) : zero;
    }
    __syncthreads();
    const LAS float* ACS = (const LAS float*)(L + S_ACS) + h * 64; const LAS float* DTV = (const LAS float*)(L + S_DTV) + h * 64; const LAS float* WSC = (const LAS float*)(L + S_WSC) + h * 64;
    const LAS float* acs_l = ACS + l31;
    const LAS float* acs_h = ACS + 4 * hh;  const LAS float* dtv_h = DTV + 4 * hh;
    const LAS float* wsc_h = WSC + 8 * hh;
    const LAS unsigned char* cm4 = L + S_CM + l31 * BM_P + 8 * hh;
    const LAS unsigned char* cm8 = L + S_CM + l31 * BM_P + 16 * hh;
    const LAS unsigned char* bm8 = L + S_BM + l31 * BM_P + 16 * hh;
    const LAS unsigned char* xt4 = L + S_XT + (64 * h + 32 * j + l31) * XT_P + 8 * hh;
    const LAS unsigned char* xt8 = L + S_XT + (64 * h + 32 * j + l31) * XT_P + 16 * hh;
    const LAS unsigned char* bt8 = L + S_BT + l31 * XT_P + 16 * hh;
    f32x16 yacc[2];
#pragma unroll
    for (int tb = 0; tb < 2; ++tb)
#pragma unroll
        for (int r = 0; r < 16; ++r) yacc[tb][r] = 0.f;
#pragma unroll
    for (int nb = 0; nb < 4; ++nb)
#pragma unroll
        for (int ss = 0; ss < 2; ++ss) { const bf16x8 a = pack_step(hacc[nb], ss);
#pragma unroll
            for (int tb = 0; tb < 2; ++tb) { const bf16x8 b = rd8x2(cm4 + 32 * tb * BM_P + (32 * nb + 16 * ss) * 2); yacc[tb] = mfma32(a, b, yacc[tb]); }
            SCHED_BAR(); }
    float acs_t[2];
#pragma unroll
    for (int tb = 0; tb < 2; ++tb) { acs_t[tb] = acs_l[32 * tb]; const float e = EXP2(acs_t[tb] * LOG2E);
#pragma unroll
        for (int r = 0; r < 16; ++r) yacc[tb][r] *= e; }
    const int dl = l31 - 4 * hh;
#pragma unroll
    for (int tile = 0; tile < 3; ++tile) { const int sb2 = tile == 2 ? 1 : 0, tb = tile == 0 ? 0 : 1;
        SCHED_BAR();
        f32x16 gt;
#pragma unroll
        for (int r = 0; r < 16; ++r) gt[r] = 0.f;
#pragma unroll
        for (int ks = 0; ks < 8; ++ks) { const bf16x8 a = rd16(bm8 + 32 * sb2 * BM_P + 32 * ks), b = rd16(cm8 + 32 * tb * BM_P + 32 * ks); gt = mfma32(a, b, gt); if (ks & 1) SCHED_BAR(); }
        SCHED_BAR();
#pragma unroll
        for (int r = 0; r < 16; ++r) { const int so = 32 * sb2 + (r & 3) + 8 * (r >> 2); const float v = gt[r] * EXP2((acs_t[tb] - acs_h[so]) * LOG2E) * dtv_h[so];
            gt[r] = (tile == 1 || (r & 3) + 8 * (r >> 2) <= dl) ? v : 0.f; }
        SCHED_BAR();
#pragma unroll
        for (int ss = 0; ss < 2; ++ss) { const bf16x8 b = pack_step(gt, ss), a = rd8x2(xt4 + (32 * sb2 + 16 * ss) * 2); yacc[tb] = mfma32(a, b, yacc[tb]); }
    }
    SCHED_BAR();
    { const float dec = EXP2(ACS[63] * LOG2E);
#pragma unroll
      for (int nb = 0; nb < 4; ++nb)
#pragma unroll
          for (int r = 0; r < 16; ++r) hacc[nb][r] *= dec;
#pragma unroll
      for (int ks = 0; ks < 4; ++ks) { const v4u xr = __builtin_bit_cast(v4u, rd16(xt8 + 32 * ks));
          const f32x4 w0 = *(const LAS f32x4*)(wsc_h + 16 * ks), w1 = *(const LAS f32x4*)(wsc_h + 16 * ks + 4);
          v4u xs; xs.x = pk2(bflo(xr.x) * w0.x, bfhi(xr.x) * w0.y); xs.y = pk2(bflo(xr.y) * w0.z, bfhi(xr.y) * w0.w); xs.z = pk2(bflo(xr.z) * w1.x, bfhi(xr.z) * w1.y); xs.w = pk2(bflo(xr.w) * w1.z, bfhi(xr.w) * w1.w);
          const bf16x8 b = __builtin_bit_cast(bf16x8, xs);
#pragma unroll
          for (int nb = 0; nb < 4; ++nb) { const bf16x8 a = rd16(bt8 + 32 * nb * XT_P + 32 * ks); hacc[nb] = mfma32(a, b, hacc[nb]); }
          SCHED_BAR(); }
    }
    SCHED_BAR();
    if (!ck.store_y) return;
    const float Dh = F.in[I_DSKIP][4 * g + h];
    const LAS unsigned char* zu_l = L + S_ZU + l31 * ZU_P + (64 * h + 32 * j + 4 * hh) * 2;
    const LAS unsigned char* xt_l = L + S_XT + (64 * h + 32 * j + 4 * hh) * XT_P + l31 * 2;
    LAS float* ssq_l = (LAS float*)(L + S_SSQ) + l31;
    float ssq[2] = {0.f, 0.f};
#pragma unroll
    for (int tb = 0; tb < 2; ++tb) {
#pragma unroll
        for (int q4 = 0; q4 < 4; ++q4) { const v2u zw = *(const LAS v2u*)(zu_l + 32 * tb * ZU_P + 16 * q4);
#pragma unroll
            for (int e = 0; e < 4; ++e) { const int r = 4 * q4 + e; const float x = bf2f(*(const LAS bf16*)(xt_l + (8 * q4 + e) * XT_P + 64 * tb));
                const unsigned zz = e < 2 ? zw.x : zw.y; const float z = (e & 1) ? bfhi(zz) : bflo(zz);
                const float u = (yacc[tb][r] + Dh * x) * siluf_(z); yacc[tb][r] = u; ssq[tb] += u * u; } }
        const float sq = ssq[tb] + __shfl_xor(ssq[tb], 32);
        if (hh == 0) ssq_l[64 * w + 32 * tb] = sq; }
    __syncthreads();
    const float* gn_l = F.in[I_SSDN] + 256 * g + 64 * h + 32 * j + 4 * hh;
#pragma unroll
    for (int tb = 0; tb < 2; ++tb) { float tot = 0.f;
#pragma unroll
        for (int ww = 0; ww < 8; ++ww) tot += ssq_l[64 * ww + 32 * tb];
        const float rstd = RSQ(tot * (1.f / 256.f) + EPS);
#pragma unroll
        for (int q4 = 0; q4 < 4; ++q4) { const f32x4 gn = *(const f32x4*)(gn_l + 8 * q4);
            v2u o; o.x = pk2(yacc[tb][4 * q4] * rstd * gn.x, yacc[tb][4 * q4 + 1] * rstd * gn.y); o.y = pk2(yacc[tb][4 * q4 + 2] * rstd * gn.z, yacc[tb][4 * q4 + 3] * rstd * gn.w);
            *(LAS v2u*)((LAS unsigned char*)zu_l + 32 * tb * ZU_P + 16 * q4) = o; } }
    __syncthreads();
    { const int t = tid >> 3, seg = tid & 7;
      if (t >= ck.t0 && t < ck.t1) {
#pragma unroll
          for (int i = 0; i < 4; ++i) *(v4u*)(F.Z() + (int)(ck.row0 + t) * DIN + 256 * g + 32 * seg + 8 * i) = *(const LAS v4u*)(L + S_ZU + t * ZU_P + seg * 64 + 16 * i); } }
}
DEV void ssd_unit(Frame& F, int kind, int sb, int g) {
    const int w = F.wave, h = w >> 1, j = w & 1, head = 4 * g + h;
    f32x16 hacc[4];
    if (kind == 0) {
#pragma unroll
        for (int nb = 0; nb < 4; ++nb)
#pragma unroll
            for (int r = 0; r < 16; ++r) hacc[nb][r] = 0.f;
    } else {
        const int lane = opaque_v(F.lane), l31 = lane & 31, hh = lane >> 5;
        const float* src = F.in[I_SSM] + (((int)sb * NSH + head) * 64 + 32 * j + l31) * DST;
#pragma unroll
        for (int nb = 0; nb < 4; ++nb)
#pragma unroll
            for (int q4 = 0; q4 < 4; ++q4) { const f32x4 v = *(const f32x4*)(src + 32 * nb + 8 * q4 + 4 * hh); hacc[nb][4 * q4] = v.x; hacc[nb][4 * q4 + 1] = v.y; hacc[nb][4 * q4 + 2] = v.z; hacc[nb][4 * q4 + 3] = v.w; }
    }
    if (kind == 0) {
        { SsdChunk ck; ck.row0 = MMAIN - 48; ck.t0 = 48; ck.t1 = 64; ck.halo = 0; ck.store_y = false; ssd_chunk(F, ck, sb, g, hacc); }
        for (int c = 0; c < SEQ / 64; ++c) { SsdChunk ck; ck.row0 = sb * SEQ + 64 * c; ck.t0 = 0; ck.t1 = 64; ck.halo = c == 0 ? 2 : 1; ck.store_y = true; ssd_chunk(F, ck, sb, g, hacc); }
    } else {
        SsdChunk ck; ck.row0 = MP + DSEQ * sb; ck.t0 = 0; ck.t1 = DSEQ; ck.halo = 3; ck.store_y = true; ssd_chunk(F, ck, sb, g, hacc);
    }
    const int lane = opaque_v(F.lane), l31 = lane & 31, hh = lane >> 5;
    float* dst = F.out + (kind == 0 ? OUT_SP : OUT_SS) + (((int)sb * NSH + head) * 64 + 32 * j + l31) * DST;
#pragma unroll
    for (int nb = 0; nb < 4; ++nb)
#pragma unroll
        for (int q4 = 0; q4 < 4; ++q4) { f32x4 v; v.x = hacc[nb][4 * q4]; v.y = hacc[nb][4 * q4 + 1]; v.z = hacc[nb][4 * q4 + 2]; v.w = hacc[nb][4 * q4 + 3]; *(f32x4*)(dst + 32 * nb + 8 * q4 + 4 * hh) = v; }
}
constexpr int A_KT = 0, A_VT = 17408, A_BUF = 35840, A_BIAS = 2 * A_BUF, A_QF = A_BIAS + 1280, A_END = A_QF + 32768, KT_P = 272, VT_P = 144;
static_assert(A_END <= RING_BYTES && 4 * 128 * 32 * 4 <= A_BIAS, "attention LDS map");
struct AttTile { int kind; int row0; const float* ck; const float* cv; int nvalid, kpos0; };
struct AttRegs { v4u r[8]; };

DEV AttTile att_tile(const Frame& F, int ukind, int sb, int hd, int i) {
    AttTile t; t.ck = nullptr; t.cv = nullptr; t.kind = 0;
    if (i == 0) { t.row0 = MMAIN; t.nvalid = NMETA; t.kpos0 = 0; return t; }
    const int f = i - 1;
    if (ukind == 0) { t.row0 = sb * SEQ + 64 * f; t.nvalid = 64; t.kpos0 = NMETA + 64 * f; return t; }
    if (f < PAST / 64) { t.kind = 1; t.row0 = 0; t.ck = F.in[I_CK] + ((size_t)sb * PAST + 64 * f) * 1024 + 128 * hd; t.cv = F.in[I_CV] + ((size_t)sb * PAST + 64 * f) * 1024 + 128 * hd; t.nvalid = 64; t.kpos0 = NMETA + 64 * f; return t; }
    t.row0 = MP + DSEQ * sb; t.nvalid = DSEQ; t.kpos0 = NMETA + PAST; return t;
}
DEV void att_load(const Frame& F, const AttTile& t, int hd, AttRegs& R, int tid, int lane) {
    const int kvk = tid >> 3, seg = tid & 7, kvv = lane, dg = F.wave; const v4u zero = {0u, 0u, 0u, 0u};
    if (t.kind == 0) {
        const bf16* kp = F.K() + (t.row0 + kvk) * D + 128 * hd + 16 * seg; const bf16* vp = F.V() + (t.row0 + kvv) * D + 128 * hd + 16 * dg;
#pragma unroll
        for (int i = 0; i < 2; ++i) { R.r[i] = kvk < t.nvalid ? *(const v4u*)(kp + 8 * i) : zero; R.r[2 + i] = kvv < t.nvalid ? *(const v4u*)(vp + 8 * i) : zero; }
    } else {
        const float* kp = t.ck + kvk * 1024 + 16 * seg; const float* vp = t.cv + kvv * 1024 + 16 * dg;
#pragma unroll
        for (int i = 0; i < 4; ++i) { R.r[i] = kvk < t.nvalid ? *(const v4u*)(kp + 4 * i) : zero; R.r[4 + i] = kvv < t.nvalid ? *(const v4u*)(vp + 4 * i) : zero; }
    }
}
DEV v4u pack8_(const v4u& a, const v4u& b) { v4u o; o.x = pk2(uaf(a.x), uaf(a.y)); o.y = pk2(uaf(a.z), uaf(a.w)); o.z = pk2(uaf(b.x), uaf(b.y)); o.w = pk2(uaf(b.z), uaf(b.w)); return o; }
DEV void att_store(const Frame& F, const AttTile& t, AttRegs& R, LAS unsigned char* buf, int tid, int lane) {
    const int kvk = tid >> 3, seg = tid & 7, kvv = lane, dg = F.wave;
    v4u bk[2], bv[2];
    if (t.kind == 1) { bk[0] = pack8_(R.r[0], R.r[1]); bk[1] = pack8_(R.r[2], R.r[3]); bv[0] = pack8_(R.r[4], R.r[5]); bv[1] = pack8_(R.r[6], R.r[7]); }
    else { bk[0] = R.r[0]; bk[1] = R.r[1]; bv[0] = R.r[2]; bv[1] = R.r[3]; }
#pragma unroll
    for (int i = 0; i < 2; ++i) *(LAS v4u*)(buf + A_KT + kvk * KT_P + seg * 32 + 16 * i) = bk[i];
#pragma unroll
    for (int i = 0; i < 2; ++i)
#pragma unroll
        for (int e = 0; e < 4; ++e) { const unsigned wv = bv[i][e];
            *(LAS bf16*)(buf + A_VT + (16 * dg + 8 * i + 2 * e) * VT_P + kvv * 2) = (bf16)(wv & 0xffffu); *(LAS bf16*)(buf + A_VT + (16 * dg + 8 * i + 2 * e + 1) * VT_P + kvv * 2) = (bf16)(wv >> 16); }
}
DEV void att_unit(Frame& F, int ukind, int sb, int hd, int cp) {
    LAS unsigned char* L = F.lds + RING_OFF;
    const int lane = opaque_v(F.lane), tid = opaque_v(F.tid), w = F.wave, l31 = lane & 31, hh = lane >> 5, comp = w >> 2, qb = w & 3;
    const bool active = ukind == 0 || qb == 0;
    const int ntile = ukind == 0 ? 2 * cp + 3 : PAST / 64 + 2;
    const int myvis = ukind == 0 ? 2 * cp + 2 + (qb >> 1) : ntile;
    const int qrow = ukind == 0 ? sb * SEQ + 128 * cp + 32 * qb + l31 : MP + DSEQ * sb + l31;
    const int qpos0 = ukind == 0 ? NMETA + 128 * cp + 32 * qb : NMETA + PAST;
    __syncthreads();
    if (tid < 320) { const int rel = tid - 255, n = rel < 0 ? -rel : rel; int bk;
        if (n < 8) bk = n; else { bk = 8 + (int)(2.0f * LOG2((float)n * 0.125f) + 1e-4f); bk = bk > 15 ? 15 : bk; }
        if (rel > 0) bk += 16;
        ((LAS float*)(L + A_BIAS))[tid] = (F.in[I_RELB][bk * NAH + hd] - F.in[I_RELB][15 * NAH + hd]) * LOG2E; }
    LAS unsigned char* qf_l = L + A_QF + (w * 256 + lane) * 16;
#pragma unroll
    for (int d0 = 0; d0 < 4; ++d0) { const v4u z = {0u, 0u, 0u, 0u}; *(LAS v4u*)(qf_l + 1024 * d0) = active ? *(const v4u*)(F.Q() + qrow * D + 128 * hd + 64 * comp + 16 * d0 + 8 * hh) : z; }
    f32x16 o[4];
#pragma unroll
    for (int dt = 0; dt < 4; ++dt)
#pragma unroll
        for (int r = 0; r < 16; ++r) o[dt][r] = 0.f;
    float mrun = -INFINITY, lsum = 0.f;
    AttRegs R; AttTile tcur = att_tile(F, ukind, sb, hd, 0), tnext = tcur;
    att_load(F, tcur, hd, R, tid, lane); att_store(F, tcur, R, L, tid, lane);
    __syncthreads();
    for (int i = 0; i < ntile; ++i) {
        LAS unsigned char* buf = L + (i & 1) * A_BUF;
        if (i + 1 < ntile) { tnext = att_tile(F, ukind, sb, hd, i + 1); att_load(F, tnext, hd, R, tid, lane); }
        if (active && i < myvis) {
            f32x16 p0, p1;
#pragma unroll
            for (int r = 0; r < 16; ++r) { p0[r] = 0.f; p1[r] = 0.f; }
            const LAS unsigned char* kb = buf + A_KT + l31 * KT_P + (64 * comp + 8 * hh) * 2;
#pragma unroll
            for (int d0 = 0; d0 < 4; ++d0) { const bf16x8 a0 = rd16(kb + d0 * 32), a1 = rd16(kb + 32 * KT_P + d0 * 32); const bf16x8 qv = rd16(qf_l + 1024 * d0); p0 = mfma32(a0, qv, p0); p1 = mfma32(a1, qv, p1); }
            SCHED_BAR();
            const int kmax = tcur.kpos0 + tcur.nvalid - 1;
            if (kmax - qpos0 > -128) {
                const LAS float* tab_l = (const LAS float*)(L + A_BIAS) + (tcur.kpos0 - (qpos0 + l31) + 255 + 4 * hh);
#pragma unroll
                for (int r = 0; r < 16; ++r) { p0[r] += tab_l[(r & 3) + 8 * (r >> 2)]; p1[r] += tab_l[(r & 3) + 8 * (r >> 2) + 32]; }
            }
            if (tcur.nvalid < 64) {
#pragma unroll
                for (int r = 0; r < 16; ++r) { if (crow(r, hh) >= tcur.nvalid) p0[r] = -INFINITY; if (crow(r, hh) + 32 >= tcur.nvalid) p1[r] = -INFINITY; }
            }
            float mx = p0[0];
#pragma unroll
            for (int r = 1; r < 16; ++r) mx = fmaxf(mx, p0[r]);
#pragma unroll
            for (int r = 0; r < 16; ++r) mx = fmaxf(mx, p1[r]);
            mx = fmaxf(mx, __shfl_xor(mx, 32));
            const float mnew = fmaxf(mrun, mx), alpha = EXP2(mrun - mnew); mrun = mnew;
            float ps = 0.f;
#pragma unroll
            for (int r = 0; r < 16; ++r) { p0[r] = EXP2(p0[r] - mnew); p1[r] = EXP2(p1[r] - mnew); ps += p0[r] + p1[r]; }
            lsum = lsum * alpha + ps;
#pragma unroll
            for (int dt = 0; dt < 4; ++dt)
#pragma unroll
                for (int r = 0; r < 16; ++r) o[dt][r] *= alpha;
            SCHED_BAR();
            const LAS unsigned char* vt4 = buf + A_VT + l31 * VT_P + 8 * hh;
            bf16x8 pa[4]; pa[0] = pack_step(p0, 0); pa[1] = pack_step(p0, 1); pa[2] = pack_step(p1, 0); pa[3] = pack_step(p1, 1);
#pragma unroll
            for (int dt = 0; dt < 4; ++dt)
#pragma unroll
                for (int ks = 0; ks < 4; ++ks) { const bf16x8 a = rd8x2(vt4 + 32 * dt * VT_P + (32 * (ks >> 1) + 16 * (ks & 1)) * 2); o[dt] = mfma32(a, pa[ks], o[dt]); if (ks == 3) SCHED_BAR(); }
        }
        if (i + 1 < ntile) att_store(F, tnext, R, L + ((i + 1) & 1) * A_BUF, tid, lane);
        tcur = tnext;
        __syncthreads();
    }
    if (active) { const float l = lsum + __shfl_xor(lsum, 32), inv = RCP(l);
#pragma unroll
        for (int dt = 0; dt < 4; ++dt)
#pragma unroll
            for (int r = 0; r < 16; ++r) o[dt][r] *= inv; }
    LAS float* xo_l = (LAS float*)L + (qb * 128 + 4 * hh) * 32 + l31;
    if (active && comp == 1) {
#pragma unroll
        for (int dt = 0; dt < 4; ++dt)
#pragma unroll
            for (int r = 0; r < 16; ++r) xo_l[(32 * dt + (r & 3) + 8 * (r >> 2)) * 32] = o[dt][r]; }
    __syncthreads();
    if (active && comp == 0) { float ss = 0.f;
        const float lam = EXP2(wave_sum(F.in[I_LQ1][lane] * F.in[I_LK1][lane]) * LOG2E) - EXP2(wave_sum(F.in[I_LQ2][lane] * F.in[I_LK2][lane]) * LOG2E) + 0.2f;
#pragma unroll
        for (int dt = 0; dt < 4; ++dt)
#pragma unroll
            for (int r = 0; r < 16; ++r) { const float v = o[dt][r] - lam * xo_l[(32 * dt + (r & 3) + 8 * (r >> 2)) * 32]; o[dt][r] = v; ss += v * v; }
        ss += __shfl_xor(ss, 32);
        const float rstd = RSQ(ss * (1.f / 128.f) + EPS) * 0.8f;
        bf16* orow = F.Q() + qrow * D + 128 * hd;
#pragma unroll
        for (int dt = 0; dt < 4; ++dt)
#pragma unroll
            for (int q4 = 0; q4 < 4; ++q4) { const int d0 = 32 * dt + 8 * q4 + 4 * hh; const f32x4 gn = *(const f32x4*)(F.in[I_SUBLN] + d0);
                v2u ov; ov.x = pk2(o[dt][4 * q4] * rstd * gn.x, o[dt][4 * q4 + 1] * rstd * gn.y); ov.y = pk2(o[dt][4 * q4 + 2] * rstd * gn.z, o[dt][4 * q4 + 3] * rstd * gn.w);
                *(v2u*)(orow + d0) = ov; } }
}

DEV void row_phase(Frame& F, int second) {
    const int gw = F.vcu * NWAVES + F.wave, NGW = F.G * NWAVES, lane = F.lane;
    for (int m = gw; m < MMAIN; m += NGW) {
        const f32x4* tr = (const f32x4*)((second ? F.T2() : F.T1()) + (size_t)m * D) + lane;
        const f32x4* br = (const f32x4*)(second ? F.out + (size_t)m * D : x_row_ptr(F, m)) + lane;
        const f32x4* g1 = (const f32x4*)F.in[second ? I_NFFNP : I_NPOST] + lane;
        f32x4 tv[4], bv[4]; float s = 0.f;
#pragma unroll
        for (int jj = 0; jj < 4; ++jj) { tv[jj] = tr[64 * jj]; bv[jj] = br[64 * jj]; s += (tv[jj].x * tv[jj].x + tv[jj].y * tv[jj].y) + (tv[jj].z * tv[jj].z + tv[jj].w * tv[jj].w); }
        const float r = RSQ(wave_sum(s) * (1.f / D) + EPS); float s2 = 0.f;
        f32x4* orow = (f32x4*)(F.out + (size_t)m * D) + lane;
#pragma unroll
        for (int jj = 0; jj < 4; ++jj) { const f32x4 g = g1[64 * jj]; bv[jj] = bv[jj] + tv[jj] * r * g; orow[64 * jj] = bv[jj]; s2 += (bv[jj].x * bv[jj].x + bv[jj].y * bv[jj].y) + (bv[jj].z * bv[jj].z + bv[jj].w * bv[jj].w); }
        if (!second) {
            const float r2 = RSQ(wave_sum(s2) * (1.f / D) + EPS); const f32x4* g2 = (const f32x4*)F.in[I_NFFN] + lane;
            unsigned long long* o8 = (unsigned long long*)(F.XN() + (size_t)m * D) + lane;
#pragma unroll
            for (int jj = 0; jj < 4; ++jj) { const f32x4 g = g2[64 * jj]; o8[64 * jj] = (unsigned long long)pk2(bv[jj].x * r2 * g.x, bv[jj].y * r2 * g.y) | ((unsigned long long)pk2(bv[jj].z * r2 * g.z, bv[jj].w * r2 * g.w) << 32); }
        }
    }
}
struct Args { const float* in[29]; float* out; unsigned char* ws; int ph_lo, ph_hi, li, pad; };
#ifndef EMU
#define RLX_AGENT __ATOMIC_RELAXED, __HIP_MEMORY_SCOPE_AGENT
#define XB_TMO      128
#define XB_XCNT(j)  (256  + 64 * (j))
#define XB_XSUB(j)  (1280 + 64 * (j))
#define XB_XGEN(j)  (2304 + 64 * (j))
#define XB_TOP      3328
#define XB_TOPGEN   3392
#define XCD_BAR_WORDS 3456
#define XB_SPIN_CAP (1u << 18)

__device__ __forceinline__ unsigned xb_ld(unsigned* p)              { return __hip_atomic_load(p, __ATOMIC_RELAXED, __HIP_MEMORY_SCOPE_AGENT); }
__device__ __forceinline__ unsigned xb_add(unsigned* p, unsigned v) { return __hip_atomic_fetch_add(p, v, __ATOMIC_RELAXED, __HIP_MEMORY_SCOPE_AGENT); }
__device__ __forceinline__ unsigned xb_xcc_id() { return (unsigned)__builtin_amdgcn_s_getreg((3 << 11) | 20) & 0xFu; }
#define XB_SPIN(cond, bar) do { unsigned _sp = 0; while (cond) { __builtin_amdgcn_s_sleep(1); \
    if ((++_sp & 255u) == 0u) { if (xb_ld(&(bar)[XB_TMO])) break; if (_sp > XB_SPIN_CAP) { atomicAdd(&(bar)[XB_TMO], 1u); break; } } } } while (0)

struct XcdBarrier {
    unsigned* bar; unsigned x;
    volatile LAS unsigned* st;
};

__device__ __forceinline__ XcdBarrier xcd_barrier_post(unsigned* bar, volatile LAS unsigned* st) {
    XcdBarrier b; b.bar = bar; b.x = xb_xcc_id(); b.st = st;
    if (threadIdx.x == 0) (void)xb_add(&bar[XB_XCNT(b.x)], 1u);
    return b;
}
__device__ __forceinline__ void xcd_barrier_complete(unsigned* bar, unsigned x, unsigned& nloc, unsigned& nx) {
    const unsigned G = gridDim.x * gridDim.y * gridDim.z;
    unsigned sum, cnt, mine, sp = 0u;
    for (;;) {
        sum = 0u; cnt = 0u; mine = 0u;
#pragma unroll
        for (unsigned j = 0; j < 16; ++j) { const unsigned c = xb_ld(&bar[XB_XCNT(j)]); sum += c; cnt += (c > 0u) ? 1u : 0u; mine = (j == x) ? c : mine; }
        if (sum == G) break;
        __builtin_amdgcn_s_sleep(1);
        if ((++sp & 255u) == 0u) { if (xb_ld(&bar[XB_TMO])) break; if (sp > XB_SPIN_CAP) { atomicAdd(&bar[XB_TMO], 1u); break; } }
    }
    nloc = mine > 0u ? mine : 1u; nx = cnt > 0u ? cnt : 1u;
}

__device__ __forceinline__ void xcd_barrier(const XcdBarrier& b) {
    asm volatile("s_waitcnt vmcnt(0)" ::: "memory");
    __syncthreads();
    if (threadIdx.x == 0) {
        unsigned* bar = b.bar;
        __builtin_amdgcn_s_waitcnt(0);
        unsigned nloc = b.st[0], nx = b.st[1];
        if (nloc == 0u) { xcd_barrier_complete(bar, b.x, nloc, nx); b.st[0] = nloc; b.st[1] = nx; }
        const unsigned old = xb_add(&bar[XB_XSUB(b.x)], 1u);
        const unsigned gen = old / nloc;
        if (old + 1u == (gen + 1u) * nloc) {
            __builtin_amdgcn_fence(__ATOMIC_RELEASE, "agent");
            asm volatile("s_waitcnt vmcnt(0)" ::: "memory");
            const unsigned og = xb_add(&bar[XB_TOP], 1u);
            const unsigned tg = og / nx;
            if (og + 1u == (tg + 1u) * nx) xb_add(&bar[XB_TOPGEN], 1u);
            else XB_SPIN(xb_ld(&bar[XB_TOPGEN]) == tg, bar);
            __builtin_amdgcn_fence(__ATOMIC_ACQUIRE, "agent");
            xb_add(&bar[XB_XGEN(b.x)], 1u);
            asm volatile("s_waitcnt vmcnt(0)" ::: "memory");
        } else {
            XB_SPIN(xb_ld(&bar[XB_XGEN(b.x)]) == gen, bar);
            __builtin_amdgcn_fence(__ATOMIC_ACQUIRE, "agent");
            asm volatile("s_waitcnt vmcnt(0)" ::: "memory");
        }
    }
    __syncthreads();
}

#endif

__global__ void __launch_bounds__(NWAVES * 64, 2) skel_fwd(Args args) {
#ifdef EMU
    unsigned char* lds = emu::B->lds;
#else
    extern __shared__ __attribute__((aligned(16))) unsigned char lds[];
#endif
    Frame F;
    F.lds = (LAS unsigned char*)lds;
    F.tid = threadIdx.x; F.lane = F.tid & 63; F.wave = RDFL(F.tid >> 6);
    F.G = gridDim.x; { const int bx = blockIdx.x; F.vcu = (F.G % 8 == 0) ? (bx % 8) * (F.G / 8) + bx / 8 : bx; }
    unsigned char* ws = args.ws; F.ws = ws; F.out = args.out;
    F.in = args.in;
    F.ctl = (unsigned*)(ws + WS_CTL);
    for (int u = F.tid; u < (LDS_BYTES - LDSCTL_OFF) / 4; u += NWAVES * 64) ((LAS unsigned*)(F.lds + LDSCTL_OFF))[u] = 0u;
    __syncthreads();
#ifndef EMU
    volatile LAS unsigned* MISC = (volatile LAS unsigned*)(F.lds + MISC_OFF);
    XcdBarrier bar = xcd_barrier_post((unsigned*)(F.ctl + CW_BAR) + args.li * XCD_BAR_WORDS, MISC + 8);
#define GRID_BAR() xcd_barrier(bar)
#else
#define GRID_BAR() do {} while (0)
#endif
    const int lo = args.ph_lo, hi = args.ph_hi;
#define IN(k) (lo <= (k) && (k) < hi)
#define BOTH(k) (IN(k) && IN((k) + 1))

    if (IN(0)) { p0_prologue(F); if (BOTH(0)) GRID_BAR(); }

    if (IN(1)) {
        pg8::Gemm g{F.XN(), F.WinT(), MALL, NPROJ, D}; pg8::StaticOrder S; S.init(MALL, NPROJ, F.G, (int)blockIdx.x);
        pg8::EpiProj E{F.Z(), F.XBC(), F.Q(), F.K(), F.V(), F.GS(), F.GA(), F.DT(), F.in[I_DTB], F.out};
        pg8::gemm_phase<pg8::EpiProj, pg8::StaticOrder, PG8_ALIGN, PG8_SP2>(F.lds + RING_OFF, g, S, E);
        if (BOTH(1)) GRID_BAR();
    }

    if (IN(2)) {
#ifndef SKIP_SSD
        for (int u = F.vcu; u < BATCH * NGRP; u += F.G) ssd_unit(F, 0, u / NGRP, u % NGRP);
        for (int u = F.vcu; u < DECB * NGRP; u += F.G) ssd_unit(F, 1, u / NGRP, u % NGRP);
#endif
#ifndef SKIP_ATT
        for (int u = F.vcu; u < BATCH * NAH; u += F.G)
            for (int cp = 0; cp < SEQ / 128; ++cp) att_unit(F, 0, u / NAH, u % NAH, cp);
        for (int u = F.vcu; u < DECB * NAH; u += F.G) att_unit(F, 1, u / NAH, u % NAH, 0);
#endif
        __syncthreads();
        if (BOTH(2)) GRID_BAR();
    }

    if (IN(3)) {
        { pg8::Gemm g{F.Z(), F.WssdT(), MMAIN, D, DIN}; pg8::StaticOrder S; S.init(MMAIN, D, F.G, (int)blockIdx.x);
          pg8::EpiGate<0> E{F.GS(), nullptr, F.TMP()};
          pg8::gemm_phase<pg8::EpiGate<0>, pg8::StaticOrder, PG8_ALIGN, PG8_SP2>(F.lds + RING_OFF, g, S, E); }
        VM_WAIT(); __syncthreads();
        { pg8::Gemm g{F.Q(), F.WattT(), MMAIN, D, D}; pg8::StaticOrder S; S.init(MMAIN, D, F.G, (int)blockIdx.x);
          pg8::EpiGate<1> E{F.GA(), F.TMP(), F.MIX()};
          pg8::gemm_phase<pg8::EpiGate<1>, pg8::StaticOrder, PG8_ALIGN, PG8_SP2>(F.lds + RING_OFF, g, S, E); }
        if (BOTH(3)) GRID_BAR();
    }

    if (IN(4)) {
        pg8::Gemm g{F.MIX(), F.WoT(), MMAIN, D, D}; pg8::StaticOrder S; S.init(MMAIN, D, F.G, (int)blockIdx.x);
        pg8::EpiF32 E{F.T1(), D};
        pg8::gemm_phase<pg8::EpiF32, pg8::StaticOrder, PG8_ALIGN, PG8_SP2>(F.lds + RING_OFF, g, S, E);
        if (BOTH(4)) GRID_BAR();
    }
    if (IN(5)) { row_phase(F, 0); if (BOTH(5)) GRID_BAR(); }

    if (IN(6)) {
        pg8::Gemm g{F.XN(), F.WffT(), MMAIN, 2 * DFF, D}; pg8::StaticOrder S; S.init(MMAIN, 2 * DFF, F.G, (int)blockIdx.x);
        pg8::EpiSwiglu E{F.HB()};
        pg8::gemm_phase<pg8::EpiSwiglu, pg8::StaticOrder, PG8_ALIGN, PG8_SP2>(F.lds + RING_OFF, g, S, E);
        if (BOTH(6)) GRID_BAR();
    }
    if (IN(7)) {
        pg8::Gemm g{F.HB(), F.Wff2T(), MMAIN, D, DFF}; pg8::StaticOrder S; S.init(MMAIN, D, F.G, (int)blockIdx.x);
        pg8::EpiF32 E{F.T2(), D};
        pg8::gemm_phase<pg8::EpiF32, pg8::StaticOrder, PG8_ALIGN, PG8_SP2>(F.lds + RING_OFF, g, S, E);
        if (BOTH(7)) GRID_BAR();
    }
    if (IN(8)) { row_phase(F, 1); }
#undef IN
#undef BOTH
}

extern "C" void kernel_launch(void* const* d_in, const int* in_sizes, int n_in, void* d_out, int out_size, void* d_ws, size_t ws_size, hipStream_t stream) {
    if (n_in != 29 || (size_t)out_size != OUT_END || ws_size < WS_END) { fprintf(stderr, "kernel_launch: shape mismatch: n_in %d out %d (want %zu) ws %zu (want %zu)\n", n_in, out_size, (size_t)OUT_END, ws_size, (size_t)WS_END); return; }
    Args a{};
    for (int i = 0; i < 29; ++i) a.in[i] = (const float*)d_in[i];
    a.out = (float*)d_out; a.ws = (unsigned char*)d_ws;
#ifdef EMU
    memset((char*)d_ws + WS_CTL, 0, CTL_ZERO_BYTES);
    const int first = getenv("EMU_PH_LO") ? atoi(getenv("EMU_PH_LO")) : 0, last = getenv("EMU_PH_HI") ? atoi(getenv("EMU_PH_HI")) : NPHASE;
    const int grid = getenv("EMU_GRID") ? atoi(getenv("EMU_GRID")) : 8;
    for (int ph = first; ph < last; ++ph) { a.ph_lo = ph; a.ph_hi = ph + 1; a.li = 0; fprintf(stderr, "[emu] phase %d\n", ph); emu::launch(grid, NWAVES * 64, LDS_BYTES, [=] { skel_fwd(a); }); }
#else
    static int grid = 0;
    if (grid == 0) {
        int dev = 0, cus = 0, per_cu = 0;
        if (hipGetDevice(&dev) != hipSuccess || hipDeviceGetAttribute(&cus, hipDeviceAttributeMultiprocessorCount, dev) != hipSuccess) { fprintf(stderr, "kernel_launch: device query failed\n"); grid = -1; return; }
        if (hipFuncSetAttribute((const void*)skel_fwd, hipFuncAttributeMaxDynamicSharedMemorySize, LDS_BYTES) != hipSuccess) { fprintf(stderr, "kernel_launch: hipFuncSetAttribute failed\n"); grid = -1; return; }
        if (hipOccupancyMaxActiveBlocksPerMultiprocessor(&per_cu, (const void*)skel_fwd, NWAVES * 64, LDS_BYTES) != hipSuccess || per_cu < 1) { fprintf(stderr, "kernel_launch: occupancy query says %d blocks per CU\n", per_cu); (void)hipGetLastError(); per_cu = 1; }
        grid = cus;
    }
    if (grid < 0) return;
    if (hipMemsetAsync((char*)d_ws + WS_CTL, 0, CTL_ZERO_BYTES, stream) != hipSuccess) { fprintf(stderr, "kernel_launch: memset failed\n"); return; }
    constexpr int NL = MK_N_LAUNCHES;
    for (int li = 0; li < NL; ++li) {
        a.ph_lo = NL == 1 ? 0 : li; a.ph_hi = NL == 1 ? NPHASE : li + 1; a.li = li;
        hipLaunchKernelGGL(skel_fwd, dim3(grid), dim3(NWAVES * 64), LDS_BYTES, stream, a);
        const hipError_t le = hipPeekAtLastError();
        if (le != hipSuccess) { fprintf(stderr, "kernel_launch: launch %d failed: %s\n", li, hipGetErrorName(le)); break; }
    }
#endif
}
```

```cpp
#ifndef EMU
#include <hip/hip_runtime.h>
#endif
#include <cstdio>
#include <cstdint>
#include <cmath>

#ifdef EMU
#define PG8_LAS
#define LAS
#define GAS
#define WAVE_LDS_SYNC() emu::wave_sync()
#define RDFL(x) (x)
#else
#define PG8_LAS __attribute__((address_space(3)))
#define LAS __attribute__((address_space(3)))
#define GAS __attribute__((address_space(1)))
#define WAVE_LDS_SYNC() asm volatile("s_waitcnt lgkmcnt(0)" ::: "memory")
#define RDFL(x) __builtin_amdgcn_readfirstlane(x)
#endif
namespace pg8 {
typedef unsigned short bf16_t;
typedef short bf16x8 __attribute__((ext_vector_type(8)));
typedef float f32x4 __attribute__((ext_vector_type(4)));
typedef unsigned u32x4 __attribute__((ext_vector_type(4)));
constexpr int BM = 256, BK = 64, HALF = 128, HTB = HALF * BK * 2  , STAGE_BYTES = 8 * HTB, NXCD = 8, WGM = 8;

__host__ __device__ __forceinline__ int lds_byte(int r, int c) { const int st = (r >> 4) * 2 + (c >> 5), rr = r & 15, cc = c & 31, ob = rr * 64 + cc * 2; return st * 1024 + (ob ^ (((ob >> 9) & 1) << 5)); }
__host__ __device__ __forceinline__ void stage_rc(int b, int& R, int& C) { const int st = b / 1024, sb = b % 1024, swz = sb ^ (((sb >> 9) & 1) << 5); R = (st >> 1) * 16 + swz / 64; C = (st & 1) * 32 + (swz % 64) / 2; }
__host__ __device__ __forceinline__ int perm32(int rho) { const int n = rho >> 4, i = rho & 15; return 8 * (i >> 2) + 4 * n + (i & 3); }

struct Unit { int pm, pn; };
struct Gemm { const bf16_t* A; const bf16_t* Bt; int M, N, K; };

struct StaticOrder {
    int nM, nN, nwg, G, c;
    __host__ __device__ void init(int M, int N, int G_, int c_) { nM = M / BM; nN = N / BM; nwg = nM * nN; G = G_; c = c_; }
    __host__ __device__ bool next(int i, Unit& u) const {
        const long L = (long)i * G + c; if (L >= nwg) return false;
        int wgid = (int)L; { const int q = nwg / NXCD, r = nwg % NXCD, xcd = wgid % NXCD, off = wgid / NXCD; wgid = (xcd < r ? xcd * (q + 1) : r * (q + 1) + (xcd - r) * q) + off; }
        const int nig = WGM * nN, gid = wgid / nig, fm = gid * WGM, gsz = (nM - fm) < WGM ? (nM - fm) : WGM;
        u.pm = fm + ((wgid % nig) % gsz); u.pn = (wgid % nig) / gsz; return true;
    }
    __device__ __forceinline__ void a_ready(const Unit&) const {}
    __device__ __forceinline__ void done(const Unit&) const {}
};
typedef float f32x2 __attribute__((ext_vector_type(2)));
#ifdef EMU
__device__ __forceinline__ unsigned cvt_pk_bf16(float lo, float hi) { return (unsigned)emu_f2bf(lo) | ((unsigned)emu_f2bf(hi) << 16); }
inline void emu_host_tile(const Gemm& g, const Unit& u, float* C) {
    const int K = g.K; std::vector<float> a((size_t)256 * K), b((size_t)256 * K);
    for (int r = 0; r < 256; ++r) for (int k = 0; k < K; ++k) { a[(size_t)r * K + k] = emu_bf2f(g.A[(size_t)(u.pm * 256 + r) * K + k]); b[(size_t)r * K + k] = emu_bf2f(g.Bt[(size_t)(u.pn * 256 + r) * K + k]); }
    for (int r = 0; r < 256; ++r) for (int c = 0; c < 256; ++c) { const float* ap = &a[(size_t)r * K]; const float* bp = &b[(size_t)c * K]; float s0 = 0.f, s1 = 0.f, s2 = 0.f, s3 = 0.f;
        for (int k = 0; k < K; k += 4) { s0 += ap[k] * bp[k]; s1 += ap[k + 1] * bp[k + 1]; s2 += ap[k + 2] * bp[k + 2]; s3 += ap[k + 3] * bp[k + 3]; } C[r * 256 + c] = (s0 + s1) + (s2 + s3); }
}
template <class Epi, class Sched, bool ALIGN_EPI = false, bool SP2 = false>
inline void gemm_phase(unsigned char* lds, const Gemm g, const Sched& S, const Epi& E) {
    const int tid = threadIdx.x, wid = tid >> 6, lane = tid & 63, wr = wid >> 2, wc = wid & 3, fr = lane & 15, fq = lane >> 4;
    Unit cur;
    for (int ui = 0; S.next(ui, cur); ++ui) {
        __syncthreads();
        if (tid == 0) emu_host_tile(g, cur, emu::B->gemm_tile);
        __syncthreads();
        f32x4 acc[2][2][4][2];
        for (int ai = 0; ai < 2; ++ai) for (int bj = 0; bj < 2; ++bj) for (int m = 0; m < 4; ++m) for (int n = 0; n < 2; ++n) for (int e = 0; e < 4; ++e) {
            const int row = 128 * ai + 64 * wr + 16 * m + fr, col = 128 * bj + 32 * wc + (Epi::PERM ? 8 * fq + 4 * n + e : 16 * n + 4 * fq + e);
            acc[ai][bj][m][n][e] = emu::B->gemm_tile[row * 256 + col]; }
        E(acc, cur, wr, wc, fr, fq);
    }
    __syncthreads();
}
#else
__device__ __forceinline__ unsigned cvt_pk_bf16(float lo, float hi) { unsigned r; asm volatile("v_cvt_pk_bf16_f32 %0, %1, %2" : "=v"(r) : "v"(lo), "v"(hi)); return r; }
template <class Epi, class Sched, bool ALIGN_EPI = false, bool SP2 = false>
__device__ __forceinline__ void gemm_phase(PG8_LAS unsigned char* lds, const Gemm g, const Sched& S, const Epi& E) {
    const int tid = threadIdx.x, wid = __builtin_amdgcn_readfirstlane(tid >> 6), lane = tid & 63, wr = wid >> 2, wc = wid & 3, fr = lane & 15, fq = lane >> 4;
    const int K = g.K, nt = K / BK;
    unsigned voffA[2], voffB[2];
#pragma unroll
    for (int i = 0; i < 2; ++i) { int R, C; stage_rc(tid * 16 + i * 8192, R, C); const int Rb = Epi::PERM ? ((R & ~31) + perm32(R & 31)) : R;
        voffA[i] = (unsigned)(R * K + C) * 2u; voffB[i] = (unsigned)(Rb * K + C) * 2u; }
    const size_t kstep = (size_t)(BK * 2);
    const size_t hstep = (size_t)HALF * K * 2;
    const size_t tstep = 2 * hstep;
    const unsigned ldsw = (unsigned)wid * 1024u;
    const int aoff = lds_byte(wr * 64 + fr, fq * 8), boff = lds_byte(wc * 32 + fr, fq * 8);
#define PG8_SA(b, h) (((b) * 2 + (h)) * HTB)
#define PG8_SB(b, h) ((4 + (b) * 2 + (h)) * HTB)
#define PG8_STAGE(bufoff, gbase, voff) do { _Pragma("unroll") for (int _i = 0; _i < 2; ++_i) \
        __builtin_amdgcn_global_load_lds((const unsigned*)((const char*)(gbase) + (voff)[_i]), (PG8_LAS unsigned*)(lds + (bufoff) + ldsw + _i * 8192), 16, 0, 0); } while (0)
#define PG8_LDA(dst, b, h) do { _Pragma("unroll") for (int m = 0; m < 4; ++m) _Pragma("unroll") for (int k = 0; k < 2; ++k) dst[m][k] = *(const PG8_LAS bf16x8*)(lds + PG8_SA(b, h) + aoff + m * 2048 + k * 1024); } while (0)
#define PG8_LDB(dst, b, h) do { _Pragma("unroll") for (int n = 0; n < 2; ++n) _Pragma("unroll") for (int k = 0; k < 2; ++k) dst[n][k] = *(const PG8_LAS bf16x8*)(lds + PG8_SB(b, h) + boff + n * 2048 + k * 1024); } while (0)
#define PG8_MMA(ai, bj, At, Bt) do { __builtin_amdgcn_s_setprio(1); _Pragma("unroll") for (int m = 0; m < 4; ++m) _Pragma("unroll") for (int n = 0; n < 2; ++n) _Pragma("unroll") for (int k = 0; k < 2; ++k) \
        acc[ai][bj][m][n] = __builtin_amdgcn_mfma_f32_16x16x32_bf16(Bt[n][k], At[m][k], acc[ai][bj][m][n], 0, 0, 0); __builtin_amdgcn_s_setprio(0); } while (0)
#define PG8_WAIT_V(n) asm volatile("s_waitcnt vmcnt(" #n ")" ::: "memory")
#define PG8_WAIT_L(n) asm volatile("s_waitcnt lgkmcnt(" #n ")" ::: "memory")
#define PG8_BAR __builtin_amdgcn_s_barrier()
#define PG8_SCHED __builtin_amdgcn_sched_barrier(0)
    Unit cur, nxt; int ui = 0;
    if (!S.next(0, cur)) return;
    f32x4 acc[2][2][4][2];
#pragma unroll
    for (int a = 0; a < 2; ++a)
#pragma unroll
        for (int b = 0; b < 2; ++b)
#pragma unroll
            for (int m = 0; m < 4; ++m)
#pragma unroll
                for (int n = 0; n < 2; ++n) acc[a][b][m][n] = (f32x4){0.f, 0.f, 0.f, 0.f};
    bf16x8 At[4][2], B0[2][2], B1[2][2];
    const char* cA = (const char*)g.A + (size_t)cur.pm * tstep; const char* cB = (const char*)g.Bt + (size_t)cur.pn * tstep;
    S.a_ready(cur);
    if constexpr (SP2) {
        PG8_STAGE(PG8_SB(0, 0), cB, voffB); PG8_STAGE(PG8_SB(0, 1), cB + hstep, voffB); PG8_STAGE(PG8_SA(0, 0), cA, voffA); PG8_STAGE(PG8_SA(0, 1), cA + hstep, voffA);
        if (wr == 1) PG8_BAR;
        PG8_WAIT_V(2); PG8_BAR;
        PG8_STAGE(PG8_SB(1, 0), cB + kstep, voffB); PG8_STAGE(PG8_SA(1, 0), cA + kstep, voffA); PG8_STAGE(PG8_SB(1, 1), cB + hstep + kstep, voffB);
        PG8_WAIT_V(6); PG8_BAR;
    } else {
        PG8_STAGE(PG8_SB(0, 0), cB, voffB); PG8_STAGE(PG8_SA(0, 0), cA, voffA); PG8_STAGE(PG8_SB(0, 1), cB + hstep, voffB); PG8_STAGE(PG8_SA(0, 1), cA + hstep, voffA);
        if (wr == 1) PG8_BAR;
        PG8_WAIT_V(4); PG8_BAR;
        PG8_STAGE(PG8_SB(1, 0), cB + kstep, voffB); PG8_STAGE(PG8_SA(1, 0), cA + kstep, voffA); PG8_STAGE(PG8_SB(1, 1), cB + hstep + kstep, voffB);
        PG8_WAIT_V(6); PG8_BAR;
    }
    for (;;) {
        const bool has_next = S.next(ui + 1, nxt);
        const char* nA = has_next ? (const char*)g.A + (size_t)nxt.pm * tstep : cA; const char* nB = has_next ? (const char*)g.Bt + (size_t)nxt.pn * tstep : cB;
        for (int t = 0; t < nt; t += 2) {
            const bool last = (t == nt - 2);
            const char* a1 = cA + (size_t)(t + 1) * kstep;
            const char* a2 = last ? nA : cA + (size_t)(t + 2) * kstep; const char* b2 = last ? nB : cB + (size_t)(t + 2) * kstep;
            const char* a3 = a2 + kstep; const char* b3 = b2 + kstep;
            if (last && has_next) S.a_ready(nxt);
            if constexpr (SP2) {
            PG8_LDB(B0, 0, 0); PG8_LDB(B1, 0, 1); PG8_SCHED; PG8_LDA(At, 0, 0); PG8_STAGE(PG8_SA(1, 1), a1 + hstep, voffA);
            PG8_WAIT_V(8); PG8_WAIT_L(0); PG8_BAR; PG8_MMA(0, 0, At, B0); PG8_MMA(0, 1, At, B1); PG8_BAR; PG8_SCHED;
            PG8_LDA(At, 0, 1); PG8_STAGE(PG8_SB(0, 0), b2, voffB); PG8_STAGE(PG8_SB(0, 1), b2 + hstep, voffB); PG8_STAGE(PG8_SA(0, 0), a2, voffA);
            PG8_WAIT_V(8); PG8_WAIT_L(0); PG8_BAR; PG8_MMA(1, 0, At, B0); PG8_MMA(1, 1, At, B1); PG8_BAR; PG8_SCHED;
            PG8_LDB(B0, 1, 0); PG8_LDB(B1, 1, 1); PG8_SCHED; PG8_LDA(At, 1, 0); PG8_STAGE(PG8_SA(0, 1), a2 + hstep, voffA);
            PG8_WAIT_V(8); PG8_WAIT_L(0); PG8_BAR; PG8_MMA(0, 0, At, B0); PG8_MMA(0, 1, At, B1); PG8_BAR; PG8_SCHED;
            PG8_LDA(At, 1, 1); PG8_STAGE(PG8_SB(1, 0), b3, voffB); PG8_STAGE(PG8_SB(1, 1), b3 + hstep, voffB); PG8_STAGE(PG8_SA(1, 0), a3, voffA);
            PG8_WAIT_V(8); PG8_WAIT_L(0); PG8_BAR; PG8_MMA(1, 0, At, B0); PG8_MMA(1, 1, At, B1); PG8_BAR; PG8_SCHED;
            } else {
            PG8_LDB(B0, 0, 0); PG8_SCHED; PG8_LDA(At, 0, 0); PG8_STAGE(PG8_SA(1, 1), a1 + hstep, voffA);
            PG8_WAIT_L(8); PG8_BAR; PG8_WAIT_L(0); PG8_MMA(0, 0, At, B0); PG8_BAR; PG8_SCHED;
            PG8_LDB(B1, 0, 1); PG8_STAGE(PG8_SB(0, 0), b2, voffB);
            PG8_BAR; PG8_WAIT_L(0); PG8_MMA(0, 1, At, B1); PG8_BAR;
            PG8_LDA(At, 0, 1); PG8_STAGE(PG8_SA(0, 0), a2, voffA);
            PG8_BAR; PG8_WAIT_L(0); PG8_MMA(1, 0, At, B0); PG8_BAR; PG8_SCHED;
            PG8_STAGE(PG8_SB(0, 1), b2 + hstep, voffB);
            PG8_WAIT_V(6); PG8_BAR; PG8_MMA(1, 1, At, B1); PG8_BAR;
            PG8_LDB(B0, 1, 0); PG8_SCHED; PG8_LDA(At, 1, 0); PG8_STAGE(PG8_SA(0, 1), a2 + hstep, voffA);
            PG8_WAIT_L(8); PG8_BAR; PG8_WAIT_L(0); PG8_MMA(0, 0, At, B0); PG8_BAR; PG8_SCHED;
            PG8_LDB(B1, 1, 1); PG8_STAGE(PG8_SB(1, 0), b3, voffB);
            PG8_BAR; PG8_WAIT_L(0); PG8_MMA(0, 1, At, B1); PG8_BAR;
            PG8_LDA(At, 1, 1); PG8_STAGE(PG8_SA(1, 0), a3, voffA);
            PG8_BAR; PG8_WAIT_L(0); PG8_MMA(1, 0, At, B0); PG8_BAR; PG8_SCHED;
            PG8_STAGE(PG8_SB(1, 1), b3 + hstep, voffB);
            PG8_WAIT_V(6); PG8_BAR; PG8_MMA(1, 1, At, B1); PG8_BAR;
            }
        }
        if constexpr (ALIGN_EPI) { if (wr == 0) PG8_BAR; }
        if constexpr (!Epi::AFTER_DRAIN) { E(acc, cur, wr, wc, fr, fq); S.done(cur); }
        if (!has_next) break;
#pragma unroll
        for (int a = 0; a < 2; ++a)
#pragma unroll
            for (int b = 0; b < 2; ++b)
#pragma unroll
                for (int m = 0; m < 4; ++m)
#pragma unroll
                    for (int n = 0; n < 2; ++n) acc[a][b][m][n] = (f32x4){0.f, 0.f, 0.f, 0.f};
        cur = nxt; cA = nA; cB = nB; ++ui;
        if constexpr (ALIGN_EPI) { if (wr == 1) PG8_BAR; }
    }
    PG8_WAIT_V(0);
    if constexpr (!ALIGN_EPI) { if (wr == 0) PG8_BAR; }
    PG8_BAR;
    if constexpr (Epi::AFTER_DRAIN) { E.fused(acc, cur, wr, wc, fr, fq, lds, wid, lane); S.done(cur); }
#undef PG8_SA
#undef PG8_SB
#undef PG8_STAGE
#undef PG8_LDA
#undef PG8_LDB
#undef PG8_MMA
#undef PG8_WAIT_V
#undef PG8_WAIT_L
#undef PG8_BAR
#undef PG8_SCHED
}
#endif
}
#ifndef PG8_SP2
#define PG8_SP2 true
#endif
#ifndef PG8_ALIGN
#define PG8_ALIGN true
#endif

#ifndef CFG_BATCH
#define CFG_BATCH 32
#endif
#ifndef CFG_SEQ
#define CFG_SEQ 2048
#endif
#ifndef CFG_DECB
#define CFG_DECB 32
#endif
#ifndef CFG_PAST
#define CFG_PAST 4096
#endif
#ifndef PROBE_DUP
#define PROBE_DUP 0
#endif
#ifndef MK_N_LAUNCHES
#define MK_N_LAUNCHES 1
#endif
constexpr int NWAVES = 8, NPHASE = 9;
constexpr int BATCH = CFG_BATCH, SEQ = CFG_SEQ, DECB = CFG_DECB, DSEQ = 32, PAST = CFG_PAST;
constexpr int D = 1024, NMETA = 16, DIN = 2048, CONVD = 4096, NSH = 32, NGRP = 8, DST = 128, NAH = 8, DFF = 2816;
constexpr int MP = BATCH * SEQ, MS = DECB * DSEQ, MMAIN = MP + MS, MALL = MMAIN + 256;
constexpr int NPROJ = 45 * 256, LEXT = NMETA + SEQ;
static_assert(MP % 256 == 0 && MS % 256 == 0 && SEQ % 128 == 0 && PAST % 64 == 0, "row panels");
constexpr float EPS = 1e-6f, LOG2E = 1.4426950408889634f, LN2 = 0.6931471805599453f, QSCALE = 0.125f * LOG2E;
constexpr size_t OUT_Y = 0, OUT_YS = OUT_Y + (size_t)MP * D, OUT_KP = OUT_YS + (size_t)MS * D, OUT_VP = OUT_KP + (size_t)BATCH * LEXT * 1024,
    OUT_CP = OUT_VP + (size_t)BATCH * LEXT * 1024, OUT_SP = OUT_CP + (size_t)BATCH * 3 * CONVD, OUT_KS = OUT_SP + (size_t)BATCH * NSH * 64 * DST,
    OUT_VS = OUT_KS + (size_t)MS * 1024, OUT_CS = OUT_VS + (size_t)MS * 1024, OUT_SS = OUT_CS + (size_t)DECB * 3 * CONVD, OUT_END = OUT_SS + (size_t)DECB * NSH * 64 * DST;
constexpr size_t MiB = 1u << 20;
constexpr size_t al(size_t x) { return (x + MiB - 1) & ~(MiB - 1); }
constexpr size_t WS_CTL = 0, CTL_ZERO_BYTES = MiB;
constexpr size_t WS_WIN = MiB, WS_WSSD = WS_WIN + al((size_t)NPROJ * D * 2), WS_WATT = WS_WSSD + al((size_t)D * DIN * 2), WS_WO = WS_WATT + al((size_t)D * D * 2),
    WS_WFF = WS_WO + al((size_t)D * D * 2), WS_WFF2 = WS_WFF + al((size_t)2 * DFF * D * 2), WS_XN = WS_WFF2 + al((size_t)D * DFF * 2);
constexpr size_t WS_Z = WS_XN + al((size_t)MALL * D * 2), WS_XBC = WS_Z + al((size_t)MALL * DIN * 2), WS_DT = WS_XBC + al((size_t)MALL * CONVD * 2), WS_Q = WS_DT + al((size_t)MALL * 32 * 4),
    WS_K = WS_Q + al((size_t)MALL * D * 2), WS_V = WS_K + al((size_t)MALL * D * 2), WS_GS = WS_V + al((size_t)MALL * D * 2), WS_GA = WS_GS + al((size_t)MALL * D * 2), WS_U = WS_GA + al((size_t)MALL * D * 2), WS_O = WS_U + al((size_t)MALL * DIN * 2), WS_END = WS_O + al((size_t)MALL * D * 2);
constexpr size_t WS_MIX = WS_XBC, WS_T1 = WS_XBC + (size_t)MMAIN * D * 2, WS_TMP = WS_T1 + (size_t)MMAIN * D * 4, WS_HB = WS_XBC, WS_T2 = WS_Z;
static_assert(WS_TMP + (size_t)MMAIN * D * 2 <= WS_DT && WS_HB + (size_t)MMAIN * DFF * 2 <= WS_DT && WS_T2 + (size_t)MMAIN * D * 4 <= WS_XBC, "overlays");
static_assert(WS_END <= ((size_t)2048 << 20), "workspace map fits 2 GiB");
constexpr int CW_TMO = 0, CW_BAR = 4096;
constexpr int RING_OFF = 0, RING_BYTES = 131072, LDSCTL_OFF = RING_BYTES, MISC_OFF = LDSCTL_OFF + 320, LDS_BYTES = 147456;

typedef unsigned short bf16;
typedef unsigned v4u __attribute__((ext_vector_type(4)));
typedef unsigned v2u __attribute__((ext_vector_type(2)));
typedef float f32x4 __attribute__((ext_vector_type(4)));
typedef float f32x16 __attribute__((ext_vector_type(16)));
typedef short bf16x8 __attribute__((ext_vector_type(8)));
typedef short s16x4 __attribute__((ext_vector_type(4)));

#ifdef EMU
#define DEV inline
DEV float EXP2(float x) { return exp2f(x); }
DEV float LOG2(float x) { return log2f(x); }
DEV float RCP(float x) { return 1.0f / x; }
DEV float RSQ(float x) { return 1.0f / sqrtf(x); }
DEV unsigned pk2(float lo, float hi) { return (unsigned)emu_f2bf(lo) | ((unsigned)emu_f2bf(hi) << 16); }
DEV f32x16 mfma32(bf16x8 a, bf16x8 b, f32x16 c) { return emu_mfma32(a, b, c); }
DEV float uaf(unsigned u) { float f; memcpy(&f, &u, 4); return f; }
#define LDS_WAIT() do {} while (0)
#define SCHED_BAR() do {} while (0)
DEV int opaque_v(int x) { return x; }
#define VM_WAIT() do {} while (0)
#else
#define DEV __device__ __forceinline__
DEV float EXP2(float x) { return __builtin_amdgcn_exp2f(x); }
DEV float LOG2(float x) { return __builtin_amdgcn_logf(x); }
DEV float RCP(float x) { return __builtin_amdgcn_rcpf(x); }
DEV float RSQ(float x) { return __builtin_amdgcn_rsqf(x); }
typedef float f32x2_t __attribute__((ext_vector_type(2))); typedef __bf16 bf16x2_t __attribute__((ext_vector_type(2)));
DEV unsigned pk2(float lo, float hi) { f32x2_t v = {lo, hi}; bf16x2_t b = __builtin_convertvector(v, bf16x2_t); return __builtin_bit_cast(unsigned, b); }
DEV f32x16 mfma32(bf16x8 a, bf16x8 b, f32x16 c) { return __builtin_amdgcn_mfma_f32_32x32x16_bf16(a, b, c, 0, 0, 0); }
DEV float uaf(unsigned u) { return __uint_as_float(u); }
#define LDS_WAIT() asm volatile("s_waitcnt lgkmcnt(0)" ::: "memory")
#define SCHED_BAR() __builtin_amdgcn_sched_barrier(0)
DEV int opaque_v(int x) { asm volatile("" : "+v"(x)); return x; }
#define VM_WAIT() asm volatile("s_waitcnt vmcnt(0)" ::: "memory")
#endif
DEV float bflo(unsigned w) { return uaf(w << 16); }
DEV float bfhi(unsigned w) { return uaf(w & 0xffff0000u); }
DEV float bf2f(bf16 b) { return uaf((unsigned)b << 16); }
DEV float sigmoidf_(float x) { return RCP(1.0f + EXP2(-x * LOG2E)); }
DEV float siluf_(float x) { return x * sigmoidf_(x); }
DEV float softplusf_(float x) { return fmaxf(x, 0.f) + LN2 * LOG2(1.0f + EXP2(-fabsf(x) * LOG2E)); }
DEV int crow(int reg, int h) { return (reg & 3) + 8 * (reg >> 2) + 4 * h; }
DEV float wave_sum(float v) {
#pragma unroll
    for (int o = 1; o < 64; o <<= 1) v += __shfl_xor(v, o);
    return v;
}
DEV bf16x8 pack_step(const f32x16& x, int s) {
    v4u p; p.x = pk2(x[8 * s], x[8 * s + 1]); p.y = pk2(x[8 * s + 2], x[8 * s + 3]); p.z = pk2(x[8 * s + 4], x[8 * s + 5]); p.w = pk2(x[8 * s + 6], x[8 * s + 7]);
    return __builtin_bit_cast(bf16x8, p);
}
DEV bf16x8 rd16(const LAS unsigned char* p) { return *(const LAS bf16x8*)p; }
DEV bf16x8 rd8x2(const LAS unsigned char* p) {
    const v2u a = *(const LAS v2u*)p, b = *(const LAS v2u*)(p + 16); v4u r; r.x = a.x; r.y = a.y; r.z = b.x; r.w = b.y; return __builtin_bit_cast(bf16x8, r);
}

struct Frame {
    LAS unsigned char* lds;
    unsigned* ctl;
    int tid, lane, wave, G, vcu;
    const float* const* in; float* out; unsigned char* ws;
#define WSP(T, NAME, OFF) DEV T* NAME() const { return (T*)(ws + OFF); }
    WSP(bf16, WinT, WS_WIN) WSP(bf16, WssdT, WS_WSSD) WSP(bf16, WattT, WS_WATT) WSP(bf16, WoT, WS_WO) WSP(bf16, WffT, WS_WFF) WSP(bf16, Wff2T, WS_WFF2)
    WSP(bf16, XN, WS_XN) WSP(bf16, Z, WS_Z) WSP(bf16, XBC, WS_XBC) WSP(bf16, Q, WS_Q) WSP(bf16, K, WS_K) WSP(bf16, V, WS_V) WSP(bf16, GS, WS_GS) WSP(bf16, GA, WS_GA) WSP(bf16, U, WS_U) WSP(bf16, O, WS_O)
    WSP(bf16, MIX, WS_MIX) WSP(bf16, TMP, WS_TMP) WSP(bf16, HB, WS_HB) WSP(float, DT, WS_DT) WSP(float, T1, WS_T1) WSP(float, T2, WS_T2)
#undef WSP
};
enum { I_XP = 0, I_XS, I_CK, I_CV, I_SSM, I_SCONV, I_META, I_RELB, I_NPRE, I_WIN, I_CONVW, I_CONVB, I_DTB, I_ALOG, I_DSKIP, I_SSDN, I_WSSD, I_LQ1, I_LK1, I_LQ2, I_LK2, I_SUBLN, I_WATT, I_WO, I_NPOST, I_NFFN, I_WFF, I_WFF2, I_NFFNP };

DEV void p0_transpose_item(const float* W, int K, int N, int src_col0, bf16* WT, int dst_row0, LAS float* scr, int kb, int lane) {
    const int k0 = 64 * kb;
#pragma unroll 8
    for (int i = 0; i < 32; ++i) { const int kk = 2 * i + (lane >> 5); scr[kk * 33 + (lane & 31)] = src_col0 >= 0 ? W[(size_t)(k0 + kk) * N + src_col0 + (lane & 31)] : 0.f; }
    WAVE_LDS_SYNC();
    const int c = lane & 7;
#pragma unroll
    for (int j = 0; j < 4; ++j) { const int n = (lane >> 3) + 8 * j; const LAS float* s = scr + (8 * c) * 33 + n;
        v4u o; o.x = pk2(s[0 * 33], s[1 * 33]); o.y = pk2(s[2 * 33], s[3 * 33]); o.z = pk2(s[4 * 33], s[5 * 33]); o.w = pk2(s[6 * 33], s[7 * 33]);
        *(v4u*)(WT + (size_t)(dst_row0 + n) * K + k0 + 8 * c) = o; }
    WAVE_LDS_SYNC();
}
DEV void rms_row_to_bf16(const float* xrow, const float* gain, bf16* orow, int lane) {
    unsigned long long* o8 = (unsigned long long*)orow + lane;
    if (!xrow) {
#pragma unroll
        for (int j = 0; j < 4; ++j) o8[64 * j] = 0ull;
        return; }
    const f32x4* xr = (const f32x4*)xrow + lane; const f32x4* gr = (const f32x4*)gain + lane;
    f32x4 v[4]; float s = 0.f;
#pragma unroll
    for (int j = 0; j < 4; ++j) { v[j] = xr[64 * j]; s += (v[j].x * v[j].x + v[j].y * v[j].y) + (v[j].z * v[j].z + v[j].w * v[j].w); }
    const float r = RSQ(wave_sum(s) * (1.f / D) + EPS);
#pragma unroll
    for (int j = 0; j < 4; ++j) { const f32x4 g = gr[64 * j]; o8[64 * j] = (unsigned long long)pk2(v[j].x * r * g.x, v[j].y * r * g.y) | ((unsigned long long)pk2(v[j].z * r * g.z, v[j].w * r * g.w) << 32); }
}
DEV const float* x_row_ptr(const Frame& F, int m) {
    if (m < MP) return F.in[I_XP] + (size_t)m * D;
    if (m < MMAIN) return F.in[I_XS] + (size_t)(m - MP) * D;
    if (m < MMAIN + NMETA) return F.in[I_META] + (size_t)(m - MMAIN) * D;
    return nullptr;
}
DEV void p0_prologue(Frame& F) {
    LAS float* scr = (LAS float*)(F.lds + RING_OFF + F.wave * 16384);
    const int gw = F.vcu * NWAVES + F.wave, NGW = F.G * NWAVES;
    constexpr int I_IN = (D / 64) * (NPROJ / 32), I_SSD = (DIN / 64) * (D / 32), I_ATT = (D / 64) * (D / 32), I_O = I_ATT, I_FF = (D / 64) * (2 * DFF / 32), I_FF2 = (DFF / 64) * (D / 32);
    constexpr int NITEMS = I_IN + I_SSD + I_ATT + I_O + I_FF + I_FF2;
    for (int it = gw; it < NITEMS; it += NGW) {
        int r = it;
        if (r < I_IN) {
            const int nblk = NPROJ / 32, kb = r / nblk, n0 = 32 * (r % nblk);
            const int src = n0 < 6144 ? n0 : (n0 < 11264 ? n0 + 32 : (n0 == 11264 ? 6144 : -1));
            p0_transpose_item(F.in[I_WIN], D, 11296, src, F.WinT(), n0, scr, kb, F.lane); continue; } r -= I_IN;
        if (r < I_SSD) { const int nblk = D / 32; p0_transpose_item(F.in[I_WSSD], DIN, D, 32 * (r % nblk), F.WssdT(), 32 * (r % nblk), scr, r / nblk, F.lane); continue; } r -= I_SSD;
        if (r < I_ATT) { const int nblk = D / 32; p0_transpose_item(F.in[I_WATT], D, D, 32 * (r % nblk), F.WattT(), 32 * (r % nblk), scr, r / nblk, F.lane); continue; } r -= I_ATT;
        if (r < I_O) { const int nblk = D / 32; p0_transpose_item(F.in[I_WO], D, D, 32 * (r % nblk), F.WoT(), 32 * (r % nblk), scr, r / nblk, F.lane); continue; } r -= I_O;
        if (r < I_FF) {
            const int nblk = 2 * DFF / 32, kb = r / nblk, n0 = 32 * (r % nblk), t = n0 / 256, w = n0 % 256;
            const int src = w < 128 ? 128 * t + w : DFF + 128 * t + (w - 128);
            p0_transpose_item(F.in[I_WFF], D, 2 * DFF, src, F.WffT(), n0, scr, kb, F.lane); continue; } r -= I_FF;
        { const int nblk = D / 32; p0_transpose_item(F.in[I_WFF2], DFF, D, 32 * (r % nblk), F.Wff2T(), 32 * (r % nblk), scr, r / nblk, F.lane); }
    }
    for (int m = gw; m < MALL; m += NGW) rms_row_to_bf16(x_row_ptr(F, m), F.in[I_NPRE], F.XN() + (size_t)m * D, F.lane);
}

namespace pg8 {
struct EpiProj {
    static constexpr bool PERM = true, AFTER_DRAIN = false;
    bf16 *Z, *XBC, *Q, *K, *V, *GS, *GA; float* DT; const float* dtb; float* out;
    __device__ __forceinline__ void operator()(const f32x4 (&acc)[2][2][4][2], const Unit& u, int wr, int wc, int fr, int fq) const {
        const int t = u.pn;
        if (t == 44) {
            if (wc != 0) return;
            const f32x4 b0 = *(const f32x4*)(dtb + 8 * fq), b1 = *(const f32x4*)(dtb + 8 * fq + 4);
#pragma unroll
            for (int ai = 0; ai < 2; ++ai)
#pragma unroll
                for (int m = 0; m < 4; ++m) { const int r = u.pm * 256 + ai * 128 + wr * 64 + m * 16 + fr; f32x4 v0 = acc[ai][0][m][0] + b0, v1 = acc[ai][0][m][1] + b1;
#pragma unroll
                    for (int e = 0; e < 4; ++e) { v0[e] = softplusf_(v0[e]); v1[e] = softplusf_(v1[e]); }
                    *(f32x4*)(DT + (size_t)r * 32 + 8 * fq) = v0; *(f32x4*)(DT + (size_t)r * 32 + 8 * fq + 4) = v1; }
            return; }
        bf16* base; int ld, c0; int kind;
        if (t < 8) { base = Z; ld = DIN; c0 = 256 * t; kind = 0; }
        else if (t < 24) { base = XBC; ld = CONVD; c0 = 256 * (t - 8); kind = 1; }
        else if (t < 28) { base = Q; ld = D; c0 = 256 * (t - 24); kind = 2; }
        else if (t < 32) { base = K; ld = D; c0 = 256 * (t - 28); kind = 3; }
        else if (t < 36) { base = V; ld = D; c0 = 256 * (t - 32); kind = 4; }
        else if (t < 40) { base = GS; ld = D; c0 = 256 * (t - 36); kind = 5; }
        else { base = GA; ld = D; c0 = 256 * (t - 40); kind = 5; }
#pragma unroll
        for (int ai = 0; ai < 2; ++ai)
#pragma unroll
            for (int m = 0; m < 4; ++m) { const int r = u.pm * 256 + ai * 128 + wr * 64 + m * 16 + fr;
#pragma unroll
                for (int bj = 0; bj < 2; ++bj) { const int col = c0 + bj * 128 + wc * 32 + 8 * fq; f32x4 v0 = acc[ai][bj][m][0], v1 = acc[ai][bj][m][1];
                    if (kind == 1) {
                        float* dst = nullptr;
                        if (r < MP) { const int tt = r % SEQ; if (tt >= SEQ - 3) dst = out + OUT_CP + ((size_t)(r / SEQ) * 3 + (tt - (SEQ - 3))) * CONVD + col; }
                        else if (r < MMAIN) { const int tt = (r - MP) % DSEQ; if (tt >= DSEQ - 3) dst = out + OUT_CS + ((size_t)((r - MP) / DSEQ) * 3 + (tt - (DSEQ - 3))) * CONVD + col; }
                        if (dst) { *(f32x4*)dst = v0; *(f32x4*)(dst + 4) = v1; } }
                    if (kind == 3 || kind == 4) {
                        const size_t op = kind == 3 ? OUT_KP : OUT_VP, os = kind == 3 ? OUT_KS : OUT_VS;
                        if (r < MP) { float* dst = out + op + ((size_t)(r / SEQ) * LEXT + NMETA + (r % SEQ)) * 1024 + col; *(f32x4*)dst = v0; *(f32x4*)(dst + 4) = v1; }
                        else if (r < MMAIN) { float* dst = out + os + (size_t)(r - MP) * 1024 + col; *(f32x4*)dst = v0; *(f32x4*)(dst + 4) = v1; }
                        else if (r < MMAIN + NMETA) { for (int b = 0; b < BATCH; ++b) { float* dst = out + op + ((size_t)b * LEXT + (r - MMAIN)) * 1024 + col; *(f32x4*)dst = v0; *(f32x4*)(dst + 4) = v1; } } }
                    if (kind == 2) { v0 = v0 * QSCALE; v1 = v1 * QSCALE; }
                    if (kind == 5) {
#pragma unroll
                        for (int e = 0; e < 4; ++e) { v0[e] = sigmoidf_(v0[e]); v1[e] = sigmoidf_(v1[e]); } }
                    u32x4 w; w.x = cvt_pk_bf16(v0[0], v0[1]); w.y = cvt_pk_bf16(v0[2], v0[3]); w.z = cvt_pk_bf16(v1[0], v1[1]); w.w = cvt_pk_bf16(v1[2], v1[3]);
                    *(u32x4*)(base + (size_t)r * ld + col) = w; } }
    }
};
template <int SECOND> struct EpiGate {
    static constexpr bool PERM = true, AFTER_DRAIN = false;
    const bf16* G; const bf16* T; bf16* O;
    __device__ __forceinline__ void operator()(const f32x4 (&acc)[2][2][4][2], const Unit& u, int wr, int wc, int fr, int fq) const {
#pragma unroll
        for (int ai = 0; ai < 2; ++ai)
#pragma unroll
            for (int m = 0; m < 4; ++m) { const int r = u.pm * 256 + ai * 128 + wr * 64 + m * 16 + fr;
#pragma unroll
                for (int bj = 0; bj < 2; ++bj) { const size_t off = (size_t)r * D + u.pn * 256 + bj * 128 + wc * 32 + 8 * fq;
                    const u32x4 g = *(const u32x4*)(G + off); const f32x4 a0 = acc[ai][bj][m][0], a1 = acc[ai][bj][m][1];
                    float v[8] = {a0[0] * bflo(g.x), a0[1] * bfhi(g.x), a0[2] * bflo(g.y), a0[3] * bfhi(g.y), a1[0] * bflo(g.z), a1[1] * bfhi(g.z), a1[2] * bflo(g.w), a1[3] * bfhi(g.w)};
                    if (SECOND) { const u32x4 tv = *(const u32x4*)(T + off);
                        v[0] += bflo(tv.x); v[1] += bfhi(tv.x); v[2] += bflo(tv.y); v[3] += bfhi(tv.y); v[4] += bflo(tv.z); v[5] += bfhi(tv.z); v[6] += bflo(tv.w); v[7] += bfhi(tv.w); }
                    u32x4 w; w.x = cvt_pk_bf16(v[0], v[1]); w.y = cvt_pk_bf16(v[2], v[3]); w.z = cvt_pk_bf16(v[4], v[5]); w.w = cvt_pk_bf16(v[6], v[7]);
                    *(u32x4*)(O + off) = w; } }
    }
};
struct EpiF32 {
    static constexpr bool PERM = false, AFTER_DRAIN = false;
    float* O; int ldc;
    __device__ __forceinline__ void operator()(const f32x4 (&acc)[2][2][4][2], const Unit& u, int wr, int wc, int fr, int fq) const {
#pragma unroll
        for (int ai = 0; ai < 2; ++ai)
#pragma unroll
            for (int m = 0; m < 4; ++m) { float* rowp = O + (size_t)(u.pm * 256 + ai * 128 + wr * 64 + m * 16 + fr) * ldc + u.pn * 256 + wc * 32 + 4 * fq;
#pragma unroll
                for (int bj = 0; bj < 2; ++bj)
#pragma unroll
                    for (int n = 0; n < 2; ++n) *(f32x4*)(rowp + bj * 128 + n * 16) = acc[ai][bj][m][n]; }
    }
};
struct EpiSwiglu {
    static constexpr bool PERM = true, AFTER_DRAIN = false;
    bf16* O;
    __device__ __forceinline__ void operator()(const f32x4 (&acc)[2][2][4][2], const Unit& u, int wr, int wc, int fr, int fq) const {
#pragma unroll
        for (int ai = 0; ai < 2; ++ai)
#pragma unroll
            for (int m = 0; m < 4; ++m) { const int r = u.pm * 256 + ai * 128 + wr * 64 + m * 16 + fr;
                const f32x4 g0 = acc[ai][0][m][0], g1 = acc[ai][0][m][1], u0 = acc[ai][1][m][0], u1 = acc[ai][1][m][1]; float v[8];
#pragma unroll
                for (int e = 0; e < 4; ++e) { v[e] = siluf_(g0[e]) * u0[e]; v[4 + e] = siluf_(g1[e]) * u1[e]; }
                u32x4 w; w.x = cvt_pk_bf16(v[0], v[1]); w.y = cvt_pk_bf16(v[2], v[3]); w.z = cvt_pk_bf16(v[4], v[5]); w.w = cvt_pk_bf16(v[6], v[7]);
                *(u32x4*)(O + (size_t)r * DFF + u.pn * 128 + wc * 32 + 8 * fq) = w; }
    }
};
}
constexpr int S_XT = 0, S_BM = 36864, S_BT = S_BM + 17408, S_CM = S_BT + 18432, S_ZU = S_CM + 17408, S_ACS = S_ZU + 33792, S_DTV = S_ACS + 1024, S_WSC = S_DTV + 1024, S_SSQ = S_WSC + 1024, S_END = S_SSQ + 2048;
constexpr int XT_P = 144, BM_P = 272, ZU_P = 528;
static_assert(S_END <= RING_BYTES, "SSD LDS map");
struct SsdChunk { int row0; int t0, t1, halo; bool store_y; };

DEV v4u ssd_raw_row(const Frame& F, const SsdChunk& ck, int sb, int tp, int col) {
    const v4u zero = {0u, 0u, 0u, 0u};
    if (tp >= ck.t0 && tp < ck.t1) return *(const v4u*)(F.XBC() + (int)(ck.row0 + tp) * CONVD + col);
    if (tp < ck.t0 && tp >= ck.t0 - 3) {
        if (ck.halo == 1) return *(const v4u*)(F.XBC() + (int)(ck.row0 + tp) * CONVD + col);
        if (ck.halo == 2) return *(const v4u*)(F.XBC() + (int)(MMAIN + NMETA + (tp - ck.t0)) * CONVD + col);
        if (ck.halo == 3) { const float* s = F.in[I_SCONV] + ((int)sb * 3 + (3 + tp - ck.t0)) * CONVD + col; const f32x4 a = *(const f32x4*)s, b = *(const f32x4*)(s + 4);
            v4u r; r.x = pk2(a.x, a.y); r.y = pk2(a.z, a.w); r.z = pk2(b.x, b.y); r.w = pk2(b.z, b.w); return r; }
    }
    return zero;
}
DEV unsigned hw_(unsigned w, int h) { return h ? (w >> 16) : (w & 0xffffu); }

DEV void ssd_chunk(Frame& F, const SsdChunk& ck, int sb, int g, f32x16 (&hacc)[4]) {
    LAS unsigned char* L = F.lds + RING_OFF;
    const int lane = opaque_v(F.lane), tid = opaque_v(F.tid), w = F.wave, l31 = lane & 31, hh = lane >> 5, h = w >> 1, j = w & 1;
    __syncthreads();
    if (w < 4) {
        const int t = lane; const bool valid = t >= ck.t0 && t < ck.t1;
        const float dtv = valid ? F.DT()[(int)(ck.row0 + t) * 32 + 4 * g + w] : 0.f;
        const float a = -EXP2(F.in[I_ALOG][4 * g + w] * LOG2E);
        float x = dtv * a;
#pragma unroll
        for (int d = 1; d < 64; d <<= 1) { const float v = __shfl_up(x, d); if (lane >= d) x += v; }
        const float last = __shfl(x, 63);
        ((LAS float*)(L + S_ACS))[w * 64 + t] = x; ((LAS float*)(L + S_DTV))[w * 64 + t] = dtv; ((LAS float*)(L + S_WSC))[w * 64 + t] = EXP2((last - x) * LOG2E) * dtv;
    }
    SCHED_BAR();
    {
        const int cg = lane, to = w;
        const int col = cg < 32 ? 256 * g + 8 * cg : (cg < 48 ? 2048 + 128 * g + 8 * (cg - 32) : 3072 + 128 * g + 8 * (cg - 48));
        v4u raw[11];
#pragma unroll
        for (int i = 0; i < 11; ++i) raw[i] = ssd_raw_row(F, ck, sb, 8 * to - 3 + i, col);
        const float* cw = F.in[I_CONVW] + col; const float* cb = F.in[I_CONVB] + col;
        unsigned pk[8][4];
#pragma unroll
        for (int e2 = 0; e2 < 4; ++e2) {
            float wgt[4][2], bias[2];
#pragma unroll
            for (int i = 0; i < 4; ++i) { wgt[i][0] = cw[i * CONVD + 2 * e2]; wgt[i][1] = cw[i * CONVD + 2 * e2 + 1]; }
            bias[0] = cb[2 * e2]; bias[1] = cb[2 * e2 + 1];
#pragma unroll
            for (int tt = 0; tt < 8; ++tt) { float a0 = bias[0], a1 = bias[1];
#pragma unroll
                for (int i = 0; i < 4; ++i) { const unsigned rw = raw[tt + i][e2]; a0 += wgt[i][0] * bflo(rw); a1 += wgt[i][1] * bfhi(rw); }
                pk[tt][e2] = pk2(siluf_(a0), siluf_(a1)); }
            SCHED_BAR();
        }
        if (cg < 48) {
            LAS unsigned char* base = cg < 32 ? L + S_XT + (8 * cg) * XT_P : L + S_BT + (8 * (cg - 32)) * XT_P;
#pragma unroll
            for (int e = 0; e < 8; ++e) { v4u o;
                o.x = hw_(pk[0][e >> 1], e & 1) | (hw_(pk[1][e >> 1], e & 1) << 16); o.y = hw_(pk[2][e >> 1], e & 1) | (hw_(pk[3][e >> 1], e & 1) << 16);
                o.z = hw_(pk[4][e >> 1], e & 1) | (hw_(pk[5][e >> 1], e & 1) << 16); o.w = hw_(pk[6][e >> 1], e & 1) | (hw_(pk[7][e >> 1], e & 1) << 16);
                *(LAS v4u*)(base + e * XT_P + 16 * to) = o; }
        }
        if (cg >= 32) {
            LAS unsigned char* base = cg < 48 ? L + S_BM + 16 * (cg - 32) : L + S_CM + 16 * (cg - 48);
#pragma unroll
            for (int tt = 0; tt < 8; ++tt) { v4u o; o.x = pk[tt][0]; o.y = pk[tt][1]; o.z = pk[tt][2]; o.w = pk[tt][3]; *(LAS v4u*)(base + (8 * to + tt) * BM_P) = o; }
        }
    }
    SCHED_BAR();
    {
        const int t = tid >> 3, seg = tid & 7; const bool valid = ck.store_y && t >= ck.t0 && t < ck.t1;
        const v4u zero = {0u, 0u, 0u, 0u};
#pragma unroll
        for (int i = 0; i < 4; ++i) *(LAS v4u*)(L + S_ZU + t * ZU_P + seg * 64 + 16 * i) = valid ? *(const v4u*)(F.Z() + (int)(ck.row0 + t) * DIN + 256 * g + 32 * seg + 8 * i) : zero;
    }
    __syncthreads();
    const LAS float* ACS = (const LAS float*)(L + S_ACS) + h * 64; const LAS float* DTV = (const LAS float*)(L + S_DTV) + h * 64; const LAS float* WSC = (const LAS float*)(L + S_WSC) + h * 64;
    const LAS float* acs_l = ACS + l31;
    const LAS float* acs_h = ACS + 4 * hh;  const LAS float* dtv_h = DTV + 4 * hh;
    const LAS float* wsc_h = WSC + 8 * hh;
    const LAS unsigned char* cm4 = L + S_CM + l31 * BM_P + 8 * hh;
    const LAS unsigned char* cm8 = L + S_CM + l31 * BM_P + 16 * hh;
    const LAS unsigned char* bm8 = L + S_BM + l31 * BM_P + 16 * hh;
    const LAS unsigned char* xt4 = L + S_XT + (64 * h + 32 * j + l31) * XT_P + 8 * hh;
    const LAS unsigned char* xt8 = L + S_XT + (64 * h + 32 * j + l31) * XT_P + 16 * hh;
    const LAS unsigned char* bt8 = L + S_BT + l31 * XT_P + 16 * hh;
    f32x16 yacc[2];
#pragma unroll
    for (int tb = 0; tb < 2; ++tb)
#pragma unroll
        for (int r = 0; r < 16; ++r) yacc[tb][r] = 0.f;
#pragma unroll
    for (int nb = 0; nb < 4; ++nb)
#pragma unroll
        for (int ss = 0; ss < 2; ++ss) { const bf16x8 a = pack_step(hacc[nb], ss);
#pragma unroll
            for (int tb = 0; tb < 2; ++tb) { const bf16x8 b = rd8x2(cm4 + 32 * tb * BM_P + (32 * nb + 16 * ss) * 2); yacc[tb] = mfma32(a, b, yacc[tb]); }
            SCHED_BAR(); }
    float acs_t[2];
#pragma unroll
    for (int tb = 0; tb < 2; ++tb) { acs_t[tb] = acs_l[32 * tb]; const float e = EXP2(acs_t[tb] * LOG2E);
#pragma unroll
        for (int r = 0; r < 16; ++r) yacc[tb][r] *= e; }
    const int dl = l31 - 4 * hh;
#pragma unroll
    for (int tile = 0; tile < 3; ++tile) { const int sb2 = tile == 2 ? 1 : 0, tb = tile == 0 ? 0 : 1;
        SCHED_BAR();
        f32x16 gt;
#pragma unroll
        for (int r = 0; r < 16; ++r) gt[r] = 0.f;
#pragma unroll
        for (int ks = 0; ks < 8; ++ks) { const bf16x8 a = rd16(bm8 + 32 * sb2 * BM_P + 32 * ks), b = rd16(cm8 + 32 * tb * BM_P + 32 * ks); gt = mfma32(a, b, gt); if (ks & 1) SCHED_BAR(); }
        SCHED_BAR();
#pragma unroll
        for (int r = 0; r < 16; ++r) { const int so = 32 * sb2 + (r & 3) + 8 * (r >> 2); const float v = gt[r] * EXP2((acs_t[tb] - acs_h[so]) * LOG2E) * dtv_h[so];
            gt[r] = (tile == 1 || (r & 3) + 8 * (r >> 2) <= dl) ? v : 0.f; }
        SCHED_BAR();
#pragma unroll
        for (int ss = 0; ss < 2; ++ss) { const bf16x8 b = pack_step(gt, ss), a = rd8x2(xt4 + (32 * sb2 + 16 * ss) * 2); yacc[tb] = mfma32(a, b, yacc[tb]); }
    }
    SCHED_BAR();
    { const float dec = EXP2(ACS[63] * LOG2E);
#pragma unroll
      for (int nb = 0; nb < 4; ++nb)
#pragma unroll
          for (int r = 0; r < 16; ++r) hacc[nb][r] *= dec;
#pragma unroll
      for (int ks = 0; ks < 4; ++ks) { const v4u xr = __builtin_bit_cast(v4u, rd16(xt8 + 32 * ks));
          const f32x4 w0 = *(const LAS f32x4*)(wsc_h + 16 * ks), w1 = *(const LAS f32x4*)(wsc_h + 16 * ks + 4);
          v4u xs; xs.x = pk2(bflo(xr.x) * w0.x, bfhi(xr.x) * w0.y); xs.y = pk2(bflo(xr.y) * w0.z, bfhi(xr.y) * w0.w); xs.z = pk2(bflo(xr.z) * w1.x, bfhi(xr.z) * w1.y); xs.w = pk2(bflo(xr.w) * w1.z, bfhi(xr.w) * w1.w);
          const bf16x8 b = __builtin_bit_cast(bf16x8, xs);
#pragma unroll
          for (int nb = 0; nb < 4; ++nb) { const bf16x8 a = rd16(bt8 + 32 * nb * XT_P + 32 * ks); hacc[nb] = mfma32(a, b, hacc[nb]); }
          SCHED_BAR(); }
    }
    SCHED_BAR();
    if (!ck.store_y) return;
    const float Dh = F.in[I_DSKIP][4 * g + h];
    const LAS unsigned char* zu_l = L + S_ZU + l31 * ZU_P + (64 * h + 32 * j + 4 * hh) * 2;
    const LAS unsigned char* xt_l = L + S_XT + (64 * h + 32 * j + 4 * hh) * XT_P + l31 * 2;
    LAS float* ssq_l = (LAS float*)(L + S_SSQ) + l31;
    float ssq[2] = {0.f, 0.f};
#pragma unroll
    for (int tb = 0; tb < 2; ++tb) {
#pragma unroll
        for (int q4 = 0; q4 < 4; ++q4) { const v2u zw = *(const LAS v2u*)(zu_l + 32 * tb * ZU_P + 16 * q4);
#pragma unroll
            for (int e = 0; e < 4; ++e) { const int r = 4 * q4 + e; const float x = bf2f(*(const LAS bf16*)(xt_l + (8 * q4 + e) * XT_P + 64 * tb));
                const unsigned zz = e < 2 ? zw.x : zw.y; const float z = (e & 1) ? bfhi(zz) : bflo(zz);
                const float u = (yacc[tb][r] + Dh * x) * siluf_(z); yacc[tb][r] = u; ssq[tb] += u * u; } }
        const float sq = ssq[tb] + __shfl_xor(ssq[tb], 32);
        if (hh == 0) ssq_l[64 * w + 32 * tb] = sq; }
    __syncthreads();
    const float* gn_l = F.in[I_SSDN] + 256 * g + 64 * h + 32 * j + 4 * hh;
#pragma unroll
    for (int tb = 0; tb < 2; ++tb) { float tot = 0.f;
#pragma unroll
        for (int ww = 0; ww < 8; ++ww) tot += ssq_l[64 * ww + 32 * tb];
        const float rstd = RSQ(tot * (1.f / 256.f) + EPS);
#pragma unroll
        for (int q4 = 0; q4 < 4; ++q4) { const f32x4 gn = *(const f32x4*)(gn_l + 8 * q4);
            v2u o; o.x = pk2(yacc[tb][4 * q4] * rstd * gn.x, yacc[tb][4 * q4 + 1] * rstd * gn.y); o.y = pk2(yacc[tb][4 * q4 + 2] * rstd * gn.z, yacc[tb][4 * q4 + 3] * rstd * gn.w);
            *(LAS v2u*)((LAS unsigned char*)zu_l + 32 * tb * ZU_P + 16 * q4) = o; } }
    __syncthreads();
    { const int t = tid >> 3, seg = tid & 7;
      if (t >= ck.t0 && t < ck.t1) {
#pragma unroll
          for (int i = 0; i < 4; ++i) *(v4u*)(F.U() + (int)(ck.row0 + t) * DIN + 256 * g + 32 * seg + 8 * i) = *(const LAS v4u*)(L + S_ZU + t * ZU_P + seg * 64 + 16 * i); } }
}
DEV void ssd_unit(Frame& F, int kind, int sb, int g) {
    const int w = F.wave, h = w >> 1, j = w & 1, head = 4 * g + h;
    f32x16 hacc[4];
    if (kind == 0) {
#pragma unroll
        for (int nb = 0; nb < 4; ++nb)
#pragma unroll
            for (int r = 0; r < 16; ++r) hacc[nb][r] = 0.f;
    } else {
        const int lane = opaque_v(F.lane), l31 = lane & 31, hh = lane >> 5;
        const float* src = F.in[I_SSM] + (((int)sb * NSH + head) * 64 + 32 * j + l31) * DST;
#pragma unroll
        for (int nb = 0; nb < 4; ++nb)
#pragma unroll
            for (int q4 = 0; q4 < 4; ++q4) { const f32x4 v = *(const f32x4*)(src + 32 * nb + 8 * q4 + 4 * hh); hacc[nb][4 * q4] = v.x; hacc[nb][4 * q4 + 1] = v.y; hacc[nb][4 * q4 + 2] = v.z; hacc[nb][4 * q4 + 3] = v.w; }
    }
    if (kind == 0) {
        { SsdChunk ck; ck.row0 = MMAIN - 48; ck.t0 = 48; ck.t1 = 64; ck.halo = 0; ck.store_y = false; ssd_chunk(F, ck, sb, g, hacc); }
        for (int c = 0; c < SEQ / 64; ++c) { SsdChunk ck; ck.row0 = sb * SEQ + 64 * c; ck.t0 = 0; ck.t1 = 64; ck.halo = c == 0 ? 2 : 1; ck.store_y = true; ssd_chunk(F, ck, sb, g, hacc); }
    } else {
        SsdChunk ck; ck.row0 = MP + DSEQ * sb; ck.t0 = 0; ck.t1 = DSEQ; ck.halo = 3; ck.store_y = true; ssd_chunk(F, ck, sb, g, hacc);
    }
    const int lane = opaque_v(F.lane), l31 = lane & 31, hh = lane >> 5;
    float* dst = F.out + (kind == 0 ? OUT_SP : OUT_SS) + (((int)sb * NSH + head) * 64 + 32 * j + l31) * DST;
#pragma unroll
    for (int nb = 0; nb < 4; ++nb)
#pragma unroll
        for (int q4 = 0; q4 < 4; ++q4) { f32x4 v; v.x = hacc[nb][4 * q4]; v.y = hacc[nb][4 * q4 + 1]; v.z = hacc[nb][4 * q4 + 2]; v.w = hacc[nb][4 * q4 + 3]; *(f32x4*)(dst + 32 * nb + 8 * q4 + 4 * hh) = v; }
}
constexpr int KT_P = 272, VN_P = 320, A_KT = 0, A_VT = 64 * KT_P, A_BUF = A_VT + 64 * VN_P, A_BIAS = 2 * A_BUF, A_END = A_BIAS + 1280;
constexpr float ATT_THR = 8.0f;
static_assert(A_END <= RING_BYTES && 4 * 128 * 32 * 4 <= A_BIAS, "attention LDS map");
struct AttTile { int kind; int row0; const float* ck; const float* cv; int nvalid, kpos0; };
struct AttRegs { v4u r0, r1, r2, r3, r4, r5, r6, r7; };
#ifdef EMU
DEV bool wave_any(bool p) { int v = p ? 1 : 0;
    for (int o = 1; o < 64; o <<= 1) v |= __shfl_xor(v, o);
    return v != 0; }
DEV s16x4 tr_read(const unsigned char* p) {
    const int w = emu::me().tid.x >> 6, l = emu::me().tid.x & 63; memcpy(emu::B->xch[w][l], p, 8); emu::wave_sync();
    s16x4 r; const int g0 = l & ~15, i = l & 15;
    for (int j = 0; j < 4; ++j) r[j] = ((const short*)emu::B->xch[w][g0 + 4 * j + (i >> 2)])[i & 3];
    emu::wave_sync(); return r; }
#else
DEV bool wave_any(bool p) { return __any(p); }
typedef short v4i16_t __attribute__((ext_vector_type(4)));
DEV s16x4 tr_read(const LAS unsigned char* p) { return __builtin_bit_cast(s16x4, __builtin_amdgcn_ds_read_tr16_b64_v4i16((LAS v4i16_t*)p)); }
#endif

DEV AttTile att_tile(const Frame& F, int ukind, int sb, int hd, int i) {
    AttTile t; t.ck = nullptr; t.cv = nullptr; t.kind = 0;
    if (i == 0) { t.row0 = MMAIN; t.nvalid = NMETA; t.kpos0 = 0; return t; }
    const int f = i - 1;
    if (ukind == 0) { t.row0 = sb * SEQ + 64 * f; t.nvalid = 64; t.kpos0 = NMETA + 64 * f; return t; }
    if (f < PAST / 64) { t.kind = 1; t.row0 = 0; t.ck = F.in[I_CK] + ((size_t)sb * PAST + 64 * f) * 1024 + 128 * hd; t.cv = F.in[I_CV] + ((size_t)sb * PAST + 64 * f) * 1024 + 128 * hd; t.nvalid = 64; t.kpos0 = NMETA + 64 * f; return t; }
    t.row0 = MP + DSEQ * sb; t.nvalid = DSEQ; t.kpos0 = NMETA + PAST; return t;
}
DEV void att_load(const Frame& F, const AttTile& t, int hd, AttRegs& R, int tid) {
    const int kv = tid >> 3, seg = tid & 7; const v4u zero = {0u, 0u, 0u, 0u}; const bool ok = kv < t.nvalid;
    R.r0 = zero; R.r1 = zero; R.r2 = zero; R.r3 = zero; R.r4 = zero; R.r5 = zero; R.r6 = zero; R.r7 = zero;
    if (t.kind == 0) {
        const int off = (t.row0 + kv) * D + 128 * hd + 16 * seg; const bf16* kp = F.K() + off; const bf16* vp = F.V() + off;
        if (ok) { R.r0 = *(const v4u*)(kp); R.r1 = *(const v4u*)(kp + 8); R.r2 = *(const v4u*)(vp); R.r3 = *(const v4u*)(vp + 8); }
    } else {
        const float* kp = t.ck + kv * 1024 + 16 * seg; const float* vp = t.cv + kv * 1024 + 16 * seg;
        if (ok) { R.r0 = *(const v4u*)(kp); R.r1 = *(const v4u*)(kp + 4); R.r2 = *(const v4u*)(kp + 8); R.r3 = *(const v4u*)(kp + 12);
                  R.r4 = *(const v4u*)(vp); R.r5 = *(const v4u*)(vp + 4); R.r6 = *(const v4u*)(vp + 8); R.r7 = *(const v4u*)(vp + 12); }
    }
}
DEV v4u pack8_(const v4u a, const v4u b) { v4u o; o.x = pk2(uaf(a.x), uaf(a.y)); o.y = pk2(uaf(a.z), uaf(a.w)); o.z = pk2(uaf(b.x), uaf(b.y)); o.w = pk2(uaf(b.z), uaf(b.w)); return o; }
DEV void att_store(const AttTile& t, AttRegs& R, LAS unsigned char* buf, int tid) {
    const int kv = tid >> 3, seg = tid & 7;
    v4u bk[2], bv[2];
    if (t.kind == 1) { bk[0] = pack8_(R.r0, R.r1); bk[1] = pack8_(R.r2, R.r3); bv[0] = pack8_(R.r4, R.r5); bv[1] = pack8_(R.r6, R.r7); }
    else { bk[0] = R.r0; bk[1] = R.r1; bv[0] = R.r2; bv[1] = R.r3; }
#pragma unroll
    for (int i = 0; i < 2; ++i) { *(LAS v4u*)(buf + A_KT + kv * KT_P + seg * 32 + 16 * i) = bk[i]; *(LAS v4u*)(buf + A_VT + kv * VN_P + seg * 32 + 16 * i) = bv[i]; }
}
DEV void att_unit(Frame& F, int ukind, int sb, int hd, int cp) {
    LAS unsigned char* L = F.lds + RING_OFF;
    const int lane = opaque_v(F.lane), tid = opaque_v(F.tid), w = F.wave, l31 = lane & 31, hh = lane >> 5, comp = w >> 2, qb = w & 3;
    const bool active = ukind == 0 || qb == 0;
    const int ntile = ukind == 0 ? 2 * cp + 3 : PAST / 64 + 2;
    const int myvis = ukind == 0 ? 2 * cp + 2 + (qb >> 1) : ntile;
    const int qrow = ukind == 0 ? sb * SEQ + 128 * cp + 32 * qb + l31 : MP + DSEQ * sb + l31;
    const int qpos0 = ukind == 0 ? NMETA + 128 * cp + 32 * qb : NMETA + PAST;
    __syncthreads();
    if (tid < 320) { const int rel = tid - 255, n = rel < 0 ? -rel : rel; int bk;
        if (n < 8) bk = n; else { bk = 8 + (int)(2.0f * LOG2((float)n * 0.125f) + 1e-4f); bk = bk > 15 ? 15 : bk; }
        if (rel > 0) bk += 16;
        ((LAS float*)(L + A_BIAS))[tid] = (F.in[I_RELB][bk * NAH + hd] - F.in[I_RELB][15 * NAH + hd]) * LOG2E; }
    bf16x8 qf[4];
#pragma unroll
    for (int d0 = 0; d0 < 4; ++d0) { const v4u z = {0u, 0u, 0u, 0u}; qf[d0] = __builtin_bit_cast(bf16x8, active ? *(const v4u*)(F.Q() + qrow * D + 128 * hd + 64 * comp + 16 * d0 + 8 * hh) : z); }
    f32x16 o[4];
#pragma unroll
    for (int r = 0; r < 16; ++r) {
#pragma unroll
        for (int dt = 0; dt < 4; ++dt) o[dt][r] = 0.f; }
    float mref = 0.f, lsum = 0.f;
    AttRegs R; AttTile tcur = att_tile(F, ukind, sb, hd, 0), tnext = tcur;
    att_load(F, tcur, hd, R, tid); att_store(tcur, R, L, tid);
    __syncthreads();
    for (int i = 0; i < ntile; ++i) {
        LAS unsigned char* buf = L + (i & 1) * A_BUF;
        if (i + 1 < ntile) { tnext = att_tile(F, ukind, sb, hd, i + 1); att_load(F, tnext, hd, R, tid); }
        if (active && i < myvis) {
            f32x16 p0, p1;
            { const float nm = -mref;
#pragma unroll
              for (int r = 0; r < 16; ++r) { p0[r] = nm; p1[r] = nm; } }
            const LAS unsigned char* kb = buf + A_KT + l31 * KT_P + (64 * comp + 8 * hh) * 2;
#pragma unroll
            for (int d0 = 0; d0 < 4; ++d0) { const bf16x8 a0 = rd16(kb + d0 * 32), a1 = rd16(kb + 32 * KT_P + d0 * 32); p0 = mfma32(a0, qf[d0], p0); p1 = mfma32(a1, qf[d0], p1); }
            SCHED_BAR();
            const int kmax = tcur.kpos0 + tcur.nvalid - 1;
            if (kmax - qpos0 > -128) {
                const LAS float* tab_l = (const LAS float*)(L + A_BIAS) + (tcur.kpos0 - (qpos0 + l31) + 255 + 4 * hh);
#pragma unroll
                for (int r = 0; r < 16; ++r) { p0[r] += tab_l[(r & 3) + 8 * (r >> 2)]; p1[r] += tab_l[(r & 3) + 8 * (r >> 2) + 32]; }
            }
            if (tcur.nvalid < 64) {
#pragma unroll
                for (int r = 0; r < 16; ++r) { if (crow(r, hh) >= tcur.nvalid) p0[r] = -INFINITY; if (crow(r, hh) + 32 >= tcur.nvalid) p1[r] = -INFINITY; }
            }
            float mx = fmaxf(p0[0], p1[0]);
#pragma unroll
            for (int r = 1; r < 16; ++r) mx = fmaxf(mx, fmaxf(p0[r], p1[r]));
            mx = fmaxf(mx, __shfl_xor(mx, 32));
            if (i == 0 || wave_any(mx > ATT_THR)) {
                const float dl = i == 0 ? mx : fmaxf(mx, 0.f), f = EXP2(-dl); mref += dl; lsum *= f;
#pragma unroll
                for (int r = 0; r < 16; ++r) { p0[r] -= dl; p1[r] -= dl;
#pragma unroll
                    for (int dt = 0; dt < 4; ++dt) o[dt][r] *= f; }
            }
            float ps = 0.f;
#pragma unroll
            for (int r = 0; r < 16; ++r) { p0[r] = EXP2(p0[r]); p1[r] = EXP2(p1[r]); ps += p0[r] + p1[r]; }
            lsum += ps;
            SCHED_BAR();
            const LAS unsigned char* vt = buf + A_VT + (4 * hh + ((lane & 15) >> 2)) * VN_P + (16 * ((lane >> 4) & 1) + 4 * (lane & 3)) * 2;
            bf16x8 pa[4]; pa[0] = pack_step(p0, 0); pa[1] = pack_step(p0, 1); pa[2] = pack_step(p1, 0); pa[3] = pack_step(p1, 1);
#pragma unroll
            for (int dt = 0; dt < 4; ++dt)
#pragma unroll
                for (int ks = 0; ks < 4; ++ks) { const s16x4 lo = tr_read(vt + (16 * ks) * VN_P + 64 * dt), hi = tr_read(vt + (16 * ks + 8) * VN_P + 64 * dt);
                    const bf16x8 a = {lo[0], lo[1], lo[2], lo[3], hi[0], hi[1], hi[2], hi[3]}; o[dt] = mfma32(a, pa[ks], o[dt]); if (ks == 3) SCHED_BAR(); }
        }
        if (i + 1 < ntile) att_store(tnext, R, L + ((i + 1) & 1) * A_BUF, tid);
        tcur = tnext;
        __syncthreads();
    }
    if (active) { const float l = lsum + __shfl_xor(lsum, 32), inv = RCP(l);
#pragma unroll
        for (int dt = 0; dt < 4; ++dt)
#pragma unroll
            for (int r = 0; r < 16; ++r) o[dt][r] *= inv; }
    LAS float* xo_l = (LAS float*)L + (qb * 128 + 4 * hh) * 32 + l31;
    if (active && comp == 1) {
#pragma unroll
        for (int dt = 0; dt < 4; ++dt)
#pragma unroll
            for (int r = 0; r < 16; ++r) xo_l[(32 * dt + (r & 3) + 8 * (r >> 2)) * 32] = o[dt][r]; }
    __syncthreads();
    if (active && comp == 0) { float ss = 0.f;
        const float lam = EXP2(wave_sum(F.in[I_LQ1][lane] * F.in[I_LK1][lane]) * LOG2E) - EXP2(wave_sum(F.in[I_LQ2][lane] * F.in[I_LK2][lane]) * LOG2E) + 0.2f;
#pragma unroll
        for (int dt = 0; dt < 4; ++dt)
#pragma unroll
            for (int r = 0; r < 16; ++r) { const float v = o[dt][r] - lam * xo_l[(32 * dt + (r & 3) + 8 * (r >> 2)) * 32]; o[dt][r] = v; ss += v * v; }
        ss += __shfl_xor(ss, 32);
        const float rstd = RSQ(ss * (1.f / 128.f) + EPS) * 0.8f;
        bf16* orow = F.O() + qrow * D + 128 * hd;
#pragma unroll
        for (int dt = 0; dt < 4; ++dt)
#pragma unroll
            for (int q4 = 0; q4 < 4; ++q4) { const int d0 = 32 * dt + 8 * q4 + 4 * hh; const f32x4 gn = *(const f32x4*)(F.in[I_SUBLN] + d0);
                v2u ov; ov.x = pk2(o[dt][4 * q4] * rstd * gn.x, o[dt][4 * q4 + 1] * rstd * gn.y); ov.y = pk2(o[dt][4 * q4 + 2] * rstd * gn.z, o[dt][4 * q4 + 3] * rstd * gn.w);
                *(v2u*)(orow + d0) = ov; } }
}

DEV void row_phase(Frame& F, int second) {
    const int gw = F.vcu * NWAVES + F.wave, NGW = F.G * NWAVES, lane = F.lane;
    for (int m = gw; m < MMAIN; m += NGW) {
        const f32x4* tr = (const f32x4*)((second ? F.T2() : F.T1()) + (size_t)m * D) + lane;
        const f32x4* br = (const f32x4*)(second ? F.out + (size_t)m * D : x_row_ptr(F, m)) + lane;
        const f32x4* g1 = (const f32x4*)F.in[second ? I_NFFNP : I_NPOST] + lane;
        f32x4 tv[4], bv[4]; float s = 0.f;
#pragma unroll
        for (int jj = 0; jj < 4; ++jj) { tv[jj] = tr[64 * jj]; bv[jj] = br[64 * jj]; s += (tv[jj].x * tv[jj].x + tv[jj].y * tv[jj].y) + (tv[jj].z * tv[jj].z + tv[jj].w * tv[jj].w); }
        const float r = RSQ(wave_sum(s) * (1.f / D) + EPS); float s2 = 0.f;
        f32x4* orow = (f32x4*)(F.out + (size_t)m * D) + lane;
#pragma unroll
        for (int jj = 0; jj < 4; ++jj) { const f32x4 g = g1[64 * jj]; bv[jj] = bv[jj] + tv[jj] * r * g; orow[64 * jj] = bv[jj]; s2 += (bv[jj].x * bv[jj].x + bv[jj].y * bv[jj].y) + (bv[jj].z * bv[jj].z + bv[jj].w * bv[jj].w); }
        if (!second) {
            const float r2 = RSQ(wave_sum(s2) * (1.f / D) + EPS); const f32x4* g2 = (const f32x4*)F.in[I_NFFN] + lane;
            unsigned long long* o8 = (unsigned long long*)(F.XN() + (size_t)m * D) + lane;
#pragma unroll
            for (int jj = 0; jj < 4; ++jj) { const f32x4 g = g2[64 * jj]; o8[64 * jj] = (unsigned long long)pk2(bv[jj].x * r2 * g.x, bv[jj].y * r2 * g.y) | ((unsigned long long)pk2(bv[jj].z * r2 * g.z, bv[jj].w * r2 * g.w) << 32); }
        }
    }
}
struct Args { const float* in[29]; float* out; unsigned char* ws; int ph_lo, ph_hi, li, pad; };
#ifndef EMU
#define RLX_AGENT __ATOMIC_RELAXED, __HIP_MEMORY_SCOPE_AGENT
#define XB_TMO      128
#define XB_XCNT(j)  (256  + 64 * (j))
#define XB_XSUB(j)  (1280 + 64 * (j))
#define XB_XGEN(j)  (2304 + 64 * (j))
#define XB_TOP      3328
#define XB_TOPGEN   3392
#define XCD_BAR_WORDS 3456
#define XB_SPIN_CAP (1u << 18)

__device__ __forceinline__ unsigned xb_ld(unsigned* p)              { return __hip_atomic_load(p, __ATOMIC_RELAXED, __HIP_MEMORY_SCOPE_AGENT); }
__device__ __forceinline__ unsigned xb_add(unsigned* p, unsigned v) { return __hip_atomic_fetch_add(p, v, __ATOMIC_RELAXED, __HIP_MEMORY_SCOPE_AGENT); }
__device__ __forceinline__ unsigned xb_xcc_id() { return (unsigned)__builtin_amdgcn_s_getreg((3 << 11) | 20) & 0xFu; }
#define XB_SPIN(cond, bar) do { unsigned _sp = 0; while (cond) { __builtin_amdgcn_s_sleep(1); \
    if ((++_sp & 255u) == 0u) { if (xb_ld(&(bar)[XB_TMO])) break; if (_sp > XB_SPIN_CAP) { atomicAdd(&(bar)[XB_TMO], 1u); break; } } } } while (0)

struct XcdBarrier {
    unsigned* bar; unsigned x;
    volatile LAS unsigned* st;
};

__device__ __forceinline__ XcdBarrier xcd_barrier_post(unsigned* bar, volatile LAS unsigned* st) {
    XcdBarrier b; b.bar = bar; b.x = xb_xcc_id(); b.st = st;
    if (threadIdx.x == 0) (void)xb_add(&bar[XB_XCNT(b.x)], 1u);
    return b;
}
__device__ __forceinline__ void xcd_barrier_complete(unsigned* bar, unsigned x, unsigned& nloc, unsigned& nx) {
    const unsigned G = gridDim.x * gridDim.y * gridDim.z;
    unsigned sum, cnt, mine, sp = 0u;
    for (;;) {
        sum = 0u; cnt = 0u; mine = 0u;
#pragma unroll
        for (unsigned j = 0; j < 16; ++j) { const unsigned c = xb_ld(&bar[XB_XCNT(j)]); sum += c; cnt += (c > 0u) ? 1u : 0u; mine = (j == x) ? c : mine; }
        if (sum == G) break;
        __builtin_amdgcn_s_sleep(1);
        if ((++sp & 255u) == 0u) { if (xb_ld(&bar[XB_TMO])) break; if (sp > XB_SPIN_CAP) { atomicAdd(&bar[XB_TMO], 1u); break; } }
    }
    nloc = mine > 0u ? mine : 1u; nx = cnt > 0u ? cnt : 1u;
}

__device__ __forceinline__ void xcd_barrier(const XcdBarrier& b) {
    asm volatile("s_waitcnt vmcnt(0)" ::: "memory");
    __syncthreads();
    if (threadIdx.x == 0) {
        unsigned* bar = b.bar;
        __builtin_amdgcn_s_waitcnt(0);
        unsigned nloc = b.st[0], nx = b.st[1];
        if (nloc == 0u) { xcd_barrier_complete(bar, b.x, nloc, nx); b.st[0] = nloc; b.st[1] = nx; }
        const unsigned old = xb_add(&bar[XB_XSUB(b.x)], 1u);
        const unsigned gen = old / nloc;
        if (old + 1u == (gen + 1u) * nloc) {
            __builtin_amdgcn_fence(__ATOMIC_RELEASE, "agent");
            asm volatile("s_waitcnt vmcnt(0)" ::: "memory");
            const unsigned og = xb_add(&bar[XB_TOP], 1u);
            const unsigned tg = og / nx;
            if (og + 1u == (tg + 1u) * nx) xb_add(&bar[XB_TOPGEN], 1u);
            else XB_SPIN(xb_ld(&bar[XB_TOPGEN]) == tg, bar);
            __builtin_amdgcn_fence(__ATOMIC_ACQUIRE, "agent");
            xb_add(&bar[XB_XGEN(b.x)], 1u);
            asm volatile("s_waitcnt vmcnt(0)" ::: "memory");
        } else {
            XB_SPIN(xb_ld(&bar[XB_XGEN(b.x)]) == gen, bar);
            __builtin_amdgcn_fence(__ATOMIC_ACQUIRE, "agent");
            asm volatile("s_waitcnt vmcnt(0)" ::: "memory");
        }
    }
    __syncthreads();
}

#endif

__global__ void __launch_bounds__(NWAVES * 64, 2) skel_fwd(Args args) {
#ifdef EMU
    unsigned char* lds = emu::B->lds;
#else
    extern __shared__ __attribute__((aligned(16))) unsigned char lds[];
#endif
    Frame F;
    F.lds = (LAS unsigned char*)lds;
    F.tid = threadIdx.x; F.lane = F.tid & 63; F.wave = RDFL(F.tid >> 6);
    F.G = gridDim.x; { const int bx = blockIdx.x; F.vcu = (F.G % 8 == 0) ? (bx % 8) * (F.G / 8) + bx / 8 : bx; }
    unsigned char* ws = args.ws; F.ws = ws; F.out = args.out;
    F.in = args.in;
    F.ctl = (unsigned*)(ws + WS_CTL);
    for (int u = F.tid; u < (LDS_BYTES - LDSCTL_OFF) / 4; u += NWAVES * 64) ((LAS unsigned*)(F.lds + LDSCTL_OFF))[u] = 0u;
    __syncthreads();
#ifndef EMU
    volatile LAS unsigned* MISC = (volatile LAS unsigned*)(F.lds + MISC_OFF);
    XcdBarrier bar = xcd_barrier_post((unsigned*)(F.ctl + CW_BAR) + args.li * XCD_BAR_WORDS, MISC + 8);
#define GRID_BAR() xcd_barrier(bar)
#else
#define GRID_BAR() do {} while (0)
#endif
    const int lo = args.ph_lo, hi = args.ph_hi;
#define IN(k) (lo <= (k) && (k) < hi)
#define BOTH(k) (IN(k) && IN((k) + 1))

    if (IN(0)) { p0_prologue(F);
#if PROBE_DUP & 32
        VM_WAIT(); __syncthreads(); p0_prologue(F);
#endif
        if (BOTH(0)) GRID_BAR(); }

    if (IN(1)) {
        pg8::Gemm g{F.XN(), F.WinT(), MALL, NPROJ, D}; pg8::StaticOrder S; S.init(MALL, NPROJ, F.G, (int)blockIdx.x);
        pg8::EpiProj E{F.Z(), F.XBC(), F.Q(), F.K(), F.V(), F.GS(), F.GA(), F.DT(), F.in[I_DTB], F.out};
        pg8::gemm_phase<pg8::EpiProj, pg8::StaticOrder, PG8_ALIGN, PG8_SP2>(F.lds + RING_OFF, g, S, E);
#if PROBE_DUP & 1
        VM_WAIT(); __syncthreads();
        pg8::gemm_phase<pg8::EpiProj, pg8::StaticOrder, PG8_ALIGN, PG8_SP2>(F.lds + RING_OFF, g, S, E);
#endif
        if (BOTH(1)) GRID_BAR();
    }

    if (IN(2)) {
        for (int u = F.vcu; u < BATCH * NGRP; u += F.G) ssd_unit(F, 0, u / NGRP, u % NGRP);
        for (int u = F.vcu; u < DECB * NGRP; u += F.G) ssd_unit(F, 1, u / NGRP, u % NGRP);
#if PROBE_DUP & 8
        for (int u = F.vcu; u < BATCH * NGRP; u += F.G) ssd_unit(F, 0, u / NGRP, u % NGRP);
        for (int u = F.vcu; u < DECB * NGRP; u += F.G) ssd_unit(F, 1, u / NGRP, u % NGRP);
#endif
        for (int u = F.vcu; u < BATCH * NAH; u += F.G)
            for (int cp = 0; cp < SEQ / 128; ++cp) att_unit(F, 0, u / NAH, u % NAH, cp);
        for (int u = F.vcu; u < DECB * NAH; u += F.G) att_unit(F, 1, u / NAH, u % NAH, 0);
#if PROBE_DUP & 16
        for (int u = F.vcu; u < BATCH * NAH; u += F.G)
            for (int cp = 0; cp < SEQ / 128; ++cp) att_unit(F, 0, u / NAH, u % NAH, cp);
        for (int u = F.vcu; u < DECB * NAH; u += F.G) att_unit(F, 1, u / NAH, u % NAH, 0);
#endif
        __syncthreads();
        if (BOTH(2)) GRID_BAR();
    }

    if (IN(3)) {
        { pg8::Gemm g{F.U(), F.WssdT(), MMAIN, D, DIN}; pg8::StaticOrder S; S.init(MMAIN, D, F.G, (int)blockIdx.x);
          pg8::EpiGate<0> E{F.GS(), nullptr, F.TMP()};
          pg8::gemm_phase<pg8::EpiGate<0>, pg8::StaticOrder, PG8_ALIGN, PG8_SP2>(F.lds + RING_OFF, g, S, E); }
        VM_WAIT(); __syncthreads();
        { pg8::Gemm g{F.O(), F.WattT(), MMAIN, D, D}; pg8::StaticOrder S; S.init(MMAIN, D, F.G, (int)blockIdx.x);
          pg8::EpiGate<1> E{F.GA(), F.TMP(), F.MIX()};
          pg8::gemm_phase<pg8::EpiGate<1>, pg8::StaticOrder, PG8_ALIGN, PG8_SP2>(F.lds + RING_OFF, g, S, E); }
#if PROBE_DUP & 2
        VM_WAIT(); __syncthreads();
        { pg8::Gemm g{F.U(), F.WssdT(), MMAIN, D, DIN}; pg8::StaticOrder S; S.init(MMAIN, D, F.G, (int)blockIdx.x);
          pg8::EpiGate<0> E{F.GS(), nullptr, F.TMP()};
          pg8::gemm_phase<pg8::EpiGate<0>, pg8::StaticOrder, PG8_ALIGN, PG8_SP2>(F.lds + RING_OFF, g, S, E); }
        VM_WAIT(); __syncthreads();
        { pg8::Gemm g{F.O(), F.WattT(), MMAIN, D, D}; pg8::StaticOrder S; S.init(MMAIN, D, F.G, (int)blockIdx.x);
          pg8::EpiGate<1> E{F.GA(), F.TMP(), F.MIX()};
          pg8::gemm_phase<pg8::EpiGate<1>, pg8::StaticOrder, PG8_ALIGN, PG8_SP2>(F.lds + RING_OFF, g, S, E); }
#endif
        if (BOTH(3)) GRID_BAR();
    }

    if (IN(4)) {
        pg8::Gemm g{F.MIX(), F.WoT(), MMAIN, D, D}; pg8::StaticOrder S; S.init(MMAIN, D, F.G, (int)blockIdx.x);
        pg8::EpiF32 E{F.T1(), D};
        pg8::gemm_phase<pg8::EpiF32, pg8::StaticOrder, PG8_ALIGN, PG8_SP2>(F.lds + RING_OFF, g, S, E);
#if PROBE_DUP & 2
        VM_WAIT(); __syncthreads();
        pg8::gemm_phase<pg8::EpiF32, pg8::StaticOrder, PG8_ALIGN, PG8_SP2>(F.lds + RING_OFF, g, S, E);
#endif
        if (BOTH(4)) GRID_BAR();
    }
    if (IN(5)) { row_phase(F, 0);
#if PROBE_DUP & 64
        VM_WAIT(); __syncthreads(); row_phase(F, 0);
#endif
        if (BOTH(5)) GRID_BAR(); }

    if (IN(6)) {
        pg8::Gemm g{F.XN(), F.WffT(), MMAIN, 2 * DFF, D}; pg8::StaticOrder S; S.init(MMAIN, 2 * DFF, F.G, (int)blockIdx.x);
        pg8::EpiSwiglu E{F.HB()};
        pg8::gemm_phase<pg8::EpiSwiglu, pg8::StaticOrder, PG8_ALIGN, PG8_SP2>(F.lds + RING_OFF, g, S, E);
#if PROBE_DUP & 4
        VM_WAIT(); __syncthreads();
        pg8::gemm_phase<pg8::EpiSwiglu, pg8::StaticOrder, PG8_ALIGN, PG8_SP2>(F.lds + RING_OFF, g, S, E);
#endif
        if (BOTH(6)) GRID_BAR();
    }
    if (IN(7)) {
        pg8::Gemm g{F.HB(), F.Wff2T(), MMAIN, D, DFF}; pg8::StaticOrder S; S.init(MMAIN, D, F.G, (int)blockIdx.x);
        pg8::EpiF32 E{F.T2(), D};
        pg8::gemm_phase<pg8::EpiF32, pg8::StaticOrder, PG8_ALIGN, PG8_SP2>(F.lds + RING_OFF, g, S, E);
#if PROBE_DUP & 4
        VM_WAIT(); __syncthreads();
        pg8::gemm_phase<pg8::EpiF32, pg8::StaticOrder, PG8_ALIGN, PG8_SP2>(F.lds + RING_OFF, g, S, E);
#endif
        if (BOTH(7)) GRID_BAR();
    }
    if (IN(8)) { row_phase(F, 1); }
#undef IN
#undef BOTH
}

extern "C" void kernel_launch(void* const* d_in, const int* in_sizes, int n_in, void* d_out, int out_size, void* d_ws, size_t ws_size, hipStream_t stream) {
    if (n_in != 29 || (size_t)out_size != OUT_END || ws_size < WS_END) { fprintf(stderr, "kernel_launch: shape mismatch: n_in %d out %d (want %zu) ws %zu (want %zu)\n", n_in, out_size, (size_t)OUT_END, ws_size, (size_t)WS_END); return; }
    Args a{};
    for (int i = 0; i < 29; ++i) a.in[i] = (const float*)d_in[i];
    a.out = (float*)d_out; a.ws = (unsigned char*)d_ws;
#ifdef EMU
    memset((char*)d_ws + WS_CTL, 0, CTL_ZERO_BYTES);
    const int first = getenv("EMU_PH_LO") ? atoi(getenv("EMU_PH_LO")) : 0, last = getenv("EMU_PH_HI") ? atoi(getenv("EMU_PH_HI")) : NPHASE;
    const int grid = getenv("EMU_GRID") ? atoi(getenv("EMU_GRID")) : 8;
    for (int ph = first; ph < last; ++ph) { a.ph_lo = ph; a.ph_hi = ph + 1; a.li = 0; fprintf(stderr, "[emu] phase %d\n", ph); emu::launch(grid, NWAVES * 64, LDS_BYTES, [=] { skel_fwd(a); }); }
#else
    static int grid = 0;
    if (grid == 0) {
        int dev = 0, cus = 0, per_cu = 0;
        if (hipGetDevice(&dev) != hipSuccess || hipDeviceGetAttribute(&cus, hipDeviceAttributeMultiprocessorCount, dev) != hipSuccess) { fprintf(stderr, "kernel_launch: device query failed\n"); grid = -1; return; }
        if (hipFuncSetAttribute((const void*)skel_fwd, hipFuncAttributeMaxDynamicSharedMemorySize, LDS_BYTES) != hipSuccess) { fprintf(stderr, "kernel_launch: hipFuncSetAttribute failed\n"); grid = -1; return; }
        if (hipOccupancyMaxActiveBlocksPerMultiprocessor(&per_cu, (const void*)skel_fwd, NWAVES * 64, LDS_BYTES) != hipSuccess || per_cu < 1) { fprintf(stderr, "kernel_launch: occupancy query says %d blocks per CU\n", per_cu); (void)hipGetLastError(); per_cu = 1; }
        grid = cus;
    }
    if (grid < 0) return;
    if (hipMemsetAsync((char*)d_ws + WS_CTL, 0, CTL_ZERO_BYTES, stream) != hipSuccess) { fprintf(stderr, "kernel_launch: memset failed\n"); return; }
    constexpr int NL = MK_N_LAUNCHES;
    for (int li = 0; li < NL; ++li) {
        a.ph_lo = NL == 1 ? 0 : li; a.ph_hi = NL == 1 ? NPHASE : li + 1; a.li = li;
        hipLaunchKernelGGL(skel_fwd, dim3(grid), dim3(NWAVES * 64), LDS_BYTES, stream, a);
        const hipError_t le = hipPeekAtLastError();
        if (le != hipSuccess) { fprintf(stderr, "kernel_launch: launch %d failed: %s\n", li, hipGetErrorName(le)); break; }
    }
#endif
}
```

```cpp
#ifndef EMU
#include <hip/hip_runtime.h>
#endif
#include <cstdio>
#include <cstdint>
#include <cmath>

#ifdef EMU
#define PG8_LAS
#define LAS
#define GAS
#define WAVE_LDS_SYNC() emu::wave_sync()
#define RDFL(x) (x)
#else
#define PG8_LAS __attribute__((address_space(3)))
#define LAS __attribute__((address_space(3)))
#define GAS __attribute__((address_space(1)))
#define WAVE_LDS_SYNC() asm volatile("s_waitcnt lgkmcnt(0)" ::: "memory")
#define RDFL(x) __builtin_amdgcn_readfirstlane(x)
#endif
namespace pg8 {
typedef unsigned short bf16_t;
typedef short bf16x8 __attribute__((ext_vector_type(8)));
typedef float f32x4 __attribute__((ext_vector_type(4)));
typedef unsigned u32x4 __attribute__((ext_vector_type(4)));
constexpr int BM = 256, BK = 64, HALF = 128, HTB = HALF * BK * 2  , STAGE_BYTES = 8 * HTB, NXCD = 8, WGM = 8;

__host__ __device__ __forceinline__ int lds_byte(int r, int c) { const int st = (r >> 4) * 2 + (c >> 5), rr = r & 15, cc = c & 31, ob = rr * 64 + cc * 2; return st * 1024 + (ob ^ (((ob >> 9) & 1) << 5)); }
__host__ __device__ __forceinline__ void stage_rc(int b, int& R, int& C) { const int st = b / 1024, sb = b % 1024, swz = sb ^ (((sb >> 9) & 1) << 5); R = (st >> 1) * 16 + swz / 64; C = (st & 1) * 32 + (swz % 64) / 2; }
__host__ __device__ __forceinline__ int perm32(int rho) { const int n = rho >> 4, i = rho & 15; return 8 * (i >> 2) + 4 * n + (i & 3); }

struct Unit { int pm, pn; };
struct Gemm { const bf16_t* A; const bf16_t* Bt; int M, N, K; };

struct StaticOrder {
    int nM, nN, nwg, G, c, wid;
    __host__ __device__ void init(int M, int N, int G_, int c_) { nM = M / BM; nN = N / BM; nwg = nM * nN; G = G_; c = c_; }
    __host__ __device__ bool next(int i, Unit& u) const {
        const long L = (long)i * G + c; if (L >= nwg) return false;
        int wgid = (int)L; { const int q = nwg / NXCD, r = nwg % NXCD, xcd = wgid % NXCD, off = wgid / NXCD; wgid = (xcd < r ? xcd * (q + 1) : r * (q + 1) + (xcd - r) * q) + off; }
        const int nig = WGM * nN, gid = wgid / nig, fm = gid * WGM, gsz = (nM - fm) < WGM ? (nM - fm) : WGM;
        u.pm = fm + ((wgid % nig) % gsz); u.pn = (wgid % nig) / gsz; return true;
    }
    __device__ __forceinline__ void a_ready(const Unit&) const {}
    __device__ __forceinline__ void done(const Unit&) const {}
};
typedef float f32x2 __attribute__((ext_vector_type(2)));
#ifdef EMU
__device__ __forceinline__ unsigned cvt_pk_bf16(float lo, float hi) { return (unsigned)emu_f2bf(lo) | ((unsigned)emu_f2bf(hi) << 16); }
inline void emu_host_tile(const Gemm& g, const Unit& u, float* C) {
    const int K = g.K; std::vector<float> a((size_t)256 * K), b((size_t)256 * K);
    for (int r = 0; r < 256; ++r) for (int k = 0; k < K; ++k) { a[(size_t)r * K + k] = emu_bf2f(g.A[(size_t)(u.pm * 256 + r) * K + k]); b[(size_t)r * K + k] = emu_bf2f(g.Bt[(size_t)(u.pn * 256 + r) * K + k]); }
    for (int r = 0; r < 256; ++r) for (int c = 0; c < 256; ++c) { const float* ap = &a[(size_t)r * K]; const float* bp = &b[(size_t)c * K]; float s0 = 0.f, s1 = 0.f, s2 = 0.f, s3 = 0.f;
        for (int k = 0; k < K; k += 4) { s0 += ap[k] * bp[k]; s1 += ap[k + 1] * bp[k + 1]; s2 += ap[k + 2] * bp[k + 2]; s3 += ap[k + 3] * bp[k + 3]; } C[r * 256 + c] = (s0 + s1) + (s2 + s3); }
}
template <class Epi, class Sched, bool ALIGN_EPI = false, bool SP2 = false>
inline void gemm_phase(unsigned char* lds, const Gemm g, const Sched& S, const Epi& E) {
    const int tid = threadIdx.x, wid = tid >> 6, lane = tid & 63, wr = wid >> 2, wc = wid & 3, fr = lane & 15, fq = lane >> 4;
    Unit cur;
    for (int ui = 0; S.next(ui, cur); ++ui) {
        __syncthreads();
        if (tid == 0) emu_host_tile(g, cur, emu::B->gemm_tile);
        __syncthreads();
        f32x4 acc[2][2][4][2];
        for (int ai = 0; ai < 2; ++ai) for (int bj = 0; bj < 2; ++bj) for (int m = 0; m < 4; ++m) for (int n = 0; n < 2; ++n) for (int e = 0; e < 4; ++e) {
            const int row = 128 * ai + 64 * wr + 16 * m + fr, col = 128 * bj + 32 * wc + (Epi::PERM ? 8 * fq + 4 * n + e : 16 * n + 4 * fq + e);
            acc[ai][bj][m][n][e] = emu::B->gemm_tile[row * 256 + col]; }
        E(acc, cur, wr, wc, fr, fq);
    }
    __syncthreads();
}
#else
__device__ __forceinline__ int pg8_lane_id() { int x; asm volatile("v_mbcnt_lo_u32_b32 %0, -1, 0\n\tv_mbcnt_hi_u32_b32 %0, -1, %0" : "=v"(x)); return x; }
__device__ __forceinline__ unsigned cvt_pk_bf16(float lo, float hi) { unsigned r; asm volatile("v_cvt_pk_bf16_f32 %0, %1, %2" : "=v"(r) : "v"(lo), "v"(hi)); return r; }
template <class Epi, class Sched, bool ALIGN_EPI = false, bool SP2 = false>
__device__ __forceinline__ void gemm_phase(PG8_LAS unsigned char* lds, const Gemm g, const Sched& S, const Epi& E) {
    const int wid = S.wid, lane = pg8_lane_id(), tid = wid * 64 + lane, wr = wid >> 2, wc = wid & 3, fr = lane & 15, fq = lane >> 4;
    const int K = g.K, nt = K / BK;
    unsigned voffA[2], voffB[2];
#pragma unroll
    for (int i = 0; i < 2; ++i) { int R, C; stage_rc(tid * 16 + i * 8192, R, C); const int Rb = Epi::PERM ? ((R & ~31) + perm32(R & 31)) : R;
        voffA[i] = (unsigned)(R * K + C) * 2u; voffB[i] = (unsigned)(Rb * K + C) * 2u; }
    const size_t kstep = (size_t)(BK * 2);
    const size_t hstep = (size_t)HALF * K * 2;
    const size_t tstep = 2 * hstep;
    const unsigned ldsw = (unsigned)wid * 1024u;
    const int aoff = lds_byte(wr * 64 + fr, fq * 8), boff = lds_byte(wc * 32 + fr, fq * 8);
#define PG8_SA(b, h) (((b) * 2 + (h)) * HTB)
#define PG8_SB(b, h) ((4 + (b) * 2 + (h)) * HTB)
#define PG8_STAGE(bufoff, gbase, voff) do { _Pragma("unroll") for (int _i = 0; _i < 2; ++_i) \
        __builtin_amdgcn_global_load_lds((const unsigned*)((const char*)(gbase) + (voff)[_i]), (PG8_LAS unsigned*)(lds + (bufoff) + ldsw + _i * 8192), 16, 0, 0); } while (0)
#define PG8_LDA(dst, b, h) do { _Pragma("unroll") for (int m = 0; m < 4; ++m) _Pragma("unroll") for (int k = 0; k < 2; ++k) dst[m][k] = *(const PG8_LAS bf16x8*)(lds + PG8_SA(b, h) + aoff + m * 2048 + k * 1024); } while (0)
#define PG8_LDB(dst, b, h) do { _Pragma("unroll") for (int n = 0; n < 2; ++n) _Pragma("unroll") for (int k = 0; k < 2; ++k) dst[n][k] = *(const PG8_LAS bf16x8*)(lds + PG8_SB(b, h) + boff + n * 2048 + k * 1024); } while (0)
#define PG8_MMA(ai, bj, At, Bt) do { __builtin_amdgcn_s_setprio(1); _Pragma("unroll") for (int m = 0; m < 4; ++m) _Pragma("unroll") for (int n = 0; n < 2; ++n) _Pragma("unroll") for (int k = 0; k < 2; ++k) \
        acc[ai][bj][m][n] = __builtin_amdgcn_mfma_f32_16x16x32_bf16(Bt[n][k], At[m][k], acc[ai][bj][m][n], 0, 0, 0); __builtin_amdgcn_s_setprio(0); } while (0)
#define PG8_WAIT_V(n) asm volatile("s_waitcnt vmcnt(" #n ")" ::: "memory")
#define PG8_WAIT_L(n) asm volatile("s_waitcnt lgkmcnt(" #n ")" ::: "memory")
#define PG8_BAR __builtin_amdgcn_s_barrier()
#define PG8_SCHED __builtin_amdgcn_sched_barrier(0)
    Unit cur, nxt; int ui = 0;
    if (!S.next(0, cur)) return;
    f32x4 acc[2][2][4][2];
#pragma unroll
    for (int a = 0; a < 2; ++a)
#pragma unroll
        for (int b = 0; b < 2; ++b)
#pragma unroll
            for (int m = 0; m < 4; ++m)
#pragma unroll
                for (int n = 0; n < 2; ++n) acc[a][b][m][n] = (f32x4){0.f, 0.f, 0.f, 0.f};
    bf16x8 At[4][2], B0[2][2], B1[2][2];
    const char* cA = (const char*)g.A + (size_t)cur.pm * tstep; const char* cB = (const char*)g.Bt + (size_t)cur.pn * tstep;
    S.a_ready(cur);
    if constexpr (SP2) {
        PG8_STAGE(PG8_SB(0, 0), cB, voffB); PG8_STAGE(PG8_SB(0, 1), cB + hstep, voffB); PG8_STAGE(PG8_SA(0, 0), cA, voffA); PG8_STAGE(PG8_SA(0, 1), cA + hstep, voffA);
        if (wr == 1) PG8_BAR;
        PG8_WAIT_V(2); PG8_BAR;
        PG8_STAGE(PG8_SB(1, 0), cB + kstep, voffB); PG8_STAGE(PG8_SA(1, 0), cA + kstep, voffA); PG8_STAGE(PG8_SB(1, 1), cB + hstep + kstep, voffB);
        PG8_WAIT_V(6); PG8_BAR;
    } else {
        PG8_STAGE(PG8_SB(0, 0), cB, voffB); PG8_STAGE(PG8_SA(0, 0), cA, voffA); PG8_STAGE(PG8_SB(0, 1), cB + hstep, voffB); PG8_STAGE(PG8_SA(0, 1), cA + hstep, voffA);
        if (wr == 1) PG8_BAR;
        PG8_WAIT_V(4); PG8_BAR;
        PG8_STAGE(PG8_SB(1, 0), cB + kstep, voffB); PG8_STAGE(PG8_SA(1, 0), cA + kstep, voffA); PG8_STAGE(PG8_SB(1, 1), cB + hstep + kstep, voffB);
        PG8_WAIT_V(6); PG8_BAR;
    }
    for (;;) {
        const bool has_next = S.next(ui + 1, nxt);
        const char* nA = has_next ? (const char*)g.A + (size_t)nxt.pm * tstep : cA; const char* nB = has_next ? (const char*)g.Bt + (size_t)nxt.pn * tstep : cB;
        for (int t = 0; t < nt; t += 2) {
            const bool last = (t == nt - 2);
            const char* a1 = cA + (size_t)(t + 1) * kstep;
            const char* a2 = last ? nA : cA + (size_t)(t + 2) * kstep; const char* b2 = last ? nB : cB + (size_t)(t + 2) * kstep;
            const char* a3 = a2 + kstep; const char* b3 = b2 + kstep;
            if (last && has_next) S.a_ready(nxt);
            if constexpr (SP2) {
            PG8_LDB(B0, 0, 0); PG8_LDB(B1, 0, 1); PG8_SCHED; PG8_LDA(At, 0, 0); PG8_STAGE(PG8_SA(1, 1), a1 + hstep, voffA);
            PG8_WAIT_V(8); PG8_WAIT_L(0); PG8_BAR; PG8_MMA(0, 0, At, B0); PG8_MMA(0, 1, At, B1); PG8_BAR; PG8_SCHED;
            PG8_LDA(At, 0, 1); PG8_STAGE(PG8_SB(0, 0), b2, voffB); PG8_STAGE(PG8_SB(0, 1), b2 + hstep, voffB); PG8_STAGE(PG8_SA(0, 0), a2, voffA);
            PG8_WAIT_V(8); PG8_WAIT_L(0); PG8_BAR; PG8_MMA(1, 0, At, B0); PG8_MMA(1, 1, At, B1); PG8_BAR; PG8_SCHED;
            PG8_LDB(B0, 1, 0); PG8_LDB(B1, 1, 1); PG8_SCHED; PG8_LDA(At, 1, 0); PG8_STAGE(PG8_SA(0, 1), a2 + hstep, voffA);
            PG8_WAIT_V(8); PG8_WAIT_L(0); PG8_BAR; PG8_MMA(0, 0, At, B0); PG8_MMA(0, 1, At, B1); PG8_BAR; PG8_SCHED;
            PG8_LDA(At, 1, 1); PG8_STAGE(PG8_SB(1, 0), b3, voffB); PG8_STAGE(PG8_SB(1, 1), b3 + hstep, voffB); PG8_STAGE(PG8_SA(1, 0), a3, voffA);
            PG8_WAIT_V(8); PG8_WAIT_L(0); PG8_BAR; PG8_MMA(1, 0, At, B0); PG8_MMA(1, 1, At, B1); PG8_BAR; PG8_SCHED;
            } else {
            PG8_LDB(B0, 0, 0); PG8_SCHED; PG8_LDA(At, 0, 0); PG8_STAGE(PG8_SA(1, 1), a1 + hstep, voffA);
            PG8_WAIT_L(8); PG8_BAR; PG8_WAIT_L(0); PG8_MMA(0, 0, At, B0); PG8_BAR; PG8_SCHED;
            PG8_LDB(B1, 0, 1); PG8_STAGE(PG8_SB(0, 0), b2, voffB);
            PG8_BAR; PG8_WAIT_L(0); PG8_MMA(0, 1, At, B1); PG8_BAR;
            PG8_LDA(At, 0, 1); PG8_STAGE(PG8_SA(0, 0), a2, voffA);
            PG8_BAR; PG8_WAIT_L(0); PG8_MMA(1, 0, At, B0); PG8_BAR; PG8_SCHED;
            PG8_STAGE(PG8_SB(0, 1), b2 + hstep, voffB);
            PG8_WAIT_V(6); PG8_BAR; PG8_MMA(1, 1, At, B1); PG8_BAR;
            PG8_LDB(B0, 1, 0); PG8_SCHED; PG8_LDA(At, 1, 0); PG8_STAGE(PG8_SA(0, 1), a2 + hstep, voffA);
            PG8_WAIT_L(8); PG8_BAR; PG8_WAIT_L(0); PG8_MMA(0, 0, At, B0); PG8_BAR; PG8_SCHED;
            PG8_LDB(B1, 1, 1); PG8_STAGE(PG8_SB(1, 0), b3, voffB);
            PG8_BAR; PG8_WAIT_L(0); PG8_MMA(0, 1, At, B1); PG8_BAR;
            PG8_LDA(At, 1, 1); PG8_STAGE(PG8_SA(1, 0), a3, voffA);
            PG8_BAR; PG8_WAIT_L(0); PG8_MMA(1, 0, At, B0); PG8_BAR; PG8_SCHED;
            PG8_STAGE(PG8_SB(1, 1), b3 + hstep, voffB);
            PG8_WAIT_V(6); PG8_BAR; PG8_MMA(1, 1, At, B1); PG8_BAR;
            }
        }
        if constexpr (ALIGN_EPI) { if (wr == 0) PG8_BAR; }
        if constexpr (!Epi::AFTER_DRAIN) { E(acc, cur, wr, wc, fr, fq); S.done(cur); }
        if (!has_next) break;
#pragma unroll
        for (int a = 0; a < 2; ++a)
#pragma unroll
            for (int b = 0; b < 2; ++b)
#pragma unroll
                for (int m = 0; m < 4; ++m)
#pragma unroll
                    for (int n = 0; n < 2; ++n) acc[a][b][m][n] = (f32x4){0.f, 0.f, 0.f, 0.f};
        cur = nxt; cA = nA; cB = nB; ++ui;
        if constexpr (ALIGN_EPI) { if (wr == 1) PG8_BAR; }
    }
    PG8_WAIT_V(0);
    if constexpr (!ALIGN_EPI) { if (wr == 0) PG8_BAR; }
    PG8_BAR;
    if constexpr (Epi::AFTER_DRAIN) { E.fused(acc, cur, wr, wc, fr, fq, lds, wid, lane); S.done(cur); }
#undef PG8_SA
#undef PG8_SB
#undef PG8_STAGE
#undef PG8_LDA
#undef PG8_LDB
#undef PG8_MMA
#undef PG8_WAIT_V
#undef PG8_WAIT_L
#undef PG8_BAR
#undef PG8_SCHED
}
#endif
}
#ifndef PG8_SP2
#define PG8_SP2 true
#endif
#ifndef PG8_ALIGN
#define PG8_ALIGN true
#endif

#ifndef CFG_BATCH
#define CFG_BATCH 32
#endif
#ifndef CFG_SEQ
#define CFG_SEQ 2048
#endif
#ifndef CFG_DECB
#define CFG_DECB 32
#endif
#ifndef CFG_PAST
#define CFG_PAST 4096
#endif
#ifndef PROBE_DUP
#define PROBE_DUP 0
#endif
#ifndef MK_N_LAUNCHES
#define MK_N_LAUNCHES 1
#endif
constexpr int NWAVES = 8, NPHASE = 9;
constexpr int BATCH = CFG_BATCH, SEQ = CFG_SEQ, DECB = CFG_DECB, DSEQ = 32, PAST = CFG_PAST;
constexpr int D = 1024, NMETA = 16, DIN = 2048, CONVD = 4096, NSH = 32, NGRP = 8, DST = 128, NAH = 8, DFF = 2816;
constexpr int MP = BATCH * SEQ, MS = DECB * DSEQ, MMAIN = MP + MS, MALL = MMAIN + 256;
constexpr int NPROJ = 45 * 256, LEXT = NMETA + SEQ;
static_assert(MP % 256 == 0 && MS % 256 == 0 && SEQ % 128 == 0 && PAST % 64 == 0, "row panels");
constexpr float EPS = 1e-6f, LOG2E = 1.4426950408889634f, LN2 = 0.6931471805599453f, QSCALE = 0.125f * LOG2E;
constexpr size_t OUT_Y = 0, OUT_YS = OUT_Y + (size_t)MP * D, OUT_KP = OUT_YS + (size_t)MS * D, OUT_VP = OUT_KP + (size_t)BATCH * LEXT * 1024,
    OUT_CP = OUT_VP + (size_t)BATCH * LEXT * 1024, OUT_SP = OUT_CP + (size_t)BATCH * 3 * CONVD, OUT_KS = OUT_SP + (size_t)BATCH * NSH * 64 * DST,
    OUT_VS = OUT_KS + (size_t)MS * 1024, OUT_CS = OUT_VS + (size_t)MS * 1024, OUT_SS = OUT_CS + (size_t)DECB * 3 * CONVD, OUT_END = OUT_SS + (size_t)DECB * NSH * 64 * DST;
constexpr size_t MiB = 1u << 20;
constexpr size_t al(size_t x) { return (x + MiB - 1) & ~(MiB - 1); }
constexpr size_t WS_CTL = 0, CTL_ZERO_BYTES = MiB;
constexpr size_t WS_WIN = MiB, WS_WSSD = WS_WIN + al((size_t)NPROJ * D * 2), WS_WATT = WS_WSSD + al((size_t)D * DIN * 2), WS_WO = WS_WATT + al((size_t)D * D * 2),
    WS_WFF = WS_WO + al((size_t)D * D * 2), WS_WFF2 = WS_WFF + al((size_t)2 * DFF * D * 2), WS_XN = WS_WFF2 + al((size_t)D * DFF * 2);
constexpr size_t WS_Z = WS_XN + al((size_t)MALL * D * 2), WS_XBC = WS_Z + al((size_t)MALL * DIN * 2), WS_DT = WS_XBC + al((size_t)MALL * CONVD * 2), WS_Q = WS_DT + al((size_t)MALL * 32 * 4),
    WS_K = WS_Q + al((size_t)MALL * D * 2), WS_V = WS_K + al((size_t)MALL * D * 2), WS_GS = WS_V + al((size_t)MALL * D * 2), WS_GA = WS_GS + al((size_t)MALL * D * 2), WS_U = WS_GA + al((size_t)MALL * D * 2), WS_O = WS_U + al((size_t)MALL * DIN * 2), WS_END = WS_O + al((size_t)MALL * D * 2);
constexpr size_t WS_MIX = WS_XBC, WS_T1 = WS_XBC + (size_t)MMAIN * D * 2, WS_TMP = WS_T1 + (size_t)MMAIN * D * 4, WS_HB = WS_XBC, WS_T2 = WS_Z;
static_assert(WS_TMP + (size_t)MMAIN * D * 2 <= WS_DT && WS_HB + (size_t)MMAIN * DFF * 2 <= WS_DT && WS_T2 + (size_t)MMAIN * D * 4 <= WS_XBC, "overlays");
static_assert(WS_END <= ((size_t)2048 << 20), "workspace map fits 2 GiB");
constexpr int CW_TMO = 0, CW_BAR = 4096;
constexpr int RING_OFF = 0, RING_BYTES = 131072, LDSCTL_OFF = RING_BYTES, MISC_OFF = LDSCTL_OFF + 320, LDS_BYTES = 147456;

typedef unsigned short bf16;
typedef unsigned v4u __attribute__((ext_vector_type(4)));
typedef unsigned v2u __attribute__((ext_vector_type(2)));
typedef float f32x4 __attribute__((ext_vector_type(4)));
typedef float f32x16 __attribute__((ext_vector_type(16)));
typedef short bf16x8 __attribute__((ext_vector_type(8)));
typedef short s16x4 __attribute__((ext_vector_type(4)));

#ifdef EMU
#define DEV inline
DEV float EXP2(float x) { return exp2f(x); }
DEV float LOG2(float x) { return log2f(x); }
DEV float RCP(float x) { return 1.0f / x; }
DEV float RSQ(float x) { return 1.0f / sqrtf(x); }
DEV unsigned pk2(float lo, float hi) { return (unsigned)emu_f2bf(lo) | ((unsigned)emu_f2bf(hi) << 16); }
DEV f32x16 mfma32(bf16x8 a, bf16x8 b, f32x16 c) { return emu_mfma32(a, b, c); }
DEV float uaf(unsigned u) { float f; memcpy(&f, &u, 4); return f; }
#define LDS_WAIT() do {} while (0)
#define SCHED_BAR() do {} while (0)
DEV int opaque_v(int x) { return x; }
#define VM_WAIT() do {} while (0)
#else
#define DEV __device__ __forceinline__
DEV float EXP2(float x) { return __builtin_amdgcn_exp2f(x); }
DEV float LOG2(float x) { return __builtin_amdgcn_logf(x); }
DEV float RCP(float x) { return __builtin_amdgcn_rcpf(x); }
DEV float RSQ(float x) { return __builtin_amdgcn_rsqf(x); }
typedef float f32x2_t __attribute__((ext_vector_type(2))); typedef __bf16 bf16x2_t __attribute__((ext_vector_type(2)));
DEV unsigned pk2(float lo, float hi) { f32x2_t v = {lo, hi}; bf16x2_t b = __builtin_convertvector(v, bf16x2_t); return __builtin_bit_cast(unsigned, b); }
DEV f32x16 mfma32(bf16x8 a, bf16x8 b, f32x16 c) { return __builtin_amdgcn_mfma_f32_32x32x16_bf16(a, b, c, 0, 0, 0); }
DEV float uaf(unsigned u) { return __uint_as_float(u); }
#define LDS_WAIT() asm volatile("s_waitcnt lgkmcnt(0)" ::: "memory")
#define SCHED_BAR() __builtin_amdgcn_sched_barrier(0)
DEV int opaque_v(int x) { asm volatile("" : "+v"(x)); return x; }
#define VM_WAIT() asm volatile("s_waitcnt vmcnt(0)" ::: "memory")
#endif
#ifdef EMU
DEV int lane_id_() { return (int)(threadIdx.x & 63); }
#else
DEV int lane_id_() { int x; asm volatile("v_mbcnt_lo_u32_b32 %0, -1, 0\n\tv_mbcnt_hi_u32_b32 %0, -1, %0" : "=v"(x)); return x; }
#endif
DEV float bflo(unsigned w) { return uaf(w << 16); }
DEV float bfhi(unsigned w) { return uaf(w & 0xffff0000u); }
DEV float bf2f(bf16 b) { return uaf((unsigned)b << 16); }
DEV float sigmoidf_(float x) { return RCP(1.0f + EXP2(-x * LOG2E)); }
DEV float siluf_(float x) { return x * sigmoidf_(x); }
DEV float softplusf_(float x) { return fmaxf(x, 0.f) + LN2 * LOG2(1.0f + EXP2(-fabsf(x) * LOG2E)); }
DEV int crow(int reg, int h) { return (reg & 3) + 8 * (reg >> 2) + 4 * h; }
DEV float wave_sum(float v) {
#pragma unroll
    for (int o = 1; o < 64; o <<= 1) v += __shfl_xor(v, o);
    return v;
}
DEV bf16x8 pack_step(const f32x16& x, int s) {
    v4u p; p.x = pk2(x[8 * s], x[8 * s + 1]); p.y = pk2(x[8 * s + 2], x[8 * s + 3]); p.z = pk2(x[8 * s + 4], x[8 * s + 5]); p.w = pk2(x[8 * s + 6], x[8 * s + 7]);
    return __builtin_bit_cast(bf16x8, p);
}
DEV bf16x8 rd16(const LAS unsigned char* p) { return *(const LAS bf16x8*)p; }
DEV bf16x8 rd8x2(const LAS unsigned char* p) {
    const v2u a = *(const LAS v2u*)p, b = *(const LAS v2u*)(p + 16); v4u r; r.x = a.x; r.y = a.y; r.z = b.x; r.w = b.y; return __builtin_bit_cast(bf16x8, r);
}

struct Frame {
    LAS unsigned char* lds;
    unsigned* ctl;
    int wave, G, vcu;
    DEV int lane() const { return lane_id_(); }
    DEV int tid() const { return wave * 64 + lane_id_(); }
    const float* const* in; float* out; unsigned char* ws;
#define WSP(T, NAME, OFF) DEV T* NAME() const { return (T*)(ws + OFF); }
    WSP(bf16, WinT, WS_WIN) WSP(bf16, WssdT, WS_WSSD) WSP(bf16, WattT, WS_WATT) WSP(bf16, WoT, WS_WO) WSP(bf16, WffT, WS_WFF) WSP(bf16, Wff2T, WS_WFF2)
    WSP(bf16, XN, WS_XN) WSP(bf16, Z, WS_Z) WSP(bf16, XBC, WS_XBC) WSP(bf16, Q, WS_Q) WSP(bf16, K, WS_K) WSP(bf16, V, WS_V) WSP(bf16, GS, WS_GS) WSP(bf16, GA, WS_GA) WSP(bf16, U, WS_U) WSP(bf16, O, WS_O)
    WSP(bf16, MIX, WS_MIX) WSP(bf16, TMP, WS_TMP) WSP(bf16, HB, WS_HB) WSP(float, DT, WS_DT) WSP(bf16, T1, WS_T1) WSP(bf16, T2, WS_T2)
#undef WSP
};
enum { I_XP = 0, I_XS, I_CK, I_CV, I_SSM, I_SCONV, I_META, I_RELB, I_NPRE, I_WIN, I_CONVW, I_CONVB, I_DTB, I_ALOG, I_DSKIP, I_SSDN, I_WSSD, I_LQ1, I_LK1, I_LQ2, I_LK2, I_SUBLN, I_WATT, I_WO, I_NPOST, I_NFFN, I_WFF, I_WFF2, I_NFFNP };

DEV void p0_transpose_item(const float* W, int K, int N, int src_col0, bf16* WT, int dst_row0, LAS float* scr, int kb, int lane) {
    const int k0 = 64 * kb;
#pragma unroll 8
    for (int i = 0; i < 32; ++i) { const int kk = 2 * i + (lane >> 5); scr[kk * 33 + (lane & 31)] = src_col0 >= 0 ? W[(size_t)(k0 + kk) * N + src_col0 + (lane & 31)] : 0.f; }
    WAVE_LDS_SYNC();
    const int c = lane & 7;
#pragma unroll
    for (int j = 0; j < 4; ++j) { const int n = (lane >> 3) + 8 * j; const LAS float* s = scr + (8 * c) * 33 + n;
        v4u o; o.x = pk2(s[0 * 33], s[1 * 33]); o.y = pk2(s[2 * 33], s[3 * 33]); o.z = pk2(s[4 * 33], s[5 * 33]); o.w = pk2(s[6 * 33], s[7 * 33]);
        *(v4u*)(WT + (size_t)(dst_row0 + n) * K + k0 + 8 * c) = o; }
    WAVE_LDS_SYNC();
}
DEV void rms_row_to_bf16(const float* xrow, const float* gain, bf16* orow, int lane) {
    unsigned long long* o8 = (unsigned long long*)orow + lane;
    if (!xrow) {
#pragma unroll
        for (int j = 0; j < 4; ++j) o8[64 * j] = 0ull;
        return; }
    const f32x4* xr = (const f32x4*)xrow + lane; const f32x4* gr = (const f32x4*)gain + lane;
    f32x4 v[4]; float s = 0.f;
#pragma unroll
    for (int j = 0; j < 4; ++j) { v[j] = xr[64 * j]; s += (v[j].x * v[j].x + v[j].y * v[j].y) + (v[j].z * v[j].z + v[j].w * v[j].w); }
    const float r = RSQ(wave_sum(s) * (1.f / D) + EPS);
#pragma unroll
    for (int j = 0; j < 4; ++j) { const f32x4 g = gr[64 * j]; o8[64 * j] = (unsigned long long)pk2(v[j].x * r * g.x, v[j].y * r * g.y) | ((unsigned long long)pk2(v[j].z * r * g.z, v[j].w * r * g.w) << 32); }
}
DEV const float* x_row_ptr(const Frame& F, int m) {
    if (m < MP) return F.in[I_XP] + (size_t)m * D;
    if (m < MMAIN) return F.in[I_XS] + (size_t)(m - MP) * D;
    if (m < MMAIN + NMETA) return F.in[I_META] + (size_t)(m - MMAIN) * D;
    return nullptr;
}
DEV void p0_prologue(Frame& F) {
    LAS float* scr = (LAS float*)(F.lds + RING_OFF + F.wave * 16384);
    const int gw = F.vcu * NWAVES + F.wave, NGW = F.G * NWAVES;
    constexpr int I_IN = (D / 64) * (NPROJ / 32), I_SSD = (DIN / 64) * (D / 32), I_ATT = (D / 64) * (D / 32), I_O = I_ATT, I_FF = (D / 64) * (2 * DFF / 32), I_FF2 = (DFF / 64) * (D / 32);
    constexpr int NITEMS = I_IN + I_SSD + I_ATT + I_O + I_FF + I_FF2;
    for (int it = gw; it < NITEMS; it += NGW) {
        int r = it;
        if (r < I_IN) {
            const int nblk = NPROJ / 32, kb = r / nblk, n0 = 32 * (r % nblk);
            const int src = n0 < 6144 ? n0 : (n0 < 11264 ? n0 + 32 : (n0 == 11264 ? 6144 : -1));
            p0_transpose_item(F.in[I_WIN], D, 11296, src, F.WinT(), n0, scr, kb, F.lane()); continue; } r -= I_IN;
        if (r < I_SSD) { const int nblk = D / 32; p0_transpose_item(F.in[I_WSSD], DIN, D, 32 * (r % nblk), F.WssdT(), 32 * (r % nblk), scr, r / nblk, F.lane()); continue; } r -= I_SSD;
        if (r < I_ATT) { const int nblk = D / 32; p0_transpose_item(F.in[I_WATT], D, D, 32 * (r % nblk), F.WattT(), 32 * (r % nblk), scr, r / nblk, F.lane()); continue; } r -= I_ATT;
        if (r < I_O) { const int nblk = D / 32; p0_transpose_item(F.in[I_WO], D, D, 32 * (r % nblk), F.WoT(), 32 * (r % nblk), scr, r / nblk, F.lane()); continue; } r -= I_O;
        if (r < I_FF) {
            const int nblk = 2 * DFF / 32, kb = r / nblk, n0 = 32 * (r % nblk), t = n0 / 256, w = n0 % 256;
            const int src = w < 128 ? 128 * t + w : DFF + 128 * t + (w - 128);
            p0_transpose_item(F.in[I_WFF], D, 2 * DFF, src, F.WffT(), n0, scr, kb, F.lane()); continue; } r -= I_FF;
        { const int nblk = D / 32; p0_transpose_item(F.in[I_WFF2], DFF, D, 32 * (r % nblk), F.Wff2T(), 32 * (r % nblk), scr, r / nblk, F.lane()); }
    }
    for (int m = gw; m < MALL; m += 2 * NGW) {
        const int m2 = m + NGW; const float* x1 = x_row_ptr(F, m); const float* x2 = m2 < MALL ? x_row_ptr(F, m2) : nullptr;
        const f32x4* gr = (const f32x4*)F.in[I_NPRE] + F.lane(); f32x4 v1[4], v2[4]; float s1 = 0.f, s2 = 0.f;
#pragma unroll
        for (int jj = 0; jj < 4; ++jj) { const f32x4 z = {0.f, 0.f, 0.f, 0.f}; v1[jj] = x1 ? ((const f32x4*)x1 + F.lane())[64 * jj] : z; v2[jj] = x2 ? ((const f32x4*)x2 + F.lane())[64 * jj] : z; }
#pragma unroll
        for (int jj = 0; jj < 4; ++jj) { s1 += (v1[jj].x * v1[jj].x + v1[jj].y * v1[jj].y) + (v1[jj].z * v1[jj].z + v1[jj].w * v1[jj].w); s2 += (v2[jj].x * v2[jj].x + v2[jj].y * v2[jj].y) + (v2[jj].z * v2[jj].z + v2[jj].w * v2[jj].w); }
        const float r1 = RSQ(wave_sum(s1) * (1.f / D) + EPS), r2 = RSQ(wave_sum(s2) * (1.f / D) + EPS);
        unsigned long long* o1 = (unsigned long long*)(F.XN() + (size_t)m * D) + F.lane(); unsigned long long* o2 = (unsigned long long*)(F.XN() + (size_t)m2 * D) + F.lane();
#pragma unroll
        for (int jj = 0; jj < 4; ++jj) { const f32x4 gq = gr[64 * jj];
            o1[64 * jj] = (unsigned long long)pk2(v1[jj].x * r1 * gq.x, v1[jj].y * r1 * gq.y) | ((unsigned long long)pk2(v1[jj].z * r1 * gq.z, v1[jj].w * r1 * gq.w) << 32);
            if (m2 < MALL) o2[64 * jj] = (unsigned long long)pk2(v2[jj].x * r2 * gq.x, v2[jj].y * r2 * gq.y) | ((unsigned long long)pk2(v2[jj].z * r2 * gq.z, v2[jj].w * r2 * gq.w) << 32); }
    }
}

namespace pg8 {
struct EpiProj {
    static constexpr bool PERM = true, AFTER_DRAIN = false;
    bf16 *Z, *XBC, *Q, *K, *V, *GS, *GA; float* DT; const float* dtb; float* out;
    __device__ __forceinline__ void operator()(const f32x4 (&acc)[2][2][4][2], const Unit& u, int wr, int wc, int fr, int fq) const {
        const int t = u.pn;
        if (t == 44) {
            if (wc != 0) return;
            const f32x4 b0 = *(const f32x4*)(dtb + 8 * fq), b1 = *(const f32x4*)(dtb + 8 * fq + 4);
#pragma unroll
            for (int ai = 0; ai < 2; ++ai)
#pragma unroll
                for (int m = 0; m < 4; ++m) { const int r = u.pm * 256 + ai * 128 + wr * 64 + m * 16 + fr; f32x4 v0 = acc[ai][0][m][0] + b0, v1 = acc[ai][0][m][1] + b1;
#pragma unroll
                    for (int e = 0; e < 4; ++e) { v0[e] = softplusf_(v0[e]); v1[e] = softplusf_(v1[e]); }
                    *(f32x4*)(DT + (size_t)r * 32 + 8 * fq) = v0; *(f32x4*)(DT + (size_t)r * 32 + 8 * fq + 4) = v1; }
            return; }
        bf16* base; int ld, c0; int kind;
        if (t < 8) { base = Z; ld = DIN; c0 = 256 * t; kind = 0; }
        else if (t < 24) { base = XBC; ld = CONVD; c0 = 256 * (t - 8); kind = 1; }
        else if (t < 28) { base = Q; ld = D; c0 = 256 * (t - 24); kind = 2; }
        else if (t < 32) { base = K; ld = D; c0 = 256 * (t - 28); kind = 3; }
        else if (t < 36) { base = V; ld = D; c0 = 256 * (t - 32); kind = 4; }
        else if (t < 40) { base = GS; ld = D; c0 = 256 * (t - 36); kind = 5; }
        else { base = GA; ld = D; c0 = 256 * (t - 40); kind = 5; }
#pragma unroll
        for (int ai = 0; ai < 2; ++ai)
#pragma unroll
            for (int m = 0; m < 4; ++m) { const int r = u.pm * 256 + ai * 128 + wr * 64 + m * 16 + fr;
#pragma unroll
                for (int bj = 0; bj < 2; ++bj) { const int col = c0 + bj * 128 + wc * 32 + 8 * fq; f32x4 v0 = acc[ai][bj][m][0], v1 = acc[ai][bj][m][1];
                    if (kind == 1) {
                        float* dst = nullptr;
                        if (r < MP) { const int tt = r % SEQ; if (tt >= SEQ - 3) dst = out + OUT_CP + ((size_t)(r / SEQ) * 3 + (tt - (SEQ - 3))) * CONVD + col; }
                        else if (r < MMAIN) { const int tt = (r - MP) % DSEQ; if (tt >= DSEQ - 3) dst = out + OUT_CS + ((size_t)((r - MP) / DSEQ) * 3 + (tt - (DSEQ - 3))) * CONVD + col; }
                        if (dst) { *(f32x4*)dst = v0; *(f32x4*)(dst + 4) = v1; } }
                    if (kind == 3 || kind == 4) {
                        const size_t op = kind == 3 ? OUT_KP : OUT_VP, os = kind == 3 ? OUT_KS : OUT_VS;
                        if (r < MP) { float* dst = out + op + ((size_t)(r / SEQ) * LEXT + NMETA + (r % SEQ)) * 1024 + col; *(f32x4*)dst = v0; *(f32x4*)(dst + 4) = v1; }
                        else if (r < MMAIN) { float* dst = out + os + (size_t)(r - MP) * 1024 + col; *(f32x4*)dst = v0; *(f32x4*)(dst + 4) = v1; }
                        else if (r < MMAIN + NMETA) { for (int b = 0; b < BATCH; ++b) { float* dst = out + op + ((size_t)b * LEXT + (r - MMAIN)) * 1024 + col; *(f32x4*)dst = v0; *(f32x4*)(dst + 4) = v1; } } }
                    if (kind == 2) { v0 = v0 * QSCALE; v1 = v1 * QSCALE; }
                    if (kind == 5) {
#pragma unroll
                        for (int e = 0; e < 4; ++e) { v0[e] = sigmoidf_(v0[e]); v1[e] = sigmoidf_(v1[e]); } }
                    u32x4 w; w.x = cvt_pk_bf16(v0[0], v0[1]); w.y = cvt_pk_bf16(v0[2], v0[3]); w.z = cvt_pk_bf16(v1[0], v1[1]); w.w = cvt_pk_bf16(v1[2], v1[3]);
                    *(u32x4*)(base + (size_t)r * ld + col) = w; } }
    }
};
template <int SECOND> struct EpiGate {
    static constexpr bool PERM = true, AFTER_DRAIN = false;
    const bf16* G; const bf16* T; bf16* O;
    __device__ __forceinline__ void operator()(const f32x4 (&acc)[2][2][4][2], const Unit& u, int wr, int wc, int fr, int fq) const {
#pragma unroll
        for (int ai = 0; ai < 2; ++ai)
#pragma unroll
            for (int m = 0; m < 4; ++m) { const int r = u.pm * 256 + ai * 128 + wr * 64 + m * 16 + fr;
#pragma unroll
                for (int bj = 0; bj < 2; ++bj) { const size_t off = (size_t)r * D + u.pn * 256 + bj * 128 + wc * 32 + 8 * fq;
                    const u32x4 g = *(const u32x4*)(G + off); const f32x4 a0 = acc[ai][bj][m][0], a1 = acc[ai][bj][m][1];
                    float v[8] = {a0[0] * bflo(g.x), a0[1] * bfhi(g.x), a0[2] * bflo(g.y), a0[3] * bfhi(g.y), a1[0] * bflo(g.z), a1[1] * bfhi(g.z), a1[2] * bflo(g.w), a1[3] * bfhi(g.w)};
                    if (SECOND) { const u32x4 tv = *(const u32x4*)(T + off);
                        v[0] += bflo(tv.x); v[1] += bfhi(tv.x); v[2] += bflo(tv.y); v[3] += bfhi(tv.y); v[4] += bflo(tv.z); v[5] += bfhi(tv.z); v[6] += bflo(tv.w); v[7] += bfhi(tv.w); }
                    u32x4 w; w.x = cvt_pk_bf16(v[0], v[1]); w.y = cvt_pk_bf16(v[2], v[3]); w.z = cvt_pk_bf16(v[4], v[5]); w.w = cvt_pk_bf16(v[6], v[7]);
                    *(u32x4*)(O + off) = w; } }
    }
};
struct EpiF32 {
    static constexpr bool PERM = false, AFTER_DRAIN = false;
    float* O; int ldc;
    __device__ __forceinline__ void operator()(const f32x4 (&acc)[2][2][4][2], const Unit& u, int wr, int wc, int fr, int fq) const {
#pragma unroll
        for (int ai = 0; ai < 2; ++ai)
#pragma unroll
            for (int m = 0; m < 4; ++m) { float* rowp = O + (size_t)(u.pm * 256 + ai * 128 + wr * 64 + m * 16 + fr) * ldc + u.pn * 256 + wc * 32 + 4 * fq;
#pragma unroll
                for (int bj = 0; bj < 2; ++bj)
#pragma unroll
                    for (int n = 0; n < 2; ++n) *(f32x4*)(rowp + bj * 128 + n * 16) = acc[ai][bj][m][n]; }
    }
};
struct EpiT {
    static constexpr bool PERM = true, AFTER_DRAIN = false;
    bf16* O; int ldc;
    __device__ __forceinline__ void operator()(const f32x4 (&acc)[2][2][4][2], const Unit& u, int wr, int wc, int fr, int fq) const {
#pragma unroll
        for (int ai = 0; ai < 2; ++ai)
#pragma unroll
            for (int m = 0; m < 4; ++m) { bf16* rowp = O + (size_t)(u.pm * 256 + ai * 128 + wr * 64 + m * 16 + fr) * ldc + u.pn * 256 + wc * 32 + 8 * fq;
#pragma unroll
                for (int bj = 0; bj < 2; ++bj) { const f32x4 v0 = acc[ai][bj][m][0], v1 = acc[ai][bj][m][1];
                    u32x4 w; w.x = cvt_pk_bf16(v0[0], v0[1]); w.y = cvt_pk_bf16(v0[2], v0[3]); w.z = cvt_pk_bf16(v1[0], v1[1]); w.w = cvt_pk_bf16(v1[2], v1[3]);
                    *(u32x4*)(rowp + bj * 128) = w; } }
    }
};
struct EpiSwiglu {
    static constexpr bool PERM = true, AFTER_DRAIN = false;
    bf16* O;
    __device__ __forceinline__ void operator()(const f32x4 (&acc)[2][2][4][2], const Unit& u, int wr, int wc, int fr, int fq) const {
#pragma unroll
        for (int ai = 0; ai < 2; ++ai)
#pragma unroll
            for (int m = 0; m < 4; ++m) { const int r = u.pm * 256 + ai * 128 + wr * 64 + m * 16 + fr;
                const f32x4 g0 = acc[ai][0][m][0], g1 = acc[ai][0][m][1], u0 = acc[ai][1][m][0], u1 = acc[ai][1][m][1]; float v[8];
#pragma unroll
                for (int e = 0; e < 4; ++e) { v[e] = siluf_(g0[e]) * u0[e]; v[4 + e] = siluf_(g1[e]) * u1[e]; }
                u32x4 w; w.x = cvt_pk_bf16(v[0], v[1]); w.y = cvt_pk_bf16(v[2], v[3]); w.z = cvt_pk_bf16(v[4], v[5]); w.w = cvt_pk_bf16(v[6], v[7]);
                *(u32x4*)(O + (size_t)r * DFF + u.pn * 128 + wc * 32 + 8 * fq) = w; }
    }
};
}
constexpr int S_XT = 0, S_BM = 36864, S_BT = S_BM + 17408, S_CM = S_BT + 18432, S_ZU = S_CM + 17408, S_ACS = S_ZU + 33792, S_DTV = S_ACS + 1024, S_WSC = S_DTV + 1024, S_SSQ = S_WSC + 1024, S_END = S_SSQ + 2048;
constexpr int XT_P = 144, BM_P = 272, ZU_P = 528;
static_assert(S_END <= RING_BYTES, "SSD LDS map");
struct SsdChunk { int row0; int t0, t1, halo; bool store_y; };

DEV v4u ssd_raw_row(const Frame& F, const SsdChunk& ck, int sb, int tp, int col) {
    const v4u zero = {0u, 0u, 0u, 0u};
    if (tp >= ck.t0 && tp < ck.t1) return *(const v4u*)(F.XBC() + (int)(ck.row0 + tp) * CONVD + col);
    if (tp < ck.t0 && tp >= ck.t0 - 3) {
        if (ck.halo == 1) return *(const v4u*)(F.XBC() + (int)(ck.row0 + tp) * CONVD + col);
        if (ck.halo == 2) return *(const v4u*)(F.XBC() + (int)(MMAIN + NMETA + (tp - ck.t0)) * CONVD + col);
        if (ck.halo == 3) { const float* s = F.in[I_SCONV] + ((int)sb * 3 + (3 + tp - ck.t0)) * CONVD + col; const f32x4 a = *(const f32x4*)s, b = *(const f32x4*)(s + 4);
            v4u r; r.x = pk2(a.x, a.y); r.y = pk2(a.z, a.w); r.z = pk2(b.x, b.y); r.w = pk2(b.z, b.w); return r; }
    }
    return zero;
}
DEV unsigned hw_(unsigned w, int h) { return h ? (w >> 16) : (w & 0xffffu); }

DEV void ssd_prefetch(const Frame& F, const SsdChunk& ck, int sb, int g, int lane, int tid, int w, v4u (&raw)[11], v4u (&zr)[4], float& dtv) {
    const int cg = lane, to = w;
    const int col = cg < 32 ? 256 * g + 8 * cg : (cg < 48 ? 2048 + 128 * g + 8 * (cg - 32) : 3072 + 128 * g + 8 * (cg - 48));
#pragma unroll
    for (int i = 0; i < 11; ++i) raw[i] = ssd_raw_row(F, ck, sb, 8 * to - 3 + i, col);
    { const int t = tid >> 3, seg = tid & 7; const bool valid = ck.store_y && t >= ck.t0 && t < ck.t1; const v4u zero = {0u, 0u, 0u, 0u};
#pragma unroll
      for (int i = 0; i < 4; ++i) zr[i] = valid ? *(const v4u*)(F.Z() + (int)(ck.row0 + t) * DIN + 256 * g + 32 * seg + 8 * i) : zero; }
    dtv = 0.f;
    if (w < 4) { const int t = lane; if (t >= ck.t0 && t < ck.t1) dtv = F.DT()[(int)(ck.row0 + t) * 32 + 4 * g + w]; }
}
DEV void ssd_chunk(Frame& F, const SsdChunk& ck, bool has_next, const SsdChunk& ckn, int sb, int g, f32x16 (&hacc)[4], v4u (&raw)[11], v4u (&zr)[4], float& dtv) {
    LAS unsigned char* L = F.lds + RING_OFF;
    const int lane = opaque_v(F.lane()), tid = opaque_v(F.tid()), w = F.wave, l31 = lane & 31, hh = lane >> 5, h = w >> 1, j = w & 1;
    __syncthreads();
    if (w < 4) {
        const int t = lane;
        const float a = -EXP2(F.in[I_ALOG][4 * g + w] * LOG2E);
        float x = dtv * a;
#pragma unroll
        for (int d = 1; d < 64; d <<= 1) { const float v = __shfl_up(x, d); if (lane >= d) x += v; }
        const float last = __shfl(x, 63);
        ((LAS float*)(L + S_ACS))[w * 64 + t] = x; ((LAS float*)(L + S_DTV))[w * 64 + t] = dtv; ((LAS float*)(L + S_WSC))[w * 64 + t] = EXP2((last - x) * LOG2E) * dtv;
    }
    SCHED_BAR();
    {
        const int cg = lane, to = w;
        const int col = cg < 32 ? 256 * g + 8 * cg : (cg < 48 ? 2048 + 128 * g + 8 * (cg - 32) : 3072 + 128 * g + 8 * (cg - 48));
        const float* cw = F.in[I_CONVW] + col; const float* cb = F.in[I_CONVB] + col;
        unsigned pk[8][4];
#pragma unroll
        for (int e2 = 0; e2 < 4; ++e2) {
            float wgt[4][2], bias[2];
#pragma unroll
            for (int i = 0; i < 4; ++i) { wgt[i][0] = cw[i * CONVD + 2 * e2]; wgt[i][1] = cw[i * CONVD + 2 * e2 + 1]; }
            bias[0] = cb[2 * e2]; bias[1] = cb[2 * e2 + 1];
#pragma unroll
            for (int tt = 0; tt < 8; ++tt) { float a0 = bias[0], a1 = bias[1];
#pragma unroll
                for (int i = 0; i < 4; ++i) { const unsigned rw = raw[tt + i][e2]; a0 += wgt[i][0] * bflo(rw); a1 += wgt[i][1] * bfhi(rw); }
                pk[tt][e2] = pk2(siluf_(a0), siluf_(a1)); }
            SCHED_BAR();
        }
        if (cg < 48) {
            LAS unsigned char* base = cg < 32 ? L + S_XT + (8 * cg) * XT_P : L + S_BT + (8 * (cg - 32)) * XT_P;
#pragma unroll
            for (int e = 0; e < 8; ++e) { v4u o;
                o.x = hw_(pk[0][e >> 1], e & 1) | (hw_(pk[1][e >> 1], e & 1) << 16); o.y = hw_(pk[2][e >> 1], e & 1) | (hw_(pk[3][e >> 1], e & 1) << 16);
                o.z = hw_(pk[4][e >> 1], e & 1) | (hw_(pk[5][e >> 1], e & 1) << 16); o.w = hw_(pk[6][e >> 1], e & 1) | (hw_(pk[7][e >> 1], e & 1) << 16);
                *(LAS v4u*)(base + e * XT_P + 16 * to) = o; }
        }
        if (cg >= 32) {
            LAS unsigned char* base = cg < 48 ? L + S_BM + 16 * (cg - 32) : L + S_CM + 16 * (cg - 48);
#pragma unroll
            for (int tt = 0; tt < 8; ++tt) { v4u o; o.x = pk[tt][0]; o.y = pk[tt][1]; o.z = pk[tt][2]; o.w = pk[tt][3]; *(LAS v4u*)(base + (8 * to + tt) * BM_P) = o; }
        }
    }
    SCHED_BAR();
    {
        const int t = tid >> 3, seg = tid & 7;
#pragma unroll
        for (int i = 0; i < 4; ++i) *(LAS v4u*)(L + S_ZU + t * ZU_P + seg * 64 + 16 * i) = zr[i];
    }
    SCHED_BAR();
    if (has_next) ssd_prefetch(F, ckn, sb, g, lane, tid, w, raw, zr, dtv);
    __syncthreads();
    const LAS float* ACS = (const LAS float*)(L + S_ACS) + h * 64; const LAS float* DTV = (const LAS float*)(L + S_DTV) + h * 64; const LAS float* WSC = (const LAS float*)(L + S_WSC) + h * 64;
    const LAS float* acs_l = ACS + l31;
    const LAS float* acs_h = ACS + 4 * hh;  const LAS float* dtv_h = DTV + 4 * hh;
    const LAS float* wsc_h = WSC + 8 * hh;
    const LAS unsigned char* cm4 = L + S_CM + l31 * BM_P + 8 * hh;
    const LAS unsigned char* cm8 = L + S_CM + l31 * BM_P + 16 * hh;
    const LAS unsigned char* bm8 = L + S_BM + l31 * BM_P + 16 * hh;
    const LAS unsigned char* xt4 = L + S_XT + (64 * h + 32 * j + l31) * XT_P + 8 * hh;
    const LAS unsigned char* xt8 = L + S_XT + (64 * h + 32 * j + l31) * XT_P + 16 * hh;
    const LAS unsigned char* bt8 = L + S_BT + l31 * XT_P + 16 * hh;
    f32x16 yacc[2];
#pragma unroll
    for (int tb = 0; tb < 2; ++tb)
#pragma unroll
        for (int r = 0; r < 16; ++r) yacc[tb][r] = 0.f;
#pragma unroll
    for (int nb = 0; nb < 4; ++nb)
#pragma unroll
        for (int ss = 0; ss < 2; ++ss) { const bf16x8 a = pack_step(hacc[nb], ss);
#pragma unroll
            for (int tb = 0; tb < 2; ++tb) { const bf16x8 b = rd8x2(cm4 + 32 * tb * BM_P + (32 * nb + 16 * ss) * 2); yacc[tb] = mfma32(a, b, yacc[tb]); }
            SCHED_BAR(); }
    float acs_t[2];
#pragma unroll
    for (int tb = 0; tb < 2; ++tb) { acs_t[tb] = acs_l[32 * tb]; const float e = EXP2(acs_t[tb] * LOG2E);
#pragma unroll
        for (int r = 0; r < 16; ++r) yacc[tb][r] *= e; }
    const int dl = l31 - 4 * hh;
#pragma unroll
    for (int tile = 0; tile < 3; ++tile) { const int sb2 = tile == 2 ? 1 : 0, tb = tile == 0 ? 0 : 1;
        SCHED_BAR();
        f32x16 gt;
#pragma unroll
        for (int r = 0; r < 16; ++r) gt[r] = 0.f;
#pragma unroll
        for (int ks = 0; ks < 8; ++ks) { const bf16x8 a = rd16(bm8 + 32 * sb2 * BM_P + 32 * ks), b = rd16(cm8 + 32 * tb * BM_P + 32 * ks); gt = mfma32(a, b, gt); if (ks & 1) SCHED_BAR(); }
        SCHED_BAR();
#pragma unroll
        for (int r = 0; r < 16; ++r) { const int so = 32 * sb2 + (r & 3) + 8 * (r >> 2); const float v = gt[r] * EXP2((acs_t[tb] - acs_h[so]) * LOG2E) * dtv_h[so];
            gt[r] = (tile == 1 || (r & 3) + 8 * (r >> 2) <= dl) ? v : 0.f; }
        SCHED_BAR();
#pragma unroll
        for (int ss = 0; ss < 2; ++ss) { const bf16x8 b = pack_step(gt, ss), a = rd8x2(xt4 + (32 * sb2 + 16 * ss) * 2); yacc[tb] = mfma32(a, b, yacc[tb]); }
    }
    SCHED_BAR();
    { const float dec = EXP2(ACS[63] * LOG2E);
#pragma unroll
      for (int nb = 0; nb < 4; ++nb)
#pragma unroll
          for (int r = 0; r < 16; ++r) hacc[nb][r] *= dec;
#pragma unroll
      for (int ks = 0; ks < 4; ++ks) { const v4u xr = __builtin_bit_cast(v4u, rd16(xt8 + 32 * ks));
          const f32x4 w0 = *(const LAS f32x4*)(wsc_h + 16 * ks), w1 = *(const LAS f32x4*)(wsc_h + 16 * ks + 4);
          v4u xs; xs.x = pk2(bflo(xr.x) * w0.x, bfhi(xr.x) * w0.y); xs.y = pk2(bflo(xr.y) * w0.z, bfhi(xr.y) * w0.w); xs.z = pk2(bflo(xr.z) * w1.x, bfhi(xr.z) * w1.y); xs.w = pk2(bflo(xr.w) * w1.z, bfhi(xr.w) * w1.w);
          const bf16x8 b = __builtin_bit_cast(bf16x8, xs);
#pragma unroll
          for (int nb = 0; nb < 4; ++nb) { const bf16x8 a = rd16(bt8 + 32 * nb * XT_P + 32 * ks); hacc[nb] = mfma32(a, b, hacc[nb]); }
          SCHED_BAR(); }
    }
    SCHED_BAR();
    if (!ck.store_y) return;
    const float Dh = F.in[I_DSKIP][4 * g + h];
    const LAS unsigned char* zu_l = L + S_ZU + l31 * ZU_P + (64 * h + 32 * j + 4 * hh) * 2;
    const LAS unsigned char* xt_l = L + S_XT + (64 * h + 32 * j + 4 * hh) * XT_P + l31 * 2;
    LAS float* ssq_l = (LAS float*)(L + S_SSQ) + l31;
    float ssq[2] = {0.f, 0.f};
#pragma unroll
    for (int tb = 0; tb < 2; ++tb) {
#pragma unroll
        for (int q4 = 0; q4 < 4; ++q4) { const v2u zw = *(const LAS v2u*)(zu_l + 32 * tb * ZU_P + 16 * q4);
#pragma unroll
            for (int e = 0; e < 4; ++e) { const int r = 4 * q4 + e; const float x = bf2f(*(const LAS bf16*)(xt_l + (8 * q4 + e) * XT_P + 64 * tb));
                const unsigned zz = e < 2 ? zw.x : zw.y; const float z = (e & 1) ? bfhi(zz) : bflo(zz);
                const float u = (yacc[tb][r] + Dh * x) * siluf_(z); yacc[tb][r] = u; ssq[tb] += u * u; } }
        const float sq = ssq[tb] + __shfl_xor(ssq[tb], 32);
        if (hh == 0) ssq_l[64 * w + 32 * tb] = sq; }
    __syncthreads();
    const float* gn_l = F.in[I_SSDN] + 256 * g + 64 * h + 32 * j + 4 * hh;
#pragma unroll
    for (int tb = 0; tb < 2; ++tb) { float tot = 0.f;
#pragma unroll
        for (int ww = 0; ww < 8; ++ww) tot += ssq_l[64 * ww + 32 * tb];
        const float rstd = RSQ(tot * (1.f / 256.f) + EPS);
#pragma unroll
        for (int q4 = 0; q4 < 4; ++q4) { const f32x4 gn = *(const f32x4*)(gn_l + 8 * q4);
            v2u o; o.x = pk2(yacc[tb][4 * q4] * rstd * gn.x, yacc[tb][4 * q4 + 1] * rstd * gn.y); o.y = pk2(yacc[tb][4 * q4 + 2] * rstd * gn.z, yacc[tb][4 * q4 + 3] * rstd * gn.w);
            *(LAS v2u*)((LAS unsigned char*)zu_l + 32 * tb * ZU_P + 16 * q4) = o; } }
    __syncthreads();
    { const int t = tid >> 3, seg = tid & 7;
      if (t >= ck.t0 && t < ck.t1) {
#pragma unroll
          for (int i = 0; i < 4; ++i) *(v4u*)(F.U() + (int)(ck.row0 + t) * DIN + 256 * g + 32 * seg + 8 * i) = *(const LAS v4u*)(L + S_ZU + t * ZU_P + seg * 64 + 16 * i); } }
}
DEV void ssd_unit(Frame& F, int kind, int sb, int g) {
    const int w = F.wave, h = w >> 1, j = w & 1, head = 4 * g + h;
    f32x16 hacc[4];
    if (kind == 0) {
#pragma unroll
        for (int nb = 0; nb < 4; ++nb)
#pragma unroll
            for (int r = 0; r < 16; ++r) hacc[nb][r] = 0.f;
    } else {
        const int lane = opaque_v(F.lane()), l31 = lane & 31, hh = lane >> 5;
        const float* src = F.in[I_SSM] + (((int)sb * NSH + head) * 64 + 32 * j + l31) * DST;
#pragma unroll
        for (int nb = 0; nb < 4; ++nb)
#pragma unroll
            for (int q4 = 0; q4 < 4; ++q4) { const f32x4 v = *(const f32x4*)(src + 32 * nb + 8 * q4 + 4 * hh); hacc[nb][4 * q4] = v.x; hacc[nb][4 * q4 + 1] = v.y; hacc[nb][4 * q4 + 2] = v.z; hacc[nb][4 * q4 + 3] = v.w; }
    }
    v4u raw[11], zr[4]; float dtv;
    const int lane0 = opaque_v(F.lane()), tid0 = opaque_v(F.tid());
    if (kind == 0) {
        SsdChunk ck, ckn; ck.row0 = MMAIN - 48; ck.t0 = 48; ck.t1 = 64; ck.halo = 0; ck.store_y = false;
        ssd_prefetch(F, ck, sb, g, lane0, tid0, w, raw, zr, dtv);
        for (int c = -1; c < SEQ / 64; ++c) {
            ckn.row0 = sb * SEQ + 64 * (c + 1); ckn.t0 = 0; ckn.t1 = 64; ckn.halo = c + 1 == 0 ? 2 : 1; ckn.store_y = true;
            ssd_chunk(F, ck, c + 1 < SEQ / 64, ckn, sb, g, hacc, raw, zr, dtv);
            ck = ckn;
        }
    } else {
        SsdChunk ck; ck.row0 = MP + DSEQ * sb; ck.t0 = 0; ck.t1 = DSEQ; ck.halo = 3; ck.store_y = true;
        ssd_prefetch(F, ck, sb, g, lane0, tid0, w, raw, zr, dtv);
        ssd_chunk(F, ck, false, ck, sb, g, hacc, raw, zr, dtv);
    }
    const int lane = opaque_v(F.lane()), l31 = lane & 31, hh = lane >> 5;
    float* dst = F.out + (kind == 0 ? OUT_SP : OUT_SS) + (((int)sb * NSH + head) * 64 + 32 * j + l31) * DST;
#pragma unroll
    for (int nb = 0; nb < 4; ++nb)
#pragma unroll
        for (int q4 = 0; q4 < 4; ++q4) { f32x4 v; v.x = hacc[nb][4 * q4]; v.y = hacc[nb][4 * q4 + 1]; v.z = hacc[nb][4 * q4 + 2]; v.w = hacc[nb][4 * q4 + 3]; *(f32x4*)(dst + 32 * nb + 8 * q4 + 4 * hh) = v; }
}
constexpr int KT_P = 272, VN_P = 320, A_KBUF = 64 * KT_P, A_VBUF = 64 * VN_P, A_K0 = 0, A_V0 = 2 * A_KBUF, A_BIAS = A_V0 + 3 * A_VBUF, A_QF = A_BIAS + 1280, A_END = A_QF + 32768;
constexpr float ATT_THR = 8.0f;
#ifndef ATT_STAGGER
#define ATT_STAGGER 1
#endif
static_assert(A_END <= RING_BYTES && 4 * 128 * 32 * 4 <= A_BIAS, "attention LDS map");
struct AttTile { int kind; int row0; const float* ck; const float* cv; int nvalid, kpos0; };
struct AttRegs { v4u r0, r1, r2, r3, r4, r5, r6, r7; };
#ifdef EMU
DEV bool wave_any(bool p) { int v = p ? 1 : 0;
    for (int o = 1; o < 64; o <<= 1) v |= __shfl_xor(v, o);
    return v != 0; }
DEV s16x4 tr_read(const unsigned char* p) {
    const int w = emu::me().tid.x >> 6, l = emu::me().tid.x & 63; memcpy(emu::B->xch[w][l], p, 8); emu::wave_sync();
    s16x4 r; const int g0 = l & ~15, i = l & 15;
    for (int j = 0; j < 4; ++j) r[j] = ((const short*)emu::B->xch[w][g0 + 4 * j + (i >> 2)])[i & 3];
    emu::wave_sync(); return r; }
#else
DEV bool wave_any(bool p) { return __any(p); }
typedef short v4i16_t __attribute__((ext_vector_type(4)));
DEV s16x4 tr_read(const LAS unsigned char* p) { return __builtin_bit_cast(s16x4, __builtin_amdgcn_ds_read_tr16_b64_v4i16((LAS v4i16_t*)p)); }
#endif

template <int ukind> DEV AttTile att_tile(const Frame& F, int sb, int hd, int i) {
    AttTile t; t.ck = nullptr; t.cv = nullptr; t.kind = 0;
    if (i == 0) { t.row0 = MMAIN; t.nvalid = NMETA; t.kpos0 = 0; return t; }
    const int f = i - 1;
    if (ukind == 0) { t.row0 = sb * SEQ + 64 * f; t.nvalid = 64; t.kpos0 = NMETA + 64 * f; return t; }
    if (f < PAST / 64) { t.kind = 1; t.row0 = 0; t.ck = F.in[I_CK] + ((size_t)sb * PAST + 64 * f) * 1024 + 128 * hd; t.cv = F.in[I_CV] + ((size_t)sb * PAST + 64 * f) * 1024 + 128 * hd; t.nvalid = 64; t.kpos0 = NMETA + 64 * f; return t; }
    t.row0 = MP + DSEQ * sb; t.nvalid = DSEQ; t.kpos0 = NMETA + PAST; return t;
}
template <int ukind> DEV void att_load(const Frame& F, const AttTile& t, int hd, AttRegs& R, int tid) {
    tid = opaque_v(tid);
    const int kv = tid >> 3, seg = tid & 7; const v4u zero = {0u, 0u, 0u, 0u}; const bool ok = kv < t.nvalid;
    R.r0 = zero; R.r1 = zero; R.r2 = zero; R.r3 = zero; if (ukind == 1) { R.r4 = zero; R.r5 = zero; R.r6 = zero; R.r7 = zero; }
    if (ukind == 0 || t.kind == 0) {
        const int off = (t.row0 + kv) * D + 128 * hd + 16 * seg; const bf16* kp = F.K() + off; const bf16* vp = F.V() + off;
        if (ok) { R.r0 = *(const v4u*)(kp); R.r1 = *(const v4u*)(kp + 8); R.r2 = *(const v4u*)(vp); R.r3 = *(const v4u*)(vp + 8); }
    } else {
        const float* kp = t.ck + kv * 1024 + 16 * seg; const float* vp = t.cv + kv * 1024 + 16 * seg;
        if (ok) { R.r0 = *(const v4u*)(kp); R.r1 = *(const v4u*)(kp + 4); R.r2 = *(const v4u*)(kp + 8); R.r3 = *(const v4u*)(kp + 12);
                  R.r4 = *(const v4u*)(vp); R.r5 = *(const v4u*)(vp + 4); R.r6 = *(const v4u*)(vp + 8); R.r7 = *(const v4u*)(vp + 12); }
    }
}
DEV v4u pack8_(const v4u a, const v4u b) { v4u o; o.x = pk2(uaf(a.x), uaf(a.y)); o.y = pk2(uaf(a.z), uaf(a.w)); o.z = pk2(uaf(b.x), uaf(b.y)); o.w = pk2(uaf(b.z), uaf(b.w)); return o; }
template <int ukind> DEV void att_store(const AttTile& t, AttRegs& R, LAS unsigned char* kbuf, LAS unsigned char* vbuf, int tid) {
    const int kv = tid >> 3, seg = tid & 7;
    v4u bk[2], bv[2];
    if (ukind == 1 && t.kind == 1) { bk[0] = pack8_(R.r0, R.r1); bk[1] = pack8_(R.r2, R.r3); bv[0] = pack8_(R.r4, R.r5); bv[1] = pack8_(R.r6, R.r7); }
    else { bk[0] = R.r0; bk[1] = R.r1; bv[0] = R.r2; bv[1] = R.r3; }
#pragma unroll
    for (int i = 0; i < 2; ++i) { *(LAS v4u*)(kbuf + kv * KT_P + seg * 32 + 16 * i) = bk[i]; *(LAS v4u*)(vbuf + kv * VN_P + seg * 32 + 16 * i) = bv[i]; }
}
template <int ukind> DEV void att_unit(Frame& F, int sb, int hd, int cp) {
    LAS unsigned char* L = F.lds + RING_OFF;
    const int lane = opaque_v(F.lane()), tid = opaque_v(F.tid()), w = F.wave, l31 = lane & 31, hh = lane >> 5, comp = w >> 2, qb = w & 3;
    const bool active = ukind == 0 || qb == 0;
    const int ntile = ukind == 0 ? 2 * cp + 3 : PAST / 64 + 2;
    const int myvis = ukind == 0 ? 2 * cp + 2 + (qb >> 1) : ntile;
    const int qrow = ukind == 0 ? sb * SEQ + 128 * cp + 32 * qb + l31 : MP + DSEQ * sb + l31;
    const int qpos0 = ukind == 0 ? NMETA + 128 * cp + 32 * qb : NMETA + PAST;
    __syncthreads();
    if (tid < 320) { const int rel = tid - 255, n = rel < 0 ? -rel : rel; int bk;
        if (n < 8) bk = n; else { bk = 8 + (int)(2.0f * LOG2((float)n * 0.125f) + 1e-4f); bk = bk > 15 ? 15 : bk; }
        if (rel > 0) bk += 16;
        ((LAS float*)(L + A_BIAS))[tid] = (F.in[I_RELB][bk * NAH + hd] - F.in[I_RELB][15 * NAH + hd]) * LOG2E; }
    LAS unsigned char* qf_l = L + A_QF + (w * 256 + lane) * 16;
#pragma unroll
    for (int d0 = 0; d0 < 4; ++d0) { const v4u z = {0u, 0u, 0u, 0u}; *(LAS v4u*)(qf_l + 1024 * d0) = active ? *(const v4u*)(F.Q() + qrow * D + 128 * hd + 64 * comp + 16 * d0 + 8 * hh) : z; }
    f32x16 o[4];
#pragma unroll
    for (int r = 0; r < 16; ++r) {
#pragma unroll
        for (int dt = 0; dt < 4; ++dt) o[dt][r] = 0.f; }
    float mref = 0.f, lsum = 0.f;
    AttRegs R; AttTile tcur = att_tile<ukind>(F, sb, hd, 0), tnext = tcur;
    att_load<ukind>(F, tcur, hd, R, tid); att_store<ukind>(tcur, R, L + A_K0, L + A_V0, tid);
    __syncthreads();
#define ATT_SCORE(i) do { \
        f32x16 p0, p1; { const float nm = -mref; _Pragma("unroll") for (int r = 0; r < 16; ++r) { p0[r] = nm; p1[r] = nm; } } \
        const LAS unsigned char* kb = L + A_K0 + ((i) & 1) * A_KBUF + l31 * KT_P + (64 * comp + 8 * hh) * 2; \
        _Pragma("unroll") for (int d0 = 0; d0 < 4; ++d0) { const bf16x8 a0 = rd16(kb + d0 * 32), a1 = rd16(kb + 32 * KT_P + d0 * 32); const bf16x8 qv = rd16(qf_l + 1024 * d0); p0 = mfma32(a0, qv, p0); p1 = mfma32(a1, qv, p1); } \
        SCHED_BAR(); \
        const int kmax = tcur.kpos0 + tcur.nvalid - 1; \
        if (kmax - qpos0 > -128) {             \
            const LAS float* tab_l = (const LAS float*)(L + A_BIAS) + (tcur.kpos0 - (qpos0 + l31) + 255 + 4 * hh); \
            _Pragma("unroll") for (int r = 0; r < 16; ++r) { p0[r] += tab_l[(r & 3) + 8 * (r >> 2)]; p1[r] += tab_l[(r & 3) + 8 * (r >> 2) + 32]; } } \
        if (tcur.nvalid < 64) { \
            _Pragma("unroll") for (int r = 0; r < 16; ++r) { if (crow(r, hh) >= tcur.nvalid) p0[r] = -INFINITY; if (crow(r, hh) + 32 >= tcur.nvalid) p1[r] = -INFINITY; } } \
        float mx = fmaxf(p0[0], p1[0]); \
        _Pragma("unroll") for (int r = 1; r < 16; ++r) mx = fmaxf(mx, fmaxf(p0[r], p1[r])); \
        mx = fmaxf(mx, __shfl_xor(mx, 32)); \
        if ((i) == 0 || wave_any(mx > ATT_THR)) {        \
            const float dl = (i) == 0 ? mx : fmaxf(mx, 0.f), f = EXP2(-dl); mref += dl; lsum *= f; \
            _Pragma("unroll") for (int r = 0; r < 16; ++r) { p0[r] -= dl; p1[r] -= dl; \
                _Pragma("unroll") for (int dt = 0; dt < 4; ++dt) o[dt][r] *= f; } } \
        float ps = 0.f; \
        _Pragma("unroll") for (int r = 0; r < 16; ++r) { p0[r] = EXP2(p0[r]); p1[r] = EXP2(p1[r]); ps += p0[r] + p1[r]; } \
        lsum += ps; \
        pa[0] = pack_step(p0, 0); pa[1] = pack_step(p0, 1); pa[2] = pack_step(p1, 0); pa[3] = pack_step(p1, 1); \
        SCHED_BAR(); } while (0)
#define ATT_PV(j) do { \
        const LAS unsigned char* vt = L + A_V0 + ((j) % 3) * A_VBUF + (4 * hh + ((lane & 15) >> 2)) * VN_P + (16 * ((lane >> 4) & 1) + 4 * (lane & 3)) * 2;     \
        _Pragma("unroll") for (int dt = 0; dt < 4; ++dt) \
            _Pragma("unroll") for (int ks = 0; ks < 4; ++ks) { const s16x4 lo = tr_read(vt + (16 * ks) * VN_P + 64 * dt), hi = tr_read(vt + (16 * ks + 8) * VN_P + 64 * dt); \
                const bf16x8 a = {lo[0], lo[1], lo[2], lo[3], hi[0], hi[1], hi[2], hi[3]}; o[dt] = mfma32(a, pa[ks], o[dt]); if (ks == 3) SCHED_BAR(); } } while (0)
#define ATT_HEAD(i) if ((i) + 1 < ntile) { tnext = att_tile<ukind>(F, sb, hd, (i) + 1); att_load<ukind>(F, tnext, hd, R, tid); }
#define ATT_TAIL(i) do { if ((i) + 1 < ntile) att_store<ukind>(tnext, R, L + A_K0 + (((i) + 1) & 1) * A_KBUF, L + A_V0 + (((i) + 1) % 3) * A_VBUF, tid); tcur = tnext; __syncthreads(); } while (0)
    if (ATT_STAGGER == 0 || ukind == 1 || comp == 0) {
        for (int i = 0; i < ntile + ((ukind == 0 && ATT_STAGGER) ? 1 : 0); ++i) { ATT_HEAD(i); if (active && i < myvis) { bf16x8 pa[4]; ATT_SCORE(i); ATT_PV(i); } ATT_TAIL(i); }
    } else {
        bf16x8 pa[4];
#pragma unroll
        for (int ks = 0; ks < 4; ++ks) pa[ks] = (bf16x8){0, 0, 0, 0, 0, 0, 0, 0};
        for (int i = 0; i < ntile + 1; ++i) { ATT_HEAD(i); if (i >= 1 && i - 1 < myvis) ATT_PV(i - 1); if (i < myvis) ATT_SCORE(i); ATT_TAIL(i); }
    }
#undef ATT_HEAD
#undef ATT_TAIL
#undef ATT_SCORE
#undef ATT_PV
    if (active) { const float l = lsum + __shfl_xor(lsum, 32), inv = RCP(l);
#pragma unroll
        for (int dt = 0; dt < 4; ++dt)
#pragma unroll
            for (int r = 0; r < 16; ++r) o[dt][r] *= inv; }
    LAS float* xo_l = (LAS float*)L + (qb * 128 + 4 * hh) * 32 + l31;
    if (active && comp == 1) {
#pragma unroll
        for (int dt = 0; dt < 4; ++dt)
#pragma unroll
            for (int r = 0; r < 16; ++r) xo_l[(32 * dt + (r & 3) + 8 * (r >> 2)) * 32] = o[dt][r]; }
    __syncthreads();
    if (active && comp == 0) { float ss = 0.f;
        const float lam = EXP2(wave_sum(F.in[I_LQ1][lane] * F.in[I_LK1][lane]) * LOG2E) - EXP2(wave_sum(F.in[I_LQ2][lane] * F.in[I_LK2][lane]) * LOG2E) + 0.2f;
#pragma unroll
        for (int dt = 0; dt < 4; ++dt)
#pragma unroll
            for (int r = 0; r < 16; ++r) { const float v = o[dt][r] - lam * xo_l[(32 * dt + (r & 3) + 8 * (r >> 2)) * 32]; o[dt][r] = v; ss += v * v; }
        ss += __shfl_xor(ss, 32);
        const float rstd = RSQ(ss * (1.f / 128.f) + EPS) * 0.8f;
        bf16* orow = F.O() + qrow * D + 128 * hd;
#pragma unroll
        for (int dt = 0; dt < 4; ++dt)
#pragma unroll
            for (int q4 = 0; q4 < 4; ++q4) { const int d0 = 32 * dt + 8 * q4 + 4 * hh; const f32x4 gn = *(const f32x4*)(F.in[I_SUBLN] + d0);
                v2u ov; ov.x = pk2(o[dt][4 * q4] * rstd * gn.x, o[dt][4 * q4 + 1] * rstd * gn.y); ov.y = pk2(o[dt][4 * q4 + 2] * rstd * gn.z, o[dt][4 * q4 + 3] * rstd * gn.w);
                *(v2u*)(orow + d0) = ov; } }
}

DEV f32x4 bf4_(v2u w) { f32x4 r; r.x = bflo(w.x); r.y = bfhi(w.x); r.z = bflo(w.y); r.w = bfhi(w.y); return r; }
DEV void row_phase(Frame& F, int second) {
    const int gw = F.vcu * NWAVES + F.wave, NGW = F.G * NWAVES, lane = F.lane();
    const f32x4* g1 = (const f32x4*)F.in[second ? I_NFFNP : I_NPOST] + lane;
    const bf16* T = second ? F.T2() : F.T1();
    v2u tv[4], tn[4]; f32x4 bv[4], bn[4];
    int m = gw;
    if (m < MMAIN) { const v2u* tr = (const v2u*)(T + (size_t)m * D) + lane; const f32x4* br = (const f32x4*)(second ? F.out + (size_t)m * D : x_row_ptr(F, m)) + lane;
#pragma unroll
        for (int jj = 0; jj < 4; ++jj) { tv[jj] = tr[64 * jj]; bv[jj] = br[64 * jj]; } }
    for (; m < MMAIN; m += NGW) {
        const int mn = m + NGW;
        if (mn < MMAIN) { const v2u* tr = (const v2u*)(T + (size_t)mn * D) + lane; const f32x4* br = (const f32x4*)(second ? F.out + (size_t)mn * D : x_row_ptr(F, mn)) + lane;
#pragma unroll
            for (int jj = 0; jj < 4; ++jj) { tn[jj] = tr[64 * jj]; bn[jj] = br[64 * jj]; } }
        f32x4 tf[4]; float s = 0.f;
#pragma unroll
        for (int jj = 0; jj < 4; ++jj) { tf[jj] = bf4_(tv[jj]); s += (tf[jj].x * tf[jj].x + tf[jj].y * tf[jj].y) + (tf[jj].z * tf[jj].z + tf[jj].w * tf[jj].w); }
        const float r = RSQ(wave_sum(s) * (1.f / D) + EPS); float s2 = 0.f;
        f32x4* orow = (f32x4*)(F.out + (size_t)m * D) + lane;
#pragma unroll
        for (int jj = 0; jj < 4; ++jj) { const f32x4 g = g1[64 * jj]; bv[jj] = bv[jj] + tf[jj] * r * g; orow[64 * jj] = bv[jj]; s2 += (bv[jj].x * bv[jj].x + bv[jj].y * bv[jj].y) + (bv[jj].z * bv[jj].z + bv[jj].w * bv[jj].w); }
        if (!second) {
            const float r2 = RSQ(wave_sum(s2) * (1.f / D) + EPS); const f32x4* g2 = (const f32x4*)F.in[I_NFFN] + lane;
            unsigned long long* o8 = (unsigned long long*)(F.XN() + (size_t)m * D) + lane;
#pragma unroll
            for (int jj = 0; jj < 4; ++jj) { const f32x4 g = g2[64 * jj]; o8[64 * jj] = (unsigned long long)pk2(bv[jj].x * r2 * g.x, bv[jj].y * r2 * g.y) | ((unsigned long long)pk2(bv[jj].z * r2 * g.z, bv[jj].w * r2 * g.w) << 32); }
        }
#pragma unroll
        for (int jj = 0; jj < 4; ++jj) { tv[jj] = tn[jj]; bv[jj] = bn[jj]; }
    }
}
struct Args { const float* in[29]; float* out; unsigned char* ws; int ph_lo, ph_hi, li, pad; };
#ifndef EMU
#define RLX_AGENT __ATOMIC_RELAXED, __HIP_MEMORY_SCOPE_AGENT
#define XB_TMO      128
#define XB_XCNT(j)  (256  + 64 * (j))
#define XB_XSUB(j)  (1280 + 64 * (j))
#define XB_XGEN(j)  (2304 + 64 * (j))
#define XB_TOP      3328
#define XB_TOPGEN   3392
#define XCD_BAR_WORDS 3456
#define XB_SPIN_CAP (1u << 18)

__device__ __forceinline__ unsigned xb_ld(unsigned* p)              { return __hip_atomic_load(p, __ATOMIC_RELAXED, __HIP_MEMORY_SCOPE_AGENT); }
__device__ __forceinline__ unsigned xb_add(unsigned* p, unsigned v) { return __hip_atomic_fetch_add(p, v, __ATOMIC_RELAXED, __HIP_MEMORY_SCOPE_AGENT); }
__device__ __forceinline__ unsigned xb_xcc_id() { return (unsigned)__builtin_amdgcn_s_getreg((3 << 11) | 20) & 0xFu; }
#define XB_SPIN(cond, bar) do { unsigned _sp = 0; while (cond) { __builtin_amdgcn_s_sleep(1); \
    if ((++_sp & 255u) == 0u) { if (xb_ld(&(bar)[XB_TMO])) break; if (_sp > XB_SPIN_CAP) { atomicAdd(&(bar)[XB_TMO], 1u); break; } } } } while (0)

struct XcdBarrier {
    unsigned* bar; unsigned x;
    volatile LAS unsigned* st;
};

__device__ __forceinline__ XcdBarrier xcd_barrier_post(unsigned* bar, volatile LAS unsigned* st) {
    XcdBarrier b; b.bar = bar; b.x = xb_xcc_id(); b.st = st;
    if (threadIdx.x == 0) (void)xb_add(&bar[XB_XCNT(b.x)], 1u);
    return b;
}
__device__ __forceinline__ void xcd_barrier_complete(unsigned* bar, unsigned x, unsigned& nloc, unsigned& nx) {
    const unsigned G = gridDim.x * gridDim.y * gridDim.z;
    unsigned sum, cnt, mine, sp = 0u;
    for (;;) {
        sum = 0u; cnt = 0u; mine = 0u;
#pragma unroll
        for (unsigned j = 0; j < 16; ++j) { const unsigned c = xb_ld(&bar[XB_XCNT(j)]); sum += c; cnt += (c > 0u) ? 1u : 0u; mine = (j == x) ? c : mine; }
        if (sum == G) break;
        __builtin_amdgcn_s_sleep(1);
        if ((++sp & 255u) == 0u) { if (xb_ld(&bar[XB_TMO])) break; if (sp > XB_SPIN_CAP) { atomicAdd(&bar[XB_TMO], 1u); break; } }
    }
    nloc = mine > 0u ? mine : 1u; nx = cnt > 0u ? cnt : 1u;
}

__device__ __forceinline__ void xcd_barrier(const XcdBarrier& b) {
    asm volatile("s_waitcnt vmcnt(0)" ::: "memory");
    __syncthreads();
    if (threadIdx.x == 0) {
        unsigned* bar = b.bar;
        __builtin_amdgcn_s_waitcnt(0);
        unsigned nloc = b.st[0], nx = b.st[1];
        if (nloc == 0u) { xcd_barrier_complete(bar, b.x, nloc, nx); b.st[0] = nloc; b.st[1] = nx; }
        const unsigned old = xb_add(&bar[XB_XSUB(b.x)], 1u);
        const unsigned gen = old / nloc;
        if (old + 1u == (gen + 1u) * nloc) {
            __builtin_amdgcn_fence(__ATOMIC_RELEASE, "agent");
            asm volatile("s_waitcnt vmcnt(0)" ::: "memory");
            const unsigned og = xb_add(&bar[XB_TOP], 1u);
            const unsigned tg = og / nx;
            if (og + 1u == (tg + 1u) * nx) xb_add(&bar[XB_TOPGEN], 1u);
            else XB_SPIN(xb_ld(&bar[XB_TOPGEN]) == tg, bar);
            __builtin_amdgcn_fence(__ATOMIC_ACQUIRE, "agent");
            xb_add(&bar[XB_XGEN(b.x)], 1u);
            asm volatile("s_waitcnt vmcnt(0)" ::: "memory");
        } else {
            XB_SPIN(xb_ld(&bar[XB_XGEN(b.x)]) == gen, bar);
            __builtin_amdgcn_fence(__ATOMIC_ACQUIRE, "agent");
            asm volatile("s_waitcnt vmcnt(0)" ::: "memory");
        }
    }
    __syncthreads();
}

#endif

__global__ void __launch_bounds__(NWAVES * 64, 2) skel_fwd(Args args) {
#ifdef EMU
    unsigned char* lds = emu::B->lds;
#else
    extern __shared__ __attribute__((aligned(16))) unsigned char lds[];
#endif
    Frame F;
    F.lds = (LAS unsigned char*)lds;
    F.wave = RDFL((int)(threadIdx.x >> 6));
    F.G = gridDim.x; { const int bx = blockIdx.x; F.vcu = (F.G % 8 == 0) ? (bx % 8) * (F.G / 8) + bx / 8 : bx; }
    unsigned char* ws = args.ws; F.ws = ws; F.out = args.out;
    F.in = args.in;
    F.ctl = (unsigned*)(ws + WS_CTL);
    for (int u = (int)threadIdx.x; u < (LDS_BYTES - LDSCTL_OFF) / 4; u += NWAVES * 64) ((LAS unsigned*)(F.lds + LDSCTL_OFF))[u] = 0u;
    __syncthreads();
#ifndef EMU
    volatile LAS unsigned* MISC = (volatile LAS unsigned*)(F.lds + MISC_OFF);
    XcdBarrier bar = xcd_barrier_post((unsigned*)(F.ctl + CW_BAR) + args.li * XCD_BAR_WORDS, MISC + 8);
#define GRID_BAR() xcd_barrier(bar)
#else
#define GRID_BAR() do {} while (0)
#endif
    const int lo = args.ph_lo, hi = args.ph_hi;
#define IN(k) (lo <= (k) && (k) < hi)
#define BOTH(k) (IN(k) && IN((k) + 1))

    if (IN(0)) { p0_prologue(F);
#if PROBE_DUP & 32
        VM_WAIT(); __syncthreads(); p0_prologue(F);
#endif
        if (BOTH(0)) GRID_BAR(); }

    if (IN(1)) {
        pg8::Gemm g{F.XN(), F.WinT(), MALL, NPROJ, D}; pg8::StaticOrder S; S.init(MALL, NPROJ, F.G, (int)blockIdx.x); S.wid = F.wave;
        pg8::EpiProj E{F.Z(), F.XBC(), F.Q(), F.K(), F.V(), F.GS(), F.GA(), F.DT(), F.in[I_DTB], F.out};
        pg8::gemm_phase<pg8::EpiProj, pg8::StaticOrder, PG8_ALIGN, PG8_SP2>(F.lds + RING_OFF, g, S, E);
#if PROBE_DUP & 1
        VM_WAIT(); __syncthreads();
        pg8::gemm_phase<pg8::EpiProj, pg8::StaticOrder, PG8_ALIGN, PG8_SP2>(F.lds + RING_OFF, g, S, E);
#endif
        if (BOTH(1)) GRID_BAR();
    }

    if (IN(2)) {
        for (int u = F.vcu; u < BATCH * NGRP; u += F.G) ssd_unit(F, 0, u / NGRP, u % NGRP);
        for (int u = F.vcu; u < DECB * NGRP; u += F.G) ssd_unit(F, 1, u / NGRP, u % NGRP);
#if PROBE_DUP & 8
        for (int u = F.vcu; u < BATCH * NGRP; u += F.G) ssd_unit(F, 0, u / NGRP, u % NGRP);
        for (int u = F.vcu; u < DECB * NGRP; u += F.G) ssd_unit(F, 1, u / NGRP, u % NGRP);
#endif
        for (int u = F.vcu; u < BATCH * NAH; u += F.G)
            for (int cp = 0; cp < SEQ / 128; ++cp) att_unit<0>(F, u / NAH, u % NAH, cp);
        for (int u = F.vcu; u < DECB * NAH; u += F.G) att_unit<1>(F, u / NAH, u % NAH, 0);
#if PROBE_DUP & 16
        for (int u = F.vcu; u < BATCH * NAH; u += F.G)
            for (int cp = 0; cp < SEQ / 128; ++cp) att_unit<0>(F, u / NAH, u % NAH, cp);
        for (int u = F.vcu; u < DECB * NAH; u += F.G) att_unit<1>(F, u / NAH, u % NAH, 0);
#endif
        __syncthreads();
        if (BOTH(2)) GRID_BAR();
    }

    if (IN(3)) {
        { pg8::Gemm g{F.U(), F.WssdT(), MMAIN, D, DIN}; pg8::StaticOrder S; S.init(MMAIN, D, F.G, (int)blockIdx.x); S.wid = F.wave;
          pg8::EpiGate<0> E{F.GS(), nullptr, F.TMP()};
          pg8::gemm_phase<pg8::EpiGate<0>, pg8::StaticOrder, PG8_ALIGN, PG8_SP2>(F.lds + RING_OFF, g, S, E); }
        VM_WAIT(); __syncthreads();
        { pg8::Gemm g{F.O(), F.WattT(), MMAIN, D, D}; pg8::StaticOrder S; S.init(MMAIN, D, F.G, (int)blockIdx.x); S.wid = F.wave;
          pg8::EpiGate<1> E{F.GA(), F.TMP(), F.MIX()};
          pg8::gemm_phase<pg8::EpiGate<1>, pg8::StaticOrder, PG8_ALIGN, PG8_SP2>(F.lds + RING_OFF, g, S, E); }
#if PROBE_DUP & 2
        VM_WAIT(); __syncthreads();
        { pg8::Gemm g{F.U(), F.WssdT(), MMAIN, D, DIN}; pg8::StaticOrder S; S.init(MMAIN, D, F.G, (int)blockIdx.x); S.wid = F.wave;
          pg8::EpiGate<0> E{F.GS(), nullptr, F.TMP()};
          pg8::gemm_phase<pg8::EpiGate<0>, pg8::StaticOrder, PG8_ALIGN, PG8_SP2>(F.lds + RING_OFF, g, S, E); }
        VM_WAIT(); __syncthreads();
        { pg8::Gemm g{F.O(), F.WattT(), MMAIN, D, D}; pg8::StaticOrder S; S.init(MMAIN, D, F.G, (int)blockIdx.x); S.wid = F.wave;
          pg8::EpiGate<1> E{F.GA(), F.TMP(), F.MIX()};
          pg8::gemm_phase<pg8::EpiGate<1>, pg8::StaticOrder, PG8_ALIGN, PG8_SP2>(F.lds + RING_OFF, g, S, E); }
#endif
        if (BOTH(3)) GRID_BAR();
    }

    if (IN(4)) {
        pg8::Gemm g{F.MIX(), F.WoT(), MMAIN, D, D}; pg8::StaticOrder S; S.init(MMAIN, D, F.G, (int)blockIdx.x); S.wid = F.wave;
        pg8::EpiT E{F.T1(), D};
        pg8::gemm_phase<pg8::EpiT, pg8::StaticOrder, PG8_ALIGN, PG8_SP2>(F.lds + RING_OFF, g, S, E);
#if PROBE_DUP & 2
        VM_WAIT(); __syncthreads();
        pg8::gemm_phase<pg8::EpiT, pg8::StaticOrder, PG8_ALIGN, PG8_SP2>(F.lds + RING_OFF, g, S, E);
#endif
        if (BOTH(4)) GRID_BAR();
    }
    if (IN(5)) { row_phase(F, 0);
#if PROBE_DUP & 64
        VM_WAIT(); __syncthreads(); row_phase(F, 0);
#endif
        if (BOTH(5)) GRID_BAR(); }

    if (IN(6)) {
        pg8::Gemm g{F.XN(), F.WffT(), MMAIN, 2 * DFF, D}; pg8::StaticOrder S; S.init(MMAIN, 2 * DFF, F.G, (int)blockIdx.x); S.wid = F.wave;
        pg8::EpiSwiglu E{F.HB()};
        pg8::gemm_phase<pg8::EpiSwiglu, pg8::StaticOrder, PG8_ALIGN, PG8_SP2>(F.lds + RING_OFF, g, S, E);
#if PROBE_DUP & 4
        VM_WAIT(); __syncthreads();
        pg8::gemm_phase<pg8::EpiSwiglu, pg8::StaticOrder, PG8_ALIGN, PG8_SP2>(F.lds + RING_OFF, g, S, E);
#endif
        if (BOTH(6)) GRID_BAR();
    }
    if (IN(7)) {
        pg8::Gemm g{F.HB(), F.Wff2T(), MMAIN, D, DFF}; pg8::StaticOrder S; S.init(MMAIN, D, F.G, (int)blockIdx.x); S.wid = F.wave;
        pg8::EpiT E{F.T2(), D};
        pg8::gemm_phase<pg8::EpiT, pg8::StaticOrder, PG8_ALIGN, PG8_SP2>(F.lds + RING_OFF, g, S, E);
#if PROBE_DUP & 4
        VM_WAIT(); __syncthreads();
        pg8::gemm_phase<pg8::EpiT, pg8::StaticOrder, PG8_ALIGN, PG8_SP2>(F.lds + RING_OFF, g, S, E);
#endif
        if (BOTH(7)) GRID_BAR();
    }
    if (IN(8)) { row_phase(F, 1); }
#undef IN
#undef BOTH
}

extern "C" void kernel_launch(void* const* d_in, const int* in_sizes, int n_in, void* d_out, int out_size, void* d_ws, size_t ws_size, hipStream_t stream) {
    if (n_in != 29 || (size_t)out_size != OUT_END || ws_size < WS_END) { fprintf(stderr, "kernel_launch: shape mismatch: n_in %d out %d (want %zu) ws %zu (want %zu)\n", n_in, out_size, (size_t)OUT_END, ws_size, (size_t)WS_END); return; }
    Args a{};
    for (int i = 0; i < 29; ++i) a.in[i] = (const float*)d_in[i];
    a.out = (float*)d_out; a.ws = (unsigned char*)d_ws;
#ifdef EMU
    memset((char*)d_ws + WS_CTL, 0, CTL_ZERO_BYTES);
    const int first = getenv("EMU_PH_LO") ? atoi(getenv("EMU_PH_LO")) : 0, last = getenv("EMU_PH_HI") ? atoi(getenv("EMU_PH_HI")) : NPHASE;
    const int grid = getenv("EMU_GRID") ? atoi(getenv("EMU_GRID")) : 8;
    for (int ph = first; ph < last; ++ph) { a.ph_lo = ph; a.ph_hi = ph + 1; a.li = 0; fprintf(stderr, "[emu] phase %d\n", ph); emu::launch(grid, NWAVES * 64, LDS_BYTES, [=] { skel_fwd(a); }); }
#else
    static int grid = 0;
    if (grid == 0) {
        int dev = 0, cus = 0, per_cu = 0;
        if (hipGetDevice(&dev) != hipSuccess || hipDeviceGetAttribute(&cus, hipDeviceAttributeMultiprocessorCount, dev) != hipSuccess) { fprintf(stderr, "kernel_launch: device query failed\n"); grid = -1; return; }
        if (hipFuncSetAttribute((const void*)skel_fwd, hipFuncAttributeMaxDynamicSharedMemorySize, LDS_BYTES) != hipSuccess) { fprintf(stderr, "kernel_launch: hipFuncSetAttribute failed\n"); grid = -1; return; }
        if (hipOccupancyMaxActiveBlocksPerMultiprocessor(&per_cu, (const void*)skel_fwd, NWAVES * 64, LDS_BYTES) != hipSuccess || per_cu < 1) { fprintf(stderr, "kernel_launch: occupancy query says %d blocks per CU\n", per_cu); (void)hipGetLastError(); per_cu = 1; }
        grid = cus;
    }
    if (grid < 0) return;
    if (hipMemsetAsync((char*)d_ws + WS_CTL, 0, CTL_ZERO_BYTES, stream) != hipSuccess) { fprintf(stderr, "kernel_launch: memset failed\n"); return; }
    constexpr int NL = MK_N_LAUNCHES;
    for (int li = 0; li < NL; ++li) {
        a.ph_lo = NL == 1 ? 0 : li; a.ph_hi = NL == 1 ? NPHASE : li + 1; a.li = li;
        hipLaunchKernelGGL(skel_fwd, dim3(grid), dim3(NWAVES * 64), LDS_BYTES, stream, a);
        const hipError_t le = hipPeekAtLastError();
        if (le != hipSuccess) { fprintf(stderr, "kernel_launch: launch %d failed: %s\n", li, hipGetErrorName(le)); break; }
    }
#endif
}
```

```cpp
#ifndef EMU
#include <hip/hip_runtime.h>
#endif
#include <cstdio>
#include <cstdint>
#include <cmath>

#ifdef EMU
#define PG8_LAS
#define LAS
#define GAS
#define WAVE_LDS_SYNC() emu::wave_sync()
#define RDFL(x) (x)
#else
#define PG8_LAS __attribute__((address_space(3)))
#define LAS __attribute__((address_space(3)))
#define GAS __attribute__((address_space(1)))
#define WAVE_LDS_SYNC() asm volatile("s_waitcnt lgkmcnt(0)" ::: "memory")
#define RDFL(x) __builtin_amdgcn_readfirstlane(x)
#endif
#ifndef PROBE_DUP
#define PROBE_DUP 0
#endif
namespace pg8 {
typedef unsigned short bf16_t;
typedef short bf16x8 __attribute__((ext_vector_type(8)));
typedef float f32x4 __attribute__((ext_vector_type(4)));
typedef unsigned u32x4 __attribute__((ext_vector_type(4)));
constexpr int BM = 256, BK = 64, HALF = 128, HTB = HALF * BK * 2  , STAGE_BYTES = 8 * HTB, NXCD = 8, WGM = 8;

__host__ __device__ __forceinline__ int lds_byte(int r, int c) { const int st = (r >> 4) * 2 + (c >> 5), rr = r & 15, cc = c & 31, ob = rr * 64 + cc * 2; return st * 1024 + (ob ^ (((ob >> 9) & 1) << 5)); }
__host__ __device__ __forceinline__ void stage_rc(int b, int& R, int& C) { const int st = b / 1024, sb = b % 1024, swz = sb ^ (((sb >> 9) & 1) << 5); R = (st >> 1) * 16 + swz / 64; C = (st & 1) * 32 + (swz % 64) / 2; }
__host__ __device__ __forceinline__ int perm32(int rho) { const int n = rho >> 4, i = rho & 15; return 8 * (i >> 2) + 4 * n + (i & 3); }

struct Unit { int pm, pn; };
struct Gemm { const bf16_t* A; const bf16_t* Bt; int M, N, K; };

struct StaticOrder {
    int nM, nN, nwg, G, c, wid;
    __host__ __device__ void init(int M, int N, int G_, int c_) { nM = M / BM; nN = N / BM; nwg = nM * nN; G = G_; c = c_; }
    __host__ __device__ bool next(int i, Unit& u) const {
        const long L = (long)i * G + c; if (L >= nwg) return false;
        int wgid = (int)L; { const int q = nwg / NXCD, r = nwg % NXCD, xcd = wgid % NXCD, off = wgid / NXCD; wgid = (xcd < r ? xcd * (q + 1) : r * (q + 1) + (xcd - r) * q) + off; }
        const int nig = WGM * nN, gid = wgid / nig, fm = gid * WGM, gsz = (nM - fm) < WGM ? (nM - fm) : WGM;
        u.pm = fm + ((wgid % nig) % gsz); u.pn = (wgid % nig) / gsz; return true;
    }
    __device__ __forceinline__ void a_ready(const Unit&) const {}
    __device__ __forceinline__ void done(const Unit&) const {}
};
typedef float f32x2 __attribute__((ext_vector_type(2)));
#ifdef EMU
__device__ __forceinline__ unsigned cvt_pk_bf16(float lo, float hi) { return (unsigned)emu_f2bf(lo) | ((unsigned)emu_f2bf(hi) << 16); }
inline void emu_host_tile(const Gemm& g, const Unit& u, float* C) {
    const int K = g.K; std::vector<float> a((size_t)256 * K), b((size_t)256 * K);
    for (int r = 0; r < 256; ++r) for (int k = 0; k < K; ++k) { a[(size_t)r * K + k] = emu_bf2f(g.A[(size_t)(u.pm * 256 + r) * K + k]); b[(size_t)r * K + k] = emu_bf2f(g.Bt[(size_t)(u.pn * 256 + r) * K + k]); }
    for (int r = 0; r < 256; ++r) for (int c = 0; c < 256; ++c) { const float* ap = &a[(size_t)r * K]; const float* bp = &b[(size_t)c * K]; float s0 = 0.f, s1 = 0.f, s2 = 0.f, s3 = 0.f;
        for (int k = 0; k < K; k += 4) { s0 += ap[k] * bp[k]; s1 += ap[k + 1] * bp[k + 1]; s2 += ap[k + 2] * bp[k + 2]; s3 += ap[k + 3] * bp[k + 3]; } C[r * 256 + c] = (s0 + s1) + (s2 + s3); }
}
template <class Epi, class Sched, bool ALIGN_EPI = false, bool SP2 = false>
inline void gemm_phase(unsigned char* lds, const Gemm g, const Sched& S, const Epi& E) {
    const int tid = threadIdx.x, wid = tid >> 6, lane = tid & 63, wr = wid >> 2, wc = wid & 3, fr = lane & 15, fq = lane >> 4;
    Unit cur;
    for (int ui = 0; S.next(ui, cur); ++ui) {
        __syncthreads();
        if (tid == 0) emu_host_tile(g, cur, emu::B->gemm_tile);
        __syncthreads();
        f32x4 acc[2][2][4][2];
        for (int ai = 0; ai < 2; ++ai) for (int bj = 0; bj < 2; ++bj) for (int m = 0; m < 4; ++m) for (int n = 0; n < 2; ++n) for (int e = 0; e < 4; ++e) {
            const int row = 128 * ai + 64 * wr + 16 * m + fr, col = 128 * bj + 32 * wc + (Epi::PERM ? 8 * fq + 4 * n + e : 16 * n + 4 * fq + e);
            acc[ai][bj][m][n][e] = emu::B->gemm_tile[row * 256 + col]; }
        E(acc, cur, wr, wc, fr, fq);
    }
    __syncthreads();
}
#else
__device__ __forceinline__ int pg8_lane_id() { int x; asm volatile("v_mbcnt_lo_u32_b32 %0, -1, 0\n\tv_mbcnt_hi_u32_b32 %0, -1, %0" : "=v"(x)); return x; }
__device__ __forceinline__ unsigned cvt_pk_bf16(float lo, float hi) { unsigned r; asm volatile("v_cvt_pk_bf16_f32 %0, %1, %2" : "=v"(r) : "v"(lo), "v"(hi)); return r; }
template <class Epi, class Sched, bool ALIGN_EPI = false, bool SP2 = false>
__device__ __forceinline__ void gemm_phase(PG8_LAS unsigned char* lds, const Gemm g, const Sched& S, const Epi& E) {
    const int wid = S.wid, lane = pg8_lane_id(), tid = wid * 64 + lane, wr = wid >> 2, wc = wid & 3, fr = lane & 15, fq = lane >> 4;
    const int K = g.K, nt = K / BK;
    unsigned voffA[2], voffB[2];
#pragma unroll
    for (int i = 0; i < 2; ++i) { int R, C; stage_rc(tid * 16 + i * 8192, R, C); const int Rb = Epi::PERM ? ((R & ~31) + perm32(R & 31)) : R;
        voffA[i] = (unsigned)(R * K + C) * 2u; voffB[i] = (unsigned)(Rb * K + C) * 2u; }
    const size_t kstep = (size_t)(BK * 2);
    const size_t hstep = (size_t)HALF * K * 2;
    const size_t tstep = 2 * hstep;
    const unsigned ldsw = (unsigned)wid * 1024u;
    const int aoff = lds_byte(wr * 64 + fr, fq * 8), boff = lds_byte(wc * 32 + fr, fq * 8);
#define PG8_SA(b, h) (((b) * 2 + (h)) * HTB)
#define PG8_SB(b, h) ((4 + (b) * 2 + (h)) * HTB)
#define PG8_STAGE(bufoff, gbase, voff) do { _Pragma("unroll") for (int _i = 0; _i < 2; ++_i) \
        __builtin_amdgcn_global_load_lds((const unsigned*)((const char*)(gbase) + (voff)[_i]), (PG8_LAS unsigned*)(lds + (bufoff) + ldsw + _i * 8192), 16, 0, 0); } while (0)
#define PG8_LDA(dst, b, h) do { _Pragma("unroll") for (int m = 0; m < 4; ++m) _Pragma("unroll") for (int k = 0; k < 2; ++k) dst[m][k] = *(const PG8_LAS bf16x8*)(lds + PG8_SA(b, h) + aoff + m * 2048 + k * 1024); } while (0)
#define PG8_LDB(dst, b, h) do { _Pragma("unroll") for (int n = 0; n < 2; ++n) _Pragma("unroll") for (int k = 0; k < 2; ++k) dst[n][k] = *(const PG8_LAS bf16x8*)(lds + PG8_SB(b, h) + boff + n * 2048 + k * 1024); } while (0)
#define PG8_MMA(ai, bj, At, Bt) do { __builtin_amdgcn_s_setprio(1); _Pragma("unroll") for (int m = 0; m < 4; ++m) _Pragma("unroll") for (int n = 0; n < 2; ++n) _Pragma("unroll") for (int k = 0; k < 2; ++k) \
        acc[ai][bj][m][n] = __builtin_amdgcn_mfma_f32_16x16x32_bf16(Bt[n][k], At[m][k], acc[ai][bj][m][n], 0, 0, 0); __builtin_amdgcn_s_setprio(0); } while (0)
#define PG8_WAIT_V(n) asm volatile("s_waitcnt vmcnt(" #n ")" ::: "memory")
#define PG8_WAIT_L(n) asm volatile("s_waitcnt lgkmcnt(" #n ")" ::: "memory")
#define PG8_BAR __builtin_amdgcn_s_barrier()
#define PG8_SCHED __builtin_amdgcn_sched_barrier(0)
    Unit cur, nxt; int ui = 0;
    if (!S.next(0, cur)) return;
    f32x4 acc[2][2][4][2];
#pragma unroll
    for (int a = 0; a < 2; ++a)
#pragma unroll
        for (int b = 0; b < 2; ++b)
#pragma unroll
            for (int m = 0; m < 4; ++m)
#pragma unroll
                for (int n = 0; n < 2; ++n) acc[a][b][m][n] = (f32x4){0.f, 0.f, 0.f, 0.f};
    bf16x8 At[4][2], B0[2][2], B1[2][2];
    const char* cA = (const char*)g.A + (size_t)cur.pm * tstep; const char* cB = (const char*)g.Bt + (size_t)cur.pn * tstep;
    S.a_ready(cur);
    if constexpr (SP2) {
        PG8_STAGE(PG8_SB(0, 0), cB, voffB); PG8_STAGE(PG8_SB(0, 1), cB + hstep, voffB); PG8_STAGE(PG8_SA(0, 0), cA, voffA); PG8_STAGE(PG8_SA(0, 1), cA + hstep, voffA);
        if (wr == 1) PG8_BAR;
        PG8_WAIT_V(2); PG8_BAR;
        PG8_STAGE(PG8_SB(1, 0), cB + kstep, voffB); PG8_STAGE(PG8_SA(1, 0), cA + kstep, voffA); PG8_STAGE(PG8_SB(1, 1), cB + hstep + kstep, voffB);
        PG8_WAIT_V(6); PG8_BAR;
    } else {
        PG8_STAGE(PG8_SB(0, 0), cB, voffB); PG8_STAGE(PG8_SA(0, 0), cA, voffA); PG8_STAGE(PG8_SB(0, 1), cB + hstep, voffB); PG8_STAGE(PG8_SA(0, 1), cA + hstep, voffA);
        if (wr == 1) PG8_BAR;
        PG8_WAIT_V(4); PG8_BAR;
        PG8_STAGE(PG8_SB(1, 0), cB + kstep, voffB); PG8_STAGE(PG8_SA(1, 0), cA + kstep, voffA); PG8_STAGE(PG8_SB(1, 1), cB + hstep + kstep, voffB);
        PG8_WAIT_V(6); PG8_BAR;
    }
    for (;;) {
        const bool has_next = S.next(ui + 1, nxt);
        const char* nA = has_next ? (const char*)g.A + (size_t)nxt.pm * tstep : cA; const char* nB = has_next ? (const char*)g.Bt + (size_t)nxt.pn * tstep : cB;
        for (int t = 0; t < nt; t += 2) {
            const bool last = (t == nt - 2);
            const char* a1 = cA + (size_t)(t + 1) * kstep;
            const char* a2 = last ? nA : cA + (size_t)(t + 2) * kstep; const char* b2 = last ? nB : cB + (size_t)(t + 2) * kstep;
            const char* a3 = a2 + kstep; const char* b3 = b2 + kstep;
            if (last && has_next) S.a_ready(nxt);
            if constexpr (SP2) {
            PG8_LDB(B0, 0, 0); PG8_LDB(B1, 0, 1); PG8_SCHED; PG8_LDA(At, 0, 0); PG8_STAGE(PG8_SA(1, 1), a1 + hstep, voffA);
            PG8_WAIT_V(8); PG8_WAIT_L(0); PG8_BAR; PG8_MMA(0, 0, At, B0); PG8_MMA(0, 1, At, B1); PG8_BAR; PG8_SCHED;
            PG8_LDA(At, 0, 1); PG8_STAGE(PG8_SB(0, 0), b2, voffB); PG8_STAGE(PG8_SB(0, 1), b2 + hstep, voffB); PG8_STAGE(PG8_SA(0, 0), a2, voffA);
            PG8_WAIT_V(8); PG8_WAIT_L(0); PG8_BAR; PG8_MMA(1, 0, At, B0); PG8_MMA(1, 1, At, B1); PG8_BAR; PG8_SCHED;
            PG8_LDB(B0, 1, 0); PG8_LDB(B1, 1, 1); PG8_SCHED; PG8_LDA(At, 1, 0); PG8_STAGE(PG8_SA(0, 1), a2 + hstep, voffA);
            PG8_WAIT_V(8); PG8_WAIT_L(0); PG8_BAR; PG8_MMA(0, 0, At, B0); PG8_MMA(0, 1, At, B1); PG8_BAR; PG8_SCHED;
            PG8_LDA(At, 1, 1); PG8_STAGE(PG8_SB(1, 0), b3, voffB); PG8_STAGE(PG8_SB(1, 1), b3 + hstep, voffB); PG8_STAGE(PG8_SA(1, 0), a3, voffA);
            PG8_WAIT_V(8); PG8_WAIT_L(0); PG8_BAR; PG8_MMA(1, 0, At, B0); PG8_MMA(1, 1, At, B1); PG8_BAR; PG8_SCHED;
            } else {
            PG8_LDB(B0, 0, 0); PG8_SCHED; PG8_LDA(At, 0, 0); PG8_STAGE(PG8_SA(1, 1), a1 + hstep, voffA);
            PG8_WAIT_L(8); PG8_BAR; PG8_WAIT_L(0); PG8_MMA(0, 0, At, B0); PG8_BAR; PG8_SCHED;
            PG8_LDB(B1, 0, 1); PG8_STAGE(PG8_SB(0, 0), b2, voffB);
            PG8_BAR; PG8_WAIT_L(0); PG8_MMA(0, 1, At, B1); PG8_BAR;
            PG8_LDA(At, 0, 1); PG8_STAGE(PG8_SA(0, 0), a2, voffA);
            PG8_BAR; PG8_WAIT_L(0); PG8_MMA(1, 0, At, B0); PG8_BAR; PG8_SCHED;
            PG8_STAGE(PG8_SB(0, 1), b2 + hstep, voffB);
            PG8_WAIT_V(6); PG8_BAR; PG8_MMA(1, 1, At, B1); PG8_BAR;
            PG8_LDB(B0, 1, 0); PG8_SCHED; PG8_LDA(At, 1, 0); PG8_STAGE(PG8_SA(0, 1), a2 + hstep, voffA);
            PG8_WAIT_L(8); PG8_BAR; PG8_WAIT_L(0); PG8_MMA(0, 0, At, B0); PG8_BAR; PG8_SCHED;
            PG8_LDB(B1, 1, 1); PG8_STAGE(PG8_SB(1, 0), b3, voffB);
            PG8_BAR; PG8_WAIT_L(0); PG8_MMA(0, 1, At, B1); PG8_BAR;
            PG8_LDA(At, 1, 1); PG8_STAGE(PG8_SA(1, 0), a3, voffA);
            PG8_BAR; PG8_WAIT_L(0); PG8_MMA(1, 0, At, B0); PG8_BAR; PG8_SCHED;
            PG8_STAGE(PG8_SB(1, 1), b3 + hstep, voffB);
            PG8_WAIT_V(6); PG8_BAR; PG8_MMA(1, 1, At, B1); PG8_BAR;
            }
        }
        if constexpr (ALIGN_EPI) { if (wr == 0) PG8_BAR; }
        if constexpr (!Epi::AFTER_DRAIN) { E(acc, cur, wr, wc, fr, fq); if (PROBE_DUP & 128) { asm volatile("" ::: "memory"); E(acc, cur, wr, wc, fr, fq); } S.done(cur); }
        if (!has_next) break;
#pragma unroll
        for (int a = 0; a < 2; ++a)
#pragma unroll
            for (int b = 0; b < 2; ++b)
#pragma unroll
                for (int m = 0; m < 4; ++m)
#pragma unroll
                    for (int n = 0; n < 2; ++n) acc[a][b][m][n] = (f32x4){0.f, 0.f, 0.f, 0.f};
        cur = nxt; cA = nA; cB = nB; ++ui;
        if constexpr (ALIGN_EPI) { if (wr == 1) PG8_BAR; }
    }
    PG8_WAIT_V(0);
    if constexpr (!ALIGN_EPI) { if (wr == 0) PG8_BAR; }
    PG8_BAR;
    if constexpr (Epi::AFTER_DRAIN) { E.fused(acc, cur, wr, wc, fr, fq, lds, wid, lane); S.done(cur); }
#undef PG8_SA
#undef PG8_SB
#undef PG8_STAGE
#undef PG8_LDA
#undef PG8_LDB
#undef PG8_MMA
#undef PG8_WAIT_V
#undef PG8_WAIT_L
#undef PG8_BAR
#undef PG8_SCHED
}
#endif
}
#ifndef PG8_SP2
#define PG8_SP2 true
#endif
#ifndef PG8_ALIGN
#define PG8_ALIGN true
#endif

#ifndef CFG_BATCH
#define CFG_BATCH 32
#endif
#ifndef CFG_SEQ
#define CFG_SEQ 2048
#endif
#ifndef CFG_DECB
#define CFG_DECB 32
#endif
#ifndef CFG_PAST
#define CFG_PAST 4096
#endif
#ifndef STAGGER_P1
#define STAGGER_P1 100
#endif
#ifndef STAGGER_P6
#define STAGGER_P6 85
#endif
#ifndef MK_N_LAUNCHES
#define MK_N_LAUNCHES 1
#endif
constexpr int NWAVES = 8, NPHASE = 9;
constexpr int BATCH = CFG_BATCH, SEQ = CFG_SEQ, DECB = CFG_DECB, DSEQ = 32, PAST = CFG_PAST;
constexpr int D = 1024, NMETA = 16, DIN = 2048, CONVD = 4096, NSH = 32, NGRP = 8, DST = 128, NAH = 8, DFF = 2816;
constexpr int MP = BATCH * SEQ, MS = DECB * DSEQ, MMAIN = MP + MS, MALL = MMAIN + 256;
constexpr int NPROJ = 45 * 256, LEXT = NMETA + SEQ;
static_assert(MP % 256 == 0 && MS % 256 == 0 && SEQ % 128 == 0 && PAST % 64 == 0, "row panels");
constexpr float EPS = 1e-6f, LOG2E = 1.4426950408889634f, LN2 = 0.6931471805599453f, QSCALE = 0.125f * LOG2E;
constexpr size_t OUT_Y = 0, OUT_YS = OUT_Y + (size_t)MP * D, OUT_KP = OUT_YS + (size_t)MS * D, OUT_VP = OUT_KP + (size_t)BATCH * LEXT * 1024,
    OUT_CP = OUT_VP + (size_t)BATCH * LEXT * 1024, OUT_SP = OUT_CP + (size_t)BATCH * 3 * CONVD, OUT_KS = OUT_SP + (size_t)BATCH * NSH * 64 * DST,
    OUT_VS = OUT_KS + (size_t)MS * 1024, OUT_CS = OUT_VS + (size_t)MS * 1024, OUT_SS = OUT_CS + (size_t)DECB * 3 * CONVD, OUT_END = OUT_SS + (size_t)DECB * NSH * 64 * DST;
constexpr size_t MiB = 1u << 20;
constexpr size_t al(size_t x) { return (x + MiB - 1) & ~(MiB - 1); }
constexpr size_t WS_CTL = 0, CTL_ZERO_BYTES = 64 * 1024;
constexpr size_t WS_WIN = MiB, WS_WSSD = WS_WIN + al((size_t)NPROJ * D * 2), WS_WATT = WS_WSSD + al((size_t)D * DIN * 2), WS_WO = WS_WATT + al((size_t)D * D * 2),
    WS_WFF = WS_WO + al((size_t)D * D * 2), WS_WFF2 = WS_WFF + al((size_t)2 * DFF * D * 2), WS_XN = WS_WFF2 + al((size_t)D * DFF * 2);
constexpr size_t WS_Z = WS_XN + al((size_t)MALL * D * 2), WS_XBC = WS_Z + al((size_t)MALL * DIN * 2), WS_DT = WS_XBC + al((size_t)MALL * CONVD * 2), WS_Q = WS_DT + al((size_t)MALL * 32 * 4),
    WS_K = WS_Q + al((size_t)MALL * D * 2), WS_V = WS_K + al((size_t)MALL * D * 2), WS_GS = WS_V + al((size_t)MALL * D * 2), WS_GA = WS_GS + al((size_t)MALL * D * 2), WS_U = WS_GA + al((size_t)MALL * D * 2), WS_O = WS_U + al((size_t)MALL * DIN * 2), WS_END = WS_O + al((size_t)MALL * D * 2);
constexpr size_t WS_MIX = WS_XBC, WS_TMP = WS_XBC + (size_t)MMAIN * D * 2, WS_HB = WS_XBC, WS_T1 = WS_Q, WS_T2 = WS_Z;
static_assert(WS_TMP + (size_t)MMAIN * D * 2 <= WS_DT && WS_HB + (size_t)MMAIN * DFF * 2 <= WS_DT && WS_T2 + (size_t)MMAIN * D * 4 <= WS_XBC, "overlays");
static_assert(WS_END <= ((size_t)2048 << 20), "workspace map fits 2 GiB");
constexpr int CW_TMO = 0, CW_BAR = 4096;
constexpr int RING_OFF = 0, RING_BYTES = 131072, LDSCTL_OFF = RING_BYTES, MISC_OFF = LDSCTL_OFF + 320, LDS_BYTES = 147456;

typedef unsigned short bf16;
typedef unsigned v4u __attribute__((ext_vector_type(4)));
typedef unsigned v2u __attribute__((ext_vector_type(2)));
typedef float f32x4 __attribute__((ext_vector_type(4)));
typedef float f32x16 __attribute__((ext_vector_type(16)));
typedef short bf16x8 __attribute__((ext_vector_type(8)));
typedef short s16x4 __attribute__((ext_vector_type(4)));

#ifdef EMU
#define DEV inline
DEV float EXP2(float x) { return exp2f(x); }
DEV float LOG2(float x) { return log2f(x); }
DEV float RCP(float x) { return 1.0f / x; }
DEV float RSQ(float x) { return 1.0f / sqrtf(x); }
DEV unsigned pk2(float lo, float hi) { return (unsigned)emu_f2bf(lo) | ((unsigned)emu_f2bf(hi) << 16); }
DEV f32x16 mfma32(bf16x8 a, bf16x8 b, f32x16 c) { return emu_mfma32(a, b, c); }
DEV float uaf(unsigned u) { float f; memcpy(&f, &u, 4); return f; }
#define LDS_WAIT() do {} while (0)
#define SCHED_BAR() do {} while (0)
#define BAR_LDS() __syncthreads()
DEV int opaque_v(int x) { return x; }
#define VM_WAIT() do {} while (0)
#else
#define DEV __device__ __forceinline__
DEV float EXP2(float x) { return __builtin_amdgcn_exp2f(x); }
DEV float LOG2(float x) { return __builtin_amdgcn_logf(x); }
DEV float RCP(float x) { return __builtin_amdgcn_rcpf(x); }
DEV float RSQ(float x) { return __builtin_amdgcn_rsqf(x); }
typedef float f32x2_t __attribute__((ext_vector_type(2))); typedef __bf16 bf16x2_t __attribute__((ext_vector_type(2)));
DEV unsigned pk2(float lo, float hi) { f32x2_t v = {lo, hi}; bf16x2_t b = __builtin_convertvector(v, bf16x2_t); return __builtin_bit_cast(unsigned, b); }
DEV f32x16 mfma32(bf16x8 a, bf16x8 b, f32x16 c) { return __builtin_amdgcn_mfma_f32_32x32x16_bf16(a, b, c, 0, 0, 0); }
DEV float uaf(unsigned u) { return __uint_as_float(u); }
#define LDS_WAIT() asm volatile("s_waitcnt lgkmcnt(0)" ::: "memory")
#define SCHED_BAR() __builtin_amdgcn_sched_barrier(0)
#define BAR_LDS() asm volatile("s_waitcnt lgkmcnt(0)\n\ts_barrier" ::: "memory")
DEV int opaque_v(int x) { asm volatile("" : "+v"(x)); return x; }
#define VM_WAIT() asm volatile("s_waitcnt vmcnt(0)" ::: "memory")
#endif
#ifdef EMU
DEV int lane_id_() { return (int)(threadIdx.x & 63); }
#else
DEV int lane_id_() { int x; asm volatile("v_mbcnt_lo_u32_b32 %0, -1, 0\n\tv_mbcnt_hi_u32_b32 %0, -1, %0" : "=v"(x)); return x; }
#endif
#ifdef EMU
DEV float rdfl_f(float x) { return x; }
#else
DEV float rdfl_f(float x) { return __builtin_bit_cast(float, __builtin_amdgcn_readfirstlane(__builtin_bit_cast(int, x))); }
#endif
DEV float bflo(unsigned w) { return uaf(w << 16); }
DEV float bfhi(unsigned w) { return uaf(w & 0xffff0000u); }
DEV float bf2f(bf16 b) { return uaf((unsigned)b << 16); }
DEV float sigmoidf_(float x) { return RCP(1.0f + EXP2(-x * LOG2E)); }
DEV float siluf_(float x) { return x * sigmoidf_(x); }
DEV float softplusf_(float x) { return fmaxf(x, 0.f) + LN2 * LOG2(1.0f + EXP2(-fabsf(x) * LOG2E)); }
DEV int crow(int reg, int h) { return (reg & 3) + 8 * (reg >> 2) + 4 * h; }
DEV float wave_sum(float v) {
#pragma unroll
    for (int o = 1; o < 64; o <<= 1) v += __shfl_xor(v, o);
    return v;
}
DEV bf16x8 pack_step(const f32x16& x, int s) {
    v4u p; p.x = pk2(x[8 * s], x[8 * s + 1]); p.y = pk2(x[8 * s + 2], x[8 * s + 3]); p.z = pk2(x[8 * s + 4], x[8 * s + 5]); p.w = pk2(x[8 * s + 6], x[8 * s + 7]);
    return __builtin_bit_cast(bf16x8, p);
}
DEV bf16x8 rd16(const LAS unsigned char* p) { return *(const LAS bf16x8*)p; }
DEV bf16x8 rd8x2(const LAS unsigned char* p) {
    const v2u a = *(const LAS v2u*)p, b = *(const LAS v2u*)(p + 16); v4u r; r.x = a.x; r.y = a.y; r.z = b.x; r.w = b.y; return __builtin_bit_cast(bf16x8, r);
}

struct Frame {
    LAS unsigned char* lds;
    unsigned* ctl;
    int wave, G, vcu; unsigned tacc;
    DEV int lane() const { return lane_id_(); }
    DEV int tid() const { return wave * 64 + lane_id_(); }
    const float* const* in; float* out; unsigned char* ws;
#define WSP(T, NAME, OFF) DEV T* NAME() const { return (T*)(ws + OFF); }
    WSP(bf16, WinT, WS_WIN) WSP(bf16, WssdT, WS_WSSD) WSP(bf16, WattT, WS_WATT) WSP(bf16, WoT, WS_WO) WSP(bf16, WffT, WS_WFF) WSP(bf16, Wff2T, WS_WFF2)
    WSP(bf16, XN, WS_XN) WSP(bf16, Z, WS_Z) WSP(bf16, XBC, WS_XBC) WSP(bf16, Q, WS_Q) WSP(bf16, K, WS_K) WSP(bf16, V, WS_V) WSP(bf16, GS, WS_GS) WSP(bf16, GA, WS_GA) WSP(bf16, U, WS_U) WSP(bf16, O, WS_O)
    WSP(bf16, MIX, WS_MIX) WSP(bf16, TMP, WS_TMP) WSP(bf16, HB, WS_HB) WSP(float, DT, WS_DT) WSP(bf16, T1, WS_T1) WSP(bf16, T2, WS_T2)
#undef WSP
};
enum { I_XP = 0, I_XS, I_CK, I_CV, I_SSM, I_SCONV, I_META, I_RELB, I_NPRE, I_WIN, I_CONVW, I_CONVB, I_DTB, I_ALOG, I_DSKIP, I_SSDN, I_WSSD, I_LQ1, I_LK1, I_LQ2, I_LK2, I_SUBLN, I_WATT, I_WO, I_NPOST, I_NFFN, I_WFF, I_WFF2, I_NFFNP };

#if !defined(EMU) && defined(PROBE_SEC)
#define PT_NOW() ((unsigned)__builtin_amdgcn_s_memrealtime())
#define PT_ADD(sec, t0, t1) do { if (PROBE_SEC == (sec) && F.wave == 0) F.tacc += (t1) - (t0); } while (0)
#else
#define PT_NOW() 0u
#define PT_ADD(sec, t0, t1) do {} while (0)
#endif
DEV void p0_transpose_item(const float* W, int K, int N, int src_col0, bf16* WT, int dst_row0, LAS float* scr, int kb, int lane) {
    const int k0 = 64 * kb;
    float wv[32];
#pragma unroll
    for (int i = 0; i < 32; ++i) { const int kk = 2 * i + (lane >> 5); wv[i] = src_col0 >= 0 ? W[(size_t)(k0 + kk) * N + src_col0 + (lane & 31)] : 0.f; }
#pragma unroll
    for (int i = 0; i < 32; ++i) { const int kk = 2 * i + (lane >> 5); scr[kk * 33 + (lane & 31)] = wv[i]; }
    WAVE_LDS_SYNC();
    const int c = lane & 7;
#pragma unroll
    for (int j = 0; j < 4; ++j) { const int n = (lane >> 3) + 8 * j; const LAS float* s = scr + (8 * c) * 33 + n;
        v4u o; o.x = pk2(s[0 * 33], s[1 * 33]); o.y = pk2(s[2 * 33], s[3 * 33]); o.z = pk2(s[4 * 33], s[5 * 33]); o.w = pk2(s[6 * 33], s[7 * 33]);
        *(v4u*)(WT + (size_t)(dst_row0 + n) * K + k0 + 8 * c) = o; }
    WAVE_LDS_SYNC();
}
DEV void rms_row_to_bf16(const float* xrow, const float* gain, bf16* orow, int lane) {
    unsigned long long* o8 = (unsigned long long*)orow + lane;
    if (!xrow) {
#pragma unroll
        for (int j = 0; j < 4; ++j) o8[64 * j] = 0ull;
        return; }
    const f32x4* xr = (const f32x4*)xrow + lane; const f32x4* gr = (const f32x4*)gain + lane;
    f32x4 v[4]; float s = 0.f;
#pragma unroll
    for (int j = 0; j < 4; ++j) { v[j] = xr[64 * j]; s += (v[j].x * v[j].x + v[j].y * v[j].y) + (v[j].z * v[j].z + v[j].w * v[j].w); }
    const float r = RSQ(wave_sum(s) * (1.f / D) + EPS);
#pragma unroll
    for (int j = 0; j < 4; ++j) { const f32x4 g = gr[64 * j]; o8[64 * j] = (unsigned long long)pk2(v[j].x * r * g.x, v[j].y * r * g.y) | ((unsigned long long)pk2(v[j].z * r * g.z, v[j].w * r * g.w) << 32); }
}
DEV const float* x_row_ptr(const Frame& F, int m) {
    if (m < MP) return F.in[I_XP] + (size_t)m * D;
    if (m < MMAIN) return F.in[I_XS] + (size_t)(m - MP) * D;
    if (m < MMAIN + NMETA) return F.in[I_META] + (size_t)(m - MMAIN) * D;
    return nullptr;
}
constexpr int P0_GAIN_OFF = LDSCTL_OFF + 1024;
DEV void p0_prologue(Frame& F) {
    LAS float* scr = (LAS float*)(F.lds + RING_OFF + F.wave * 16384);
    { LAS float* GL = (LAS float*)(F.lds + P0_GAIN_OFF); for (int k = F.tid(); k < D; k += NWAVES * 64) GL[k] = F.in[I_NPRE][k]; __syncthreads(); }
    const int gw = F.vcu * NWAVES + F.wave, NGW = F.G * NWAVES;
    constexpr int I_IN = (D / 64) * (NPROJ / 32), I_SSD = (DIN / 64) * (D / 32), I_ATT = (D / 64) * (D / 32), I_O = I_ATT, I_FF = (D / 64) * (2 * DFF / 32), I_FF2 = (DFF / 64) * (D / 32);
    constexpr int NITEMS = I_IN + I_SSD + I_ATT + I_O + I_FF + I_FF2;
    for (int it = gw; it < NITEMS; it += NGW) {
        int r = it;
        if (r < I_IN) {
            const int nblk = NPROJ / 32, kb = r / nblk, n0 = 32 * (r % nblk);
            const int src = n0 < 6144 ? n0 : (n0 < 11264 ? n0 + 32 : (n0 == 11264 ? 6144 : -1));
            p0_transpose_item(F.in[I_WIN], D, 11296, src, F.WinT(), n0, scr, kb, F.lane()); continue; } r -= I_IN;
        if (r < I_SSD) { const int nblk = D / 32; p0_transpose_item(F.in[I_WSSD], DIN, D, 32 * (r % nblk), F.WssdT(), 32 * (r % nblk), scr, r / nblk, F.lane()); continue; } r -= I_SSD;
        if (r < I_ATT) { const int nblk = D / 32; p0_transpose_item(F.in[I_WATT], D, D, 32 * (r % nblk), F.WattT(), 32 * (r % nblk), scr, r / nblk, F.lane()); continue; } r -= I_ATT;
        if (r < I_O) { const int nblk = D / 32; p0_transpose_item(F.in[I_WO], D, D, 32 * (r % nblk), F.WoT(), 32 * (r % nblk), scr, r / nblk, F.lane()); continue; } r -= I_O;
        if (r < I_FF) {
            const int nblk = 2 * DFF / 32, kb = r / nblk, n0 = 32 * (r % nblk), t = n0 / 256, w = n0 % 256;
            const int src = w < 128 ? 128 * t + w : DFF + 128 * t + (w - 128);
            p0_transpose_item(F.in[I_WFF], D, 2 * DFF, src, F.WffT(), n0, scr, kb, F.lane()); continue; } r -= I_FF;
        { const int nblk = D / 32; p0_transpose_item(F.in[I_WFF2], DFF, D, 32 * (r % nblk), F.Wff2T(), 32 * (r % nblk), scr, r / nblk, F.lane()); }
    }
    for (int m = gw; m < MALL; m += 2 * NGW) {
        const int m2 = m + NGW; const float* x1 = x_row_ptr(F, m); const float* x2 = m2 < MALL ? x_row_ptr(F, m2) : nullptr;
        const LAS f32x4* gr = (const LAS f32x4*)(F.lds + P0_GAIN_OFF) + F.lane(); f32x4 v1[4], v2[4]; float s1 = 0.f, s2 = 0.f;
#pragma unroll
        for (int jj = 0; jj < 4; ++jj) { const f32x4 z = {0.f, 0.f, 0.f, 0.f}; v1[jj] = x1 ? ((const f32x4*)x1 + F.lane())[64 * jj] : z; v2[jj] = x2 ? ((const f32x4*)x2 + F.lane())[64 * jj] : z; }
#pragma unroll
        for (int jj = 0; jj < 4; ++jj) { s1 += (v1[jj].x * v1[jj].x + v1[jj].y * v1[jj].y) + (v1[jj].z * v1[jj].z + v1[jj].w * v1[jj].w); s2 += (v2[jj].x * v2[jj].x + v2[jj].y * v2[jj].y) + (v2[jj].z * v2[jj].z + v2[jj].w * v2[jj].w); }
        const float r1 = RSQ(wave_sum(s1) * (1.f / D) + EPS), r2 = RSQ(wave_sum(s2) * (1.f / D) + EPS);
        unsigned long long* o1 = (unsigned long long*)(F.XN() + (size_t)m * D) + F.lane(); unsigned long long* o2 = (unsigned long long*)(F.XN() + (size_t)m2 * D) + F.lane();
#pragma unroll
        for (int jj = 0; jj < 4; ++jj) { const f32x4 gq = gr[64 * jj];
            o1[64 * jj] = (unsigned long long)pk2(v1[jj].x * r1 * gq.x, v1[jj].y * r1 * gq.y) | ((unsigned long long)pk2(v1[jj].z * r1 * gq.z, v1[jj].w * r1 * gq.w) << 32);
            if (m2 < MALL) o2[64 * jj] = (unsigned long long)pk2(v2[jj].x * r2 * gq.x, v2[jj].y * r2 * gq.y) | ((unsigned long long)pk2(v2[jj].z * r2 * gq.z, v2[jj].w * r2 * gq.w) << 32); }
    }
}

#ifdef EMU
#define NT_STORE16(p, v) (*(p) = (v))
#else
#define NT_STORE16(p, v) __builtin_nontemporal_store((v), (p))
#endif
namespace pg8 {
struct EpiProj {
    static constexpr bool PERM = true, AFTER_DRAIN = false;
    bf16 *Z, *XBC, *Q, *K, *V, *GS, *GA; float* DT; const float* dtb; float* out;
    __device__ __forceinline__ void operator()(const f32x4 (&acc)[2][2][4][2], const Unit& u, int wr, int wc, int fr, int fq) const {
        const int t = u.pn;
        if (t == 44) {
            if (wc != 0) return;
            const f32x4 b0 = *(const f32x4*)(dtb + 8 * fq), b1 = *(const f32x4*)(dtb + 8 * fq + 4);
#pragma unroll
            for (int ai = 0; ai < 2; ++ai)
#pragma unroll
                for (int m = 0; m < 4; ++m) { const int r = u.pm * 256 + ai * 128 + wr * 64 + m * 16 + fr; f32x4 v0 = acc[ai][0][m][0] + b0, v1 = acc[ai][0][m][1] + b1;
#pragma unroll
                    for (int e = 0; e < 4; ++e) { v0[e] = softplusf_(v0[e]); v1[e] = softplusf_(v1[e]); }
                    *(f32x4*)(DT + (size_t)r * 32 + 8 * fq) = v0; *(f32x4*)(DT + (size_t)r * 32 + 8 * fq + 4) = v1; }
            return; }
        bf16* base; int ld, c0; int kind;
        if (t < 8) { base = Z; ld = DIN; c0 = 256 * t; kind = 0; }
        else if (t < 24) { base = XBC; ld = CONVD; c0 = 256 * (t - 8); kind = 1; }
        else if (t < 28) { base = Q; ld = D; c0 = 256 * (t - 24); kind = 2; }
        else if (t < 32) { base = K; ld = D; c0 = 256 * (t - 28); kind = 3; }
        else if (t < 36) { base = V; ld = D; c0 = 256 * (t - 32); kind = 4; }
        else if (t < 40) { base = GS; ld = D; c0 = 256 * (t - 36); kind = 5; }
        else { base = GA; ld = D; c0 = 256 * (t - 40); kind = 5; }
#pragma unroll
        for (int ai = 0; ai < 2; ++ai)
#pragma unroll
            for (int m = 0; m < 4; ++m) { const int r = u.pm * 256 + ai * 128 + wr * 64 + m * 16 + fr;
#pragma unroll
                for (int bj = 0; bj < 2; ++bj) { const int col = c0 + bj * 128 + wc * 32 + 8 * fq; f32x4 v0 = acc[ai][bj][m][0], v1 = acc[ai][bj][m][1];
                    if (kind == 1) {
                        float* dst = nullptr;
                        if (r < MP) { const int tt = r % SEQ; if (tt >= SEQ - 3) dst = out + OUT_CP + ((size_t)(r / SEQ) * 3 + (tt - (SEQ - 3))) * CONVD + col; }
                        else if (r < MMAIN) { const int tt = (r - MP) % DSEQ; if (tt >= DSEQ - 3) dst = out + OUT_CS + ((size_t)((r - MP) / DSEQ) * 3 + (tt - (DSEQ - 3))) * CONVD + col; }
                        if (dst) { *(f32x4*)dst = v0; *(f32x4*)(dst + 4) = v1; } }
                    if (kind == 2) { v0 = v0 * QSCALE; v1 = v1 * QSCALE; }
                    if (kind == 5) {
#pragma unroll
                        for (int e = 0; e < 4; ++e) { v0[e] = sigmoidf_(v0[e]); v1[e] = sigmoidf_(v1[e]); } }
                    u32x4 w; w.x = cvt_pk_bf16(v0[0], v0[1]); w.y = cvt_pk_bf16(v0[2], v0[3]); w.z = cvt_pk_bf16(v1[0], v1[1]); w.w = cvt_pk_bf16(v1[2], v1[3]);
                    *(u32x4*)(base + (size_t)r * ld + col) = w; } }
    }
};
template <int SECOND> struct EpiGate {
    static constexpr bool PERM = true, AFTER_DRAIN = false;
    const bf16* G; const bf16* T; bf16* O;
    __device__ __forceinline__ void operator()(const f32x4 (&acc)[2][2][4][2], const Unit& u, int wr, int wc, int fr, int fq) const {
#pragma unroll
        for (int ai = 0; ai < 2; ++ai) {
            u32x4 gv[4][2], tv[4][2];
#pragma unroll
            for (int m = 0; m < 4; ++m)
#pragma unroll
                for (int bj = 0; bj < 2; ++bj) { const size_t off = (size_t)(u.pm * 256 + ai * 128 + wr * 64 + m * 16 + fr) * D + u.pn * 256 + bj * 128 + wc * 32 + 8 * fq;
                    gv[m][bj] = *(const u32x4*)(G + off); if (SECOND) tv[m][bj] = *(const u32x4*)(T + off); }
            SCHED_BAR();
#pragma unroll
            for (int m = 0; m < 4; ++m)
#pragma unroll
                for (int bj = 0; bj < 2; ++bj) { const size_t off = (size_t)(u.pm * 256 + ai * 128 + wr * 64 + m * 16 + fr) * D + u.pn * 256 + bj * 128 + wc * 32 + 8 * fq;
                    const u32x4 g = gv[m][bj]; const f32x4 a0 = acc[ai][bj][m][0], a1 = acc[ai][bj][m][1];
                    float v[8] = {a0[0] * bflo(g.x), a0[1] * bfhi(g.x), a0[2] * bflo(g.y), a0[3] * bfhi(g.y), a1[0] * bflo(g.z), a1[1] * bfhi(g.z), a1[2] * bflo(g.w), a1[3] * bfhi(g.w)};
                    if (SECOND) { const u32x4 tq = tv[m][bj];
                        v[0] += bflo(tq.x); v[1] += bfhi(tq.x); v[2] += bflo(tq.y); v[3] += bfhi(tq.y); v[4] += bflo(tq.z); v[5] += bfhi(tq.z); v[6] += bflo(tq.w); v[7] += bfhi(tq.w); }
                    u32x4 w; w.x = cvt_pk_bf16(v[0], v[1]); w.y = cvt_pk_bf16(v[2], v[3]); w.z = cvt_pk_bf16(v[4], v[5]); w.w = cvt_pk_bf16(v[6], v[7]);
                    *(u32x4*)(O + off) = w; }
            SCHED_BAR(); }
    }
};
struct EpiF32 {
    static constexpr bool PERM = false, AFTER_DRAIN = false;
    float* O; int ldc;
    __device__ __forceinline__ void operator()(const f32x4 (&acc)[2][2][4][2], const Unit& u, int wr, int wc, int fr, int fq) const {
#pragma unroll
        for (int ai = 0; ai < 2; ++ai)
#pragma unroll
            for (int m = 0; m < 4; ++m) { float* rowp = O + (size_t)(u.pm * 256 + ai * 128 + wr * 64 + m * 16 + fr) * ldc + u.pn * 256 + wc * 32 + 4 * fq;
#pragma unroll
                for (int bj = 0; bj < 2; ++bj)
#pragma unroll
                    for (int n = 0; n < 2; ++n) *(f32x4*)(rowp + bj * 128 + n * 16) = acc[ai][bj][m][n]; }
    }
};
struct EpiT {
    static constexpr bool PERM = true, AFTER_DRAIN = false;
    bf16* O; int ldc;
    __device__ __forceinline__ void operator()(const f32x4 (&acc)[2][2][4][2], const Unit& u, int wr, int wc, int fr, int fq) const {
#pragma unroll
        for (int ai = 0; ai < 2; ++ai)
#pragma unroll
            for (int m = 0; m < 4; ++m) { bf16* rowp = O + (size_t)(u.pm * 256 + ai * 128 + wr * 64 + m * 16 + fr) * ldc + u.pn * 256 + wc * 32 + 8 * fq;
#pragma unroll
                for (int bj = 0; bj < 2; ++bj) { const f32x4 v0 = acc[ai][bj][m][0], v1 = acc[ai][bj][m][1];
                    u32x4 w; w.x = cvt_pk_bf16(v0[0], v0[1]); w.y = cvt_pk_bf16(v0[2], v0[3]); w.z = cvt_pk_bf16(v1[0], v1[1]); w.w = cvt_pk_bf16(v1[2], v1[3]);
                    *(u32x4*)(rowp + bj * 128) = w; } }
    }
};
struct EpiSwiglu {
    static constexpr bool PERM = true, AFTER_DRAIN = false;
    bf16* O;
    __device__ __forceinline__ void operator()(const f32x4 (&acc)[2][2][4][2], const Unit& u, int wr, int wc, int fr, int fq) const {
#pragma unroll
        for (int ai = 0; ai < 2; ++ai)
#pragma unroll
            for (int m = 0; m < 4; ++m) { const int r = u.pm * 256 + ai * 128 + wr * 64 + m * 16 + fr;
                const f32x4 g0 = acc[ai][0][m][0], g1 = acc[ai][0][m][1], u0 = acc[ai][1][m][0], u1 = acc[ai][1][m][1]; float v[8];
#pragma unroll
                for (int e = 0; e < 4; ++e) { v[e] = siluf_(g0[e]) * u0[e]; v[4 + e] = siluf_(g1[e]) * u1[e]; }
                u32x4 w; w.x = cvt_pk_bf16(v[0], v[1]); w.y = cvt_pk_bf16(v[2], v[3]); w.z = cvt_pk_bf16(v[4], v[5]); w.w = cvt_pk_bf16(v[6], v[7]);
                *(u32x4*)(O + (size_t)r * DFF + u.pn * 128 + wc * 32 + 8 * fq) = w; }
    }
};
}
constexpr int S_XT = 0, S_BM = 36864, S_BT = S_BM + 17408, S_CM = S_BT + 18432, S_ZU = S_CM + 17408, S_ACS = S_ZU + 33792, S_DTV = S_ACS + 1024, S_WSC = S_DTV + 1024, S_SSQ = S_WSC + 1024, S_END = S_SSQ + 2048;
constexpr int XT_P = 144, BM_P = 272, ZU_P = 528;
static_assert(S_END <= RING_BYTES, "SSD LDS map");
constexpr int S_CW = LDSCTL_OFF + 1024;
constexpr int S_GN = S_CW + 5 * 512 * 4;
static_assert(S_GN + 1024 <= LDS_BYTES, "conv weight table");
struct SsdChunk { int row0; int t0, t1, halo; bool store_y; };

DEV v4u ssd_raw_row(const Frame& F, const SsdChunk& ck, int sb, int tp, int col) {
    const v4u zero = {0u, 0u, 0u, 0u};
    if (tp >= ck.t0 && tp < ck.t1) return *(const v4u*)(F.XBC() + (int)(ck.row0 + tp) * CONVD + col);
    if (tp < ck.t0 && tp >= ck.t0 - 3) {
        if (ck.halo == 1) return *(const v4u*)(F.XBC() + (int)(ck.row0 + tp) * CONVD + col);
        if (ck.halo == 2) return *(const v4u*)(F.XBC() + (int)(MMAIN + NMETA + (tp - ck.t0)) * CONVD + col);
        if (ck.halo == 3) { const float* s = F.in[I_SCONV] + ((int)sb * 3 + (3 + tp - ck.t0)) * CONVD + col; const f32x4 a = *(const f32x4*)s, b = *(const f32x4*)(s + 4);
            v4u r; r.x = pk2(a.x, a.y); r.y = pk2(a.z, a.w); r.z = pk2(b.x, b.y); r.w = pk2(b.z, b.w); return r; }
    }
    return zero;
}
typedef float f32x2v __attribute__((ext_vector_type(2)));
DEV unsigned hw_(unsigned w, int h) { return h ? (w >> 16) : (w & 0xffffu); }

DEV void ssd_prefetch(const Frame& F, const SsdChunk& ck, int sb, int g, int lane, int tid, int w, v4u (&raw)[11], v4u (&zr)[4], float& dtv) {
    const int cg = lane, to = w;
    const int col = cg < 32 ? 256 * g + 8 * cg : (cg < 48 ? 2048 + 128 * g + 8 * (cg - 32) : 3072 + 128 * g + 8 * (cg - 48));
#pragma unroll
    for (int i = 0; i < 11; ++i) raw[i] = ssd_raw_row(F, ck, sb, 8 * to - 3 + i, col);
    { const int t = tid >> 3, seg = tid & 7; const bool valid = ck.store_y && t >= ck.t0 && t < ck.t1; const v4u zero = {0u, 0u, 0u, 0u};
#pragma unroll
      for (int i = 0; i < 4; ++i) zr[i] = valid ? *(const v4u*)(F.Z() + (int)(ck.row0 + t) * DIN + 256 * g + 32 * seg + 8 * i) : zero; }
    dtv = 0.f;
    if (w < 4) { const int t = lane; if (t >= ck.t0 && t < ck.t1) dtv = F.DT()[(int)(ck.row0 + t) * 32 + 4 * g + w]; }
}
DEV void ssd_chunk(Frame& F, const SsdChunk& ck, bool has_next, const SsdChunk& ckn, int sb, int g, f32x16 (&hacc)[4], v4u (&raw)[11], v4u (&zr)[4], float& dtv, const float a_coef, const float Dh) {
    LAS unsigned char* L = F.lds + RING_OFF;
    const int lane = opaque_v(F.lane()), tid = opaque_v(F.tid()), w = F.wave, l31 = lane & 31, hh = lane >> 5, h = w >> 1, j = w & 1;
    BAR_LDS();
    const unsigned pt0_ = PT_NOW();
    if (w < 4) {
        const int t = lane;
        const float a = a_coef;
        float x = dtv * a;
#pragma unroll
        for (int d = 1; d < 64; d <<= 1) { const float v = __shfl_up(x, d); if (lane >= d) x += v; }
        const float last = __shfl(x, 63);
        ((LAS float*)(L + S_ACS))[w * 64 + t] = x; ((LAS float*)(L + S_DTV))[w * 64 + t] = dtv; ((LAS float*)(L + S_WSC))[w * 64 + t] = EXP2((last - x) * LOG2E) * dtv;
    }
    SCHED_BAR();
    {
        const int cg = lane, to = w;
        const int col = cg < 32 ? 256 * g + 8 * cg : (cg < 48 ? 2048 + 128 * g + 8 * (cg - 32) : 3072 + 128 * g + 8 * (cg - 48));
        const LAS float* cwl = (const LAS float*)(F.lds + S_CW) + cg;
        unsigned pk[8][4];
#pragma unroll
        for (int e2 = 0; e2 < 4; ++e2) {
            f32x2v wgt[4], bias, xr[11];
#pragma unroll
            for (int i = 0; i < 4; ++i) wgt[i] = (f32x2v){cwl[(8 * i + 2 * e2) * 64], cwl[(8 * i + 2 * e2 + 1) * 64]};
            bias = (f32x2v){cwl[(32 + 2 * e2) * 64], cwl[(32 + 2 * e2 + 1) * 64]};
#pragma unroll
            for (int i = 0; i < 11; ++i) { const unsigned rw = raw[i][e2]; xr[i] = (f32x2v){bflo(rw), bfhi(rw)}; }
#pragma unroll
            for (int tt = 0; tt < 8; ++tt) { f32x2v a = bias;
#pragma unroll
                for (int i = 0; i < 4; ++i) a = wgt[i] * xr[tt + i] + a;
                const f32x2v e = (f32x2v){EXP2(a.x * -LOG2E), EXP2(a.y * -LOG2E)} + 1.0f;
                pk[tt][e2] = pk2(a.x * RCP(e.x), a.y * RCP(e.y)); }
            SCHED_BAR();
        }
        if (cg < 48) {
            LAS unsigned char* base = cg < 32 ? L + S_XT + (8 * cg) * XT_P : L + S_BT + (8 * (cg - 32)) * XT_P;
#pragma unroll
            for (int e = 0; e < 8; ++e) { v4u o;
                o.x = hw_(pk[0][e >> 1], e & 1) | (hw_(pk[1][e >> 1], e & 1) << 16); o.y = hw_(pk[2][e >> 1], e & 1) | (hw_(pk[3][e >> 1], e & 1) << 16);
                o.z = hw_(pk[4][e >> 1], e & 1) | (hw_(pk[5][e >> 1], e & 1) << 16); o.w = hw_(pk[6][e >> 1], e & 1) | (hw_(pk[7][e >> 1], e & 1) << 16);
                *(LAS v4u*)(base + e * XT_P + 16 * to) = o; }
        }
        if (cg >= 32) {
            LAS unsigned char* base = cg < 48 ? L + S_BM + 16 * (cg - 32) : L + S_CM + 16 * (cg - 48);
#pragma unroll
            for (int tt = 0; tt < 8; ++tt) { v4u o; o.x = pk[tt][0]; o.y = pk[tt][1]; o.z = pk[tt][2]; o.w = pk[tt][3]; *(LAS v4u*)(base + (8 * to + tt) * BM_P) = o; }
        }
    }
    SCHED_BAR();
    {
        const int t = tid >> 3, seg = tid & 7;
#pragma unroll
        for (int i = 0; i < 4; ++i) *(LAS v4u*)(L + S_ZU + t * ZU_P + seg * 64 + 16 * i) = zr[i];
    }
    SCHED_BAR();
    if (has_next) ssd_prefetch(F, ckn, sb, g, lane, tid, w, raw, zr, dtv);
    const unsigned pt1_ = PT_NOW();
    BAR_LDS();
    const unsigned pt2_ = PT_NOW(); PT_ADD(11, pt0_, pt1_); PT_ADD(12, pt1_, pt2_);
    const LAS float* ACS = (const LAS float*)(L + S_ACS) + h * 64; const LAS float* DTV = (const LAS float*)(L + S_DTV) + h * 64; const LAS float* WSC = (const LAS float*)(L + S_WSC) + h * 64;
    const LAS float* acs_l = ACS + l31;
    const LAS float* acs_h = ACS + 4 * hh;  const LAS float* dtv_h = DTV + 4 * hh;
    const LAS float* wsc_h = WSC + 8 * hh;
    const LAS unsigned char* cm4 = L + S_CM + l31 * BM_P + 8 * hh;
    const LAS unsigned char* cm8 = L + S_CM + l31 * BM_P + 16 * hh;
    const LAS unsigned char* bm8 = L + S_BM + l31 * BM_P + 16 * hh;
    const LAS unsigned char* xt4 = L + S_XT + (64 * h + 32 * j + l31) * XT_P + 8 * hh;
    const LAS unsigned char* xt8 = L + S_XT + (64 * h + 32 * j + l31) * XT_P + 16 * hh;
    const LAS unsigned char* bt8 = L + S_BT + l31 * XT_P + 16 * hh;
    f32x16 yacc[2];
#pragma unroll
    for (int tb = 0; tb < 2; ++tb)
#pragma unroll
        for (int r = 0; r < 16; ++r) yacc[tb][r] = 0.f;
    {
        bf16x8 cf[2][2][2];
#define LD_CF(buf, nb) do { _Pragma("unroll") for (int ss = 0; ss < 2; ++ss) _Pragma("unroll") for (int tb = 0; tb < 2; ++tb) cf[buf][ss][tb] = rd8x2(cm4 + 32 * tb * BM_P + (32 * (nb) + 16 * ss) * 2); } while (0)
        LD_CF(0, 0);
#pragma unroll
        for (int nb = 0; nb < 4; ++nb) {
            SCHED_BAR();
            if (nb < 3) LD_CF((nb + 1) & 1, nb + 1);
#pragma unroll
            for (int ss = 0; ss < 2; ++ss) { const bf16x8 a = pack_step(hacc[nb], ss);
#pragma unroll
                for (int tb = 0; tb < 2; ++tb) yacc[tb] = mfma32(a, cf[nb & 1][ss][tb], yacc[tb]); }
        }
#undef LD_CF
        SCHED_BAR();
    }
    float acs_t[2];
#pragma unroll
    for (int tb = 0; tb < 2; ++tb) { acs_t[tb] = acs_l[32 * tb]; const float e = EXP2(acs_t[tb] * LOG2E);
#pragma unroll
        for (int r = 0; r < 16; ++r) yacc[tb][r] *= e; }
    const int dl = l31 - 4 * hh;
    {
        bf16x8 fa[2][2], fb[2][2];
#define LD_G(buf, grp) do { const int t_ = (grp) >> 2, sb_ = t_ == 2 ? 1 : 0, tb_ = t_ == 0 ? 0 : 1, k0_ = 2 * ((grp) & 3); \
        _Pragma("unroll") for (int q = 0; q < 2; ++q) { fa[buf][q] = rd16(bm8 + 32 * sb_ * BM_P + 32 * (k0_ + q)); fb[buf][q] = rd16(cm8 + 32 * tb_ * BM_P + 32 * (k0_ + q)); } } while (0)
        LD_G(0, 0);
        f32x16 gt;
#pragma unroll
        for (int grp = 0; grp < 12; ++grp) { const int tile = grp >> 2, sb2 = tile == 2 ? 1 : 0, tb = tile == 0 ? 0 : 1;
            SCHED_BAR();
            if (grp < 11) LD_G((grp + 1) & 1, grp + 1);
            if ((grp & 3) == 0) {
#pragma unroll
                for (int r = 0; r < 16; ++r) gt[r] = 0.f; }
#pragma unroll
            for (int q = 0; q < 2; ++q) gt = mfma32(fa[grp & 1][q], fb[grp & 1][q], gt);
            if ((grp & 3) == 3) {
                SCHED_BAR();
                const bf16x8 xa0 = rd8x2(xt4 + (32 * sb2) * 2), xa1 = rd8x2(xt4 + (32 * sb2 + 16) * 2);
#pragma unroll
                for (int r = 0; r < 16; ++r) { const int so = 32 * sb2 + (r & 3) + 8 * (r >> 2); const float v = gt[r] * EXP2((acs_t[tb] - acs_h[so]) * LOG2E) * dtv_h[so];
                    gt[r] = (tile == 1 || (r & 3) + 8 * (r >> 2) <= dl) ? v : 0.f; }
                yacc[tb] = mfma32(xa0, pack_step(gt, 0), yacc[tb]); yacc[tb] = mfma32(xa1, pack_step(gt, 1), yacc[tb]);
            }
        }
#undef LD_G
        SCHED_BAR();
    }
    { const float dec = EXP2(ACS[63] * LOG2E);
#pragma unroll
      for (int nb = 0; nb < 4; ++nb)
#pragma unroll
          for (int r = 0; r < 16; ++r) hacc[nb][r] *= dec;
      bf16x8 ba[2][4]; v4u xr[2]; f32x4 w0[2], w1[2];
#define LD_S(buf, ks) do { xr[buf] = __builtin_bit_cast(v4u, rd16(xt8 + 32 * (ks))); w0[buf] = *(const LAS f32x4*)(wsc_h + 16 * (ks)); w1[buf] = *(const LAS f32x4*)(wsc_h + 16 * (ks) + 4); \
        _Pragma("unroll") for (int nb = 0; nb < 4; ++nb) ba[buf][nb] = rd16(bt8 + 32 * nb * XT_P + 32 * (ks)); } while (0)
      LD_S(0, 0);
#pragma unroll
      for (int ks = 0; ks < 4; ++ks) { const int bu = ks & 1;
          SCHED_BAR();
          if (ks < 3) LD_S((ks + 1) & 1, ks + 1);
          v4u xs; xs.x = pk2(bflo(xr[bu].x) * w0[bu].x, bfhi(xr[bu].x) * w0[bu].y); xs.y = pk2(bflo(xr[bu].y) * w0[bu].z, bfhi(xr[bu].y) * w0[bu].w);
          xs.z = pk2(bflo(xr[bu].z) * w1[bu].x, bfhi(xr[bu].z) * w1[bu].y); xs.w = pk2(bflo(xr[bu].w) * w1[bu].z, bfhi(xr[bu].w) * w1[bu].w);
          const bf16x8 b = __builtin_bit_cast(bf16x8, xs);
#pragma unroll
          for (int nb = 0; nb < 4; ++nb) hacc[nb] = mfma32(ba[bu][nb], b, hacc[nb]); }
#undef LD_S
    }
    SCHED_BAR();
    const unsigned pt3_ = PT_NOW(); PT_ADD(13, pt2_, pt3_);
    if (!ck.store_y) return;
    const LAS unsigned char* zu_l = L + S_ZU + l31 * ZU_P + (64 * h + 32 * j + 4 * hh) * 2;
    const LAS unsigned char* xt_l = L + S_XT + (64 * h + 32 * j + 4 * hh) * XT_P + l31 * 2;
    LAS float* ssq_l = (LAS float*)(L + S_SSQ) + l31;
    float ssq[2] = {0.f, 0.f};
#pragma unroll
    for (int tb = 0; tb < 2; ++tb) {
        v2u zw[4]; bf16 xv[16];
#pragma unroll
        for (int q4 = 0; q4 < 4; ++q4) { zw[q4] = *(const LAS v2u*)(zu_l + 32 * tb * ZU_P + 16 * q4);
#pragma unroll
            for (int e = 0; e < 4; ++e) xv[4 * q4 + e] = *(const LAS bf16*)(xt_l + (8 * q4 + e) * XT_P + 64 * tb); }
        SCHED_BAR();
#pragma unroll
        for (int q4 = 0; q4 < 4; ++q4) {
#pragma unroll
            for (int e = 0; e < 4; ++e) { const int r = 4 * q4 + e; const float x = bf2f(xv[r]);
                const unsigned zz = e < 2 ? zw[q4].x : zw[q4].y; const float z = (e & 1) ? bfhi(zz) : bflo(zz);
                const float u = (yacc[tb][r] + Dh * x) * siluf_(z); yacc[tb][r] = u; ssq[tb] += u * u; } }
        const float sq = ssq[tb] + __shfl_xor(ssq[tb], 32);
        if (hh == 0) ssq_l[64 * w + 32 * tb] = sq;
        SCHED_BAR(); }
    BAR_LDS();
    const LAS float* gn_l = (const LAS float*)(F.lds + S_GN) + 64 * h + 32 * j + 4 * hh;
#pragma unroll
    for (int tb = 0; tb < 2; ++tb) { float tot = 0.f;
#pragma unroll
        for (int ww = 0; ww < 8; ++ww) tot += ssq_l[64 * ww + 32 * tb];
        const float rstd = RSQ(tot * (1.f / 256.f) + EPS);
#pragma unroll
        for (int q4 = 0; q4 < 4; ++q4) { const f32x4 gn = *(const LAS f32x4*)(gn_l + 8 * q4);
            v2u o; o.x = pk2(yacc[tb][4 * q4] * rstd * gn.x, yacc[tb][4 * q4 + 1] * rstd * gn.y); o.y = pk2(yacc[tb][4 * q4 + 2] * rstd * gn.z, yacc[tb][4 * q4 + 3] * rstd * gn.w);
            *(LAS v2u*)((LAS unsigned char*)zu_l + 32 * tb * ZU_P + 16 * q4) = o; } }
    BAR_LDS();
    { const int t = tid >> 3, seg = tid & 7;
      if (t >= ck.t0 && t < ck.t1) {
#pragma unroll
          for (int i = 0; i < 4; ++i) *(v4u*)(F.U() + (int)(ck.row0 + t) * DIN + 256 * g + 32 * seg + 8 * i) = *(const LAS v4u*)(L + S_ZU + t * ZU_P + seg * 64 + 16 * i); } }
    { const unsigned pt4_ = PT_NOW(); PT_ADD(14, pt3_, pt4_); }
}
DEV void ssd_unit(Frame& F, int kind, int sb, int g) {
    const int w = F.wave, h = w >> 1, j = w & 1, head = 4 * g + h;
    f32x16 hacc[4];
    if (kind == 0) {
#pragma unroll
        for (int nb = 0; nb < 4; ++nb)
#pragma unroll
            for (int r = 0; r < 16; ++r) hacc[nb][r] = 0.f;
    } else {
        const int lane = opaque_v(F.lane()), l31 = lane & 31, hh = lane >> 5;
        const float* src = F.in[I_SSM] + (((int)sb * NSH + head) * 64 + 32 * j + l31) * DST;
#pragma unroll
        for (int nb = 0; nb < 4; ++nb)
#pragma unroll
            for (int q4 = 0; q4 < 4; ++q4) { const f32x4 v = *(const f32x4*)(src + 32 * nb + 8 * q4 + 4 * hh); hacc[nb][4 * q4] = v.x; hacc[nb][4 * q4 + 1] = v.y; hacc[nb][4 * q4 + 2] = v.z; hacc[nb][4 * q4 + 3] = v.w; }
    }
    v4u raw[11], zr[4]; float dtv;
    const int lane0 = opaque_v(F.lane()), tid0 = opaque_v(F.tid());
    const float a_coef = rdfl_f(-EXP2(F.in[I_ALOG][4 * g + (w & 3)] * LOG2E)), Dh = rdfl_f(F.in[I_DSKIP][4 * g + h]);
    { LAS float* CW = (LAS float*)(F.lds + S_CW);
      for (int idx = tid0; idx < 5 * 512; idx += NWAVES * 64) { const int i = idx >> 9, e = (idx >> 6) & 7, cg = idx & 63;
          const int col = cg < 32 ? 256 * g + 8 * cg : (cg < 48 ? 2048 + 128 * g + 8 * (cg - 32) : 3072 + 128 * g + 8 * (cg - 48));
          CW[idx] = i < 4 ? F.in[I_CONVW][i * CONVD + col + e] : F.in[I_CONVB][col + e]; }
      if (tid0 < 256) ((LAS float*)(F.lds + S_GN))[tid0] = F.in[I_SSDN][256 * g + tid0]; }
    if (kind == 0) {
        SsdChunk ck, ckn; ck.row0 = MMAIN - 48; ck.t0 = 48; ck.t1 = 64; ck.halo = 0; ck.store_y = false;
        ssd_prefetch(F, ck, sb, g, lane0, tid0, w, raw, zr, dtv);
        for (int c = -1; c < SEQ / 64; ++c) {
            ckn.row0 = sb * SEQ + 64 * (c + 1); ckn.t0 = 0; ckn.t1 = 64; ckn.halo = c + 1 == 0 ? 2 : 1; ckn.store_y = true;
            ssd_chunk(F, ck, c + 1 < SEQ / 64, ckn, sb, g, hacc, raw, zr, dtv, a_coef, Dh);
            ck = ckn;
        }
    } else {
        SsdChunk ck; ck.row0 = MP + DSEQ * sb; ck.t0 = 0; ck.t1 = DSEQ; ck.halo = 3; ck.store_y = true;
        ssd_prefetch(F, ck, sb, g, lane0, tid0, w, raw, zr, dtv);
        ssd_chunk(F, ck, false, ck, sb, g, hacc, raw, zr, dtv, a_coef, Dh);
    }
    const int lane = opaque_v(F.lane()), l31 = lane & 31, hh = lane >> 5;
    float* dst = F.out + (kind == 0 ? OUT_SP : OUT_SS) + (((int)sb * NSH + head) * 64 + 32 * j + l31) * DST;
#pragma unroll
    for (int nb = 0; nb < 4; ++nb)
#pragma unroll
        for (int q4 = 0; q4 < 4; ++q4) { f32x4 v; v.x = hacc[nb][4 * q4]; v.y = hacc[nb][4 * q4 + 1]; v.z = hacc[nb][4 * q4 + 2]; v.w = hacc[nb][4 * q4 + 3]; *(f32x4*)(dst + 32 * nb + 8 * q4 + 4 * hh) = v; }
}
constexpr int KT_P = 272, VN_P = 320, A_KBUF = 64 * KT_P, A_VBUF = 64 * VN_P, A_K0 = 0, A_V0 = 2 * A_KBUF, A_BIAS = A_V0 + 3 * A_VBUF, A_QF = A_BIAS + 1280 + 64, A_END = A_QF + 32768;
constexpr float ATT_THR = 8.0f;
#ifndef ATT_STAGGER
#define ATT_STAGGER 1
#endif
#ifndef ATT_FUSE
#define ATT_FUSE 0
#endif
static_assert(A_END <= RING_BYTES && 4 * 128 * 32 * 4 <= A_BIAS, "attention LDS map");
struct AttTile { int kind; int row0; const float* ck; const float* cv; int nvalid, kpos0; int orow; int osample; };
struct AttRegs { v4u r0, r1, r2, r3, r4, r5, r6, r7; };
#ifdef EMU
DEV void swap32_(unsigned& a, unsigned& b) { const unsigned oa = __shfl_xor(a, 32), ob = __shfl_xor(b, 32); const bool up = (emu::me().tid.x & 63) >= 32; const unsigned na = up ? ob : a, nb = up ? b : oa; a = na; b = nb; }
#define SETPRIO(n) do {} while (0)
DEV float max3_(float a, float b, float c) { return fmaxf(fmaxf(a, b), c); }
DEV bool wave_any(bool p) { int v = p ? 1 : 0;
    for (int o = 1; o < 64; o <<= 1) v |= __shfl_xor(v, o);
    return v != 0; }
DEV s16x4 tr_read(const unsigned char* p) {
    const int w = emu::me().tid.x >> 6, l = emu::me().tid.x & 63; memcpy(emu::B->xch[w][l], p, 8); emu::wave_sync();
    s16x4 r; const int g0 = l & ~15, i = l & 15;
    for (int j = 0; j < 4; ++j) r[j] = ((const short*)emu::B->xch[w][g0 + 4 * j + (i >> 2)])[i & 3];
    emu::wave_sync(); return r; }
#else
DEV bool wave_any(bool p) { return __any(p); }
DEV void swap32_(unsigned& a, unsigned& b) { auto r = __builtin_amdgcn_permlane32_swap(a, b, false, false); a = r[0]; b = r[1]; }
#define SETPRIO(n) __builtin_amdgcn_s_setprio(n)
DEV float max3_(float a, float b, float c) { float r; asm("v_max3_f32 %0, %1, %2, %3" : "=v"(r) : "v"(a), "v"(b), "v"(c)); return r; }
#endif
#ifdef EMU
#define TR_RD(dst, base, OFF) dst = tr_read((base) + (OFF))
#define TR8_WAIT(a0, a1, a2, a3, b0, b1, b2, b3) do {} while (0)
#define TR4_WAIT(a0, a1, b0, b1) do {} while (0)
#else
#define TR_RD(dst, base, OFF) asm volatile("ds_read_b64_tr_b16 %0, %1 offset:%c2" : "=&v"(dst) : "v"((unsigned)(size_t)(base)), "i"(OFF) : "memory")
#define TR4_WAIT(a0, a1, b0, b1) asm volatile("s_waitcnt lgkmcnt(0)" : "+v"(a0), "+v"(a1), "+v"(b0), "+v"(b1) :: "memory")
#define TR8_WAIT(a0, a1, a2, a3, b0, b1, b2, b3) asm volatile("s_waitcnt lgkmcnt(0)" : "+v"(a0), "+v"(a1), "+v"(a2), "+v"(a3), "+v"(b0), "+v"(b1), "+v"(b2), "+v"(b3) :: "memory")
#endif

template <int ukind> DEV AttTile att_tile(const Frame& F, int sb, int hd, int i, int cp) {
    AttTile t; t.ck = nullptr; t.cv = nullptr; t.kind = 0; t.orow = -1; t.osample = 0;
    if (i == 0) { t.row0 = MMAIN; t.nvalid = NMETA; t.kpos0 = 0; if (ukind == 0 && cp == 0) t.orow = sb * LEXT; return t; }
    const int f = i - 1;
    if (ukind == 0) { t.row0 = sb * SEQ + 64 * f; t.nvalid = 64; t.kpos0 = NMETA + 64 * f; if ((f >> 1) == cp) t.orow = sb * LEXT + NMETA + 64 * f; return t; }
    if (f < PAST / 64) { t.kind = 1; t.row0 = 0; t.ck = F.in[I_CK] + ((size_t)sb * PAST + 64 * f) * 1024 + 128 * hd; t.cv = F.in[I_CV] + ((size_t)sb * PAST + 64 * f) * 1024 + 128 * hd; t.nvalid = 64; t.kpos0 = NMETA + 64 * f; return t; }
    t.row0 = MP + DSEQ * sb; t.nvalid = DSEQ; t.kpos0 = NMETA + PAST; t.orow = DSEQ * sb; t.osample = 1; return t;
}
template <int ukind> DEV void att_load(const Frame& F, const AttTile& t, int hd, AttRegs& R, int tid) {
    tid = opaque_v(tid);
    const int kv = tid >> 3, seg = tid & 7; const v4u zero = {0u, 0u, 0u, 0u}; const bool ok = kv < t.nvalid;
    R.r0 = zero; R.r1 = zero; R.r2 = zero; R.r3 = zero; if (ukind == 1) { R.r4 = zero; R.r5 = zero; R.r6 = zero; R.r7 = zero; }
    if (ukind == 0 || t.kind == 0) {
        const int off = (t.row0 + kv) * D + 128 * hd + 16 * seg; const bf16* kp = F.K() + off; const bf16* vp = F.V() + off;
        if (ok) { R.r0 = *(const v4u*)(kp); R.r1 = *(const v4u*)(kp + 8); R.r2 = *(const v4u*)(vp); R.r3 = *(const v4u*)(vp + 8); }
    } else {
        const float* kp = t.ck + kv * 1024 + 16 * seg; const float* vp = t.cv + kv * 1024 + 16 * seg;
        if (ok) { R.r0 = *(const v4u*)(kp); R.r1 = *(const v4u*)(kp + 4); R.r2 = *(const v4u*)(kp + 8); R.r3 = *(const v4u*)(kp + 12);
                  R.r4 = *(const v4u*)(vp); R.r5 = *(const v4u*)(vp + 4); R.r6 = *(const v4u*)(vp + 8); R.r7 = *(const v4u*)(vp + 12); }
    }
}
DEV void att_load_fast(const Frame& F, const AttTile& t, int hd, AttRegs& R, int tid) {
    tid = opaque_v(tid);
    const int kv = tid >> 3, seg = tid & 7, off = (t.row0 + kv) * D + 128 * hd + 16 * seg; const bf16* kp = F.K() + off; const bf16* vp = F.V() + off;
    R.r0 = *(const v4u*)kp; R.r1 = *(const v4u*)(kp + 8); R.r2 = *(const v4u*)vp; R.r3 = *(const v4u*)(vp + 8);
}
DEV void att_load_cache(const AttTile& t, AttRegs& R, int tid) {
    tid = opaque_v(tid);
    const int kv = tid >> 3, seg = tid & 7; const float* kp = t.ck + kv * 1024 + 16 * seg; const float* vp = t.cv + kv * 1024 + 16 * seg;
    R.r0 = *(const v4u*)(kp); R.r1 = *(const v4u*)(kp + 4); R.r2 = *(const v4u*)(kp + 8); R.r3 = *(const v4u*)(kp + 12);
    R.r4 = *(const v4u*)(vp); R.r5 = *(const v4u*)(vp + 4); R.r6 = *(const v4u*)(vp + 8); R.r7 = *(const v4u*)(vp + 12);
}
DEV v4u pack8_(const v4u a, const v4u b) { v4u o; o.x = pk2(uaf(a.x), uaf(a.y)); o.y = pk2(uaf(a.z), uaf(a.w)); o.z = pk2(uaf(b.x), uaf(b.y)); o.w = pk2(uaf(b.z), uaf(b.w)); return o; }
template <int ukind, bool OUTS = true> DEV void att_store(const Frame& F, int hd, const AttTile& t, AttRegs& R, LAS unsigned char* kbuf, LAS unsigned char* vbuf, int tid) {
    tid = opaque_v(tid);
    const int kv = tid >> 3, seg = tid & 7;
    v4u bk[2], bv[2];
    if (ukind == 1 && t.kind == 1) { bk[0] = pack8_(R.r0, R.r1); bk[1] = pack8_(R.r2, R.r3); bv[0] = pack8_(R.r4, R.r5); bv[1] = pack8_(R.r6, R.r7); }
    else { bk[0] = R.r0; bk[1] = R.r1; bv[0] = R.r2; bv[1] = R.r3; }
#pragma unroll
    for (int i = 0; i < 2; ++i) { *(LAS v4u*)(kbuf + kv * KT_P + seg * 32 + 16 * i) = bk[i]; *(LAS v4u*)(vbuf + kv * VN_P + seg * 32 + 16 * i) = bv[i]; }
    if (OUTS && t.orow >= 0 && kv < t.nvalid) {
        const int off = (t.orow + kv) * 1024 + 128 * hd + 16 * seg;
        float* ko = F.out + (t.osample ? OUT_KS : OUT_KP) + off; float* vo = F.out + (t.osample ? OUT_VS : OUT_VP) + off;
#pragma unroll
        for (int i = 0; i < 2; ++i) {
            f32x4 a; a.x = bflo(bk[i].x); a.y = bfhi(bk[i].x); a.z = bflo(bk[i].y); a.w = bfhi(bk[i].y); *(f32x4*)(ko + 8 * i) = a;
            a.x = bflo(bk[i].z); a.y = bfhi(bk[i].z); a.z = bflo(bk[i].w); a.w = bfhi(bk[i].w); *(f32x4*)(ko + 8 * i + 4) = a;
            a.x = bflo(bv[i].x); a.y = bfhi(bv[i].x); a.z = bflo(bv[i].y); a.w = bfhi(bv[i].y); *(f32x4*)(vo + 8 * i) = a;
            a.x = bflo(bv[i].z); a.y = bfhi(bv[i].z); a.z = bflo(bv[i].w); a.w = bfhi(bv[i].w); *(f32x4*)(vo + 8 * i + 4) = a; }
    }
}
constexpr int A_LAM_OFF = LDSCTL_OFF + 1024 + 5 * 512 * 4 + 1024;
static_assert(A_LAM_OFF + 129 * 4 <= LDS_BYTES, "lambda words");
DEV void att_lambda_setup(Frame& F) {
    LAS float* T = (LAS float*)(F.lds + A_LAM_OFF); const int tid = F.tid();
    if (tid < 64) { T[tid] = F.in[I_LQ1][tid] * F.in[I_LK1][tid]; T[64 + tid] = F.in[I_LQ2][tid] * F.in[I_LK2][tid]; }
    __syncthreads();
    if (tid == 0) { float sa = 0.f, sb2 = 0.f;
        for (int k = 0; k < 64; ++k) { sa += T[k]; sb2 += T[64 + k]; }
        T[128] = EXP2(sa * LOG2E) - EXP2(sb2 * LOG2E) + 0.2f; }
    __syncthreads();
}
DEV void att_head_setup(Frame& F, int hd) {
    LAS unsigned char* L = F.lds + RING_OFF; const int tid = opaque_v(F.tid()), lane = tid & 63;
    BAR_LDS();
    if (tid < 320) { const int rel = tid - 255, n = rel < 0 ? -rel : rel; int bk;
        if (n < 8) bk = n; else { bk = 8 + (int)(2.0f * LOG2((float)n * 0.125f) + 1e-4f); bk = bk > 15 ? 15 : bk; }
        if (rel > 0) bk += 16;
        ((LAS float*)(L + A_BIAS))[tid] = (F.in[I_RELB][bk * NAH + hd] - F.in[I_RELB][15 * NAH + hd]) * LOG2E; }
    if (tid == 448) ((LAS float*)(L + A_BIAS))[320] = ((const LAS float*)(F.lds + A_LAM_OFF))[128];
    if (tid >= 320 && tid < 448) ((LAS float*)(L + A_QF))[tid - 320] = F.in[I_SUBLN][tid - 320];
}
template <int ukind> DEV void att_unit(Frame& F, int sb, int hd, int cp) {
    LAS unsigned char* L = F.lds + RING_OFF;
    const int lane = opaque_v(F.lane()), tid = opaque_v(F.tid()), w = F.wave, l31 = lane & 31, hh = lane >> 5, comp = w >> 2, qb = w & 3;
    const bool active = ukind == 0 || qb == 0;
    const int ntile = ukind == 0 ? 2 * cp + 3 : PAST / 64 + 2;
    const int myvis = ukind == 0 ? 2 * cp + 2 + (qb >> 1) : ntile;
    const int qrow = ukind == 0 ? sb * SEQ + 128 * cp + 32 * qb + l31 : MP + DSEQ * sb + l31;
    const int qpos0 = ukind == 0 ? NMETA + 128 * cp + 32 * qb : NMETA + PAST;
    BAR_LDS();
    bf16x8 qf[4];
    LAS unsigned char* qf_l = L + A_QF + (w * 256 + lane) * 16;
#pragma unroll
    for (int d0 = 0; d0 < 4; ++d0) { const v4u z = {0u, 0u, 0u, 0u}; const v4u qv_ = active ? *(const v4u*)(F.Q() + qrow * D + 128 * hd + 64 * comp + 16 * d0 + 8 * hh) : z;
        if (ukind == 0 && ATT_FUSE) *(LAS v4u*)(qf_l + 1024 * d0) = qv_; else qf[d0] = __builtin_bit_cast(bf16x8, qv_); }
    f32x16 o[4];
#pragma unroll
    for (int r = 0; r < 16; ++r) {
#pragma unroll
        for (int dt = 0; dt < 4; ++dt) o[dt][r] = 0.f; }
    float mref = 0.f, lsum = 0.f;
    if (w >= 4) SETPRIO(1);
    AttRegs R, RB; AttTile tcur = att_tile<ukind>(F, sb, hd, 0, cp), tnext = tcur;
    if (ukind == 0 && !ATT_FUSE) {
        AttRegs RM; att_load<ukind>(F, tcur, hd, RM, tid);
        { const AttTile t1 = att_tile<ukind>(F, sb, hd, 1, cp); att_load_fast(F, t1, hd, RB, tid); }
        { const AttTile t2 = att_tile<ukind>(F, sb, hd, 2, cp); att_load_fast(F, t2, hd, R, tid); }
        SCHED_BAR();
        att_store<ukind>(F, hd, tcur, RM, L + A_K0, L + A_V0, tid);
    } else { att_load<ukind>(F, tcur, hd, R, tid); att_store<ukind>(F, hd, tcur, R, L + A_K0, L + A_V0, tid); }
    BAR_LDS();
#define ATT_SCORE(i) do { \
        f32x16 p0, p1; { const float nm = -mref; _Pragma("unroll") for (int r = 0; r < 16; ++r) { p0[r] = nm; p1[r] = nm; } } \
        const LAS unsigned char* kb = L + A_K0 + ((i) & 1) * A_KBUF + l31 * KT_P + (64 * comp + 8 * hh) * 2; \
        bf16x8 ka[4], kc[4];                     \
        _Pragma("unroll") for (int d0 = 0; d0 < 4; ++d0) { ka[d0] = rd16(kb + d0 * 32); kc[d0] = rd16(kb + 32 * KT_P + d0 * 32); } \
        SCHED_BAR(); \
        _Pragma("unroll") for (int d0 = 0; d0 < 4; ++d0) { p0 = mfma32(ka[d0], qf[d0], p0); p1 = mfma32(kc[d0], qf[d0], p1); } \
        SCHED_BAR(); \
        const int kmax = tcur.kpos0 + tcur.nvalid - 1; \
        if (kmax - qpos0 > -128) {             \
            const LAS float* tab_l = (const LAS float*)(L + A_BIAS) + (tcur.kpos0 - (qpos0 + l31) + 255 + 4 * hh); \
            _Pragma("unroll") for (int r = 0; r < 16; ++r) { p0[r] += tab_l[(r & 3) + 8 * (r >> 2)]; p1[r] += tab_l[(r & 3) + 8 * (r >> 2) + 32]; } } \
        if (tcur.nvalid < 64) { \
            _Pragma("unroll") for (int r = 0; r < 16; ++r) { if (crow(r, hh) >= tcur.nvalid) p0[r] = -INFINITY; if (crow(r, hh) + 32 >= tcur.nvalid) p1[r] = -INFINITY; } } \
        float mx = max3_(p0[0], p1[0], p0[1]), mx2 = max3_(p1[1], p0[2], p1[2]); \
        _Pragma("unroll") for (int r = 3; r < 15; r += 2) { mx = max3_(mx, p0[r], p1[r]); mx2 = max3_(mx2, p0[r + 1], p1[r + 1]); } \
        mx = max3_(mx, mx2, max3_(p0[15], p1[15], p0[15])); \
        mx = fmaxf(mx, __shfl_xor(mx, 32)); \
        if ((i) == 0 || wave_any(mx > ATT_THR)) {        \
            const float dl = (i) == 0 ? mx : fmaxf(mx, 0.f), f = EXP2(-dl); mref += dl; lsum *= f; \
            _Pragma("unroll") for (int r = 0; r < 16; ++r) { p0[r] -= dl; p1[r] -= dl; \
                _Pragma("unroll") for (int dt = 0; dt < 4; ++dt) o[dt][r] *= f; } } \
        float ps = 0.f; \
        _Pragma("unroll") for (int r = 0; r < 16; ++r) { p0[r] = EXP2(p0[r]); p1[r] = EXP2(p1[r]); ps += p0[r] + p1[r]; } \
        lsum += ps; \
        pa[0] = pack_step(p0, 0); pa[1] = pack_step(p0, 1); pa[2] = pack_step(p1, 0); pa[3] = pack_step(p1, 1); \
        SCHED_BAR(); } while (0)
#define ATT_PV(j) do { \
        const LAS unsigned char* vt = L + A_V0 + ((j) % 3) * A_VBUF + (4 * hh + ((lane & 15) >> 2)) * VN_P + (16 * ((lane >> 4) & 1) + 4 * (lane & 3)) * 2;     \
        s16x4 lo[2][4], hi[2][4];                \
        _Pragma("unroll") for (int dt = 0; dt < 4; ++dt) { TR_RD(lo[0][dt], vt, 64 * dt); TR_RD(hi[0][dt], vt, 8 * VN_P + 64 * dt); } \
        _Pragma("unroll") for (int ks = 0; ks < 4; ++ks) { \
            TR8_WAIT(lo[ks & 1][0], lo[ks & 1][1], lo[ks & 1][2], lo[ks & 1][3], hi[ks & 1][0], hi[ks & 1][1], hi[ks & 1][2], hi[ks & 1][3]); \
            if (ks < 3) { _Pragma("unroll") for (int dt = 0; dt < 4; ++dt) { TR_RD(lo[(ks + 1) & 1][dt], vt, (16 * (ks + 1)) * VN_P + 64 * dt); TR_RD(hi[(ks + 1) & 1][dt], vt, (16 * (ks + 1) + 8) * VN_P + 64 * dt); } } \
            _Pragma("unroll") for (int dt = 0; dt < 4; ++dt) { const s16x4 l_ = lo[ks & 1][dt], h_ = hi[ks & 1][dt]; \
                const bf16x8 a = {l_[0], l_[1], l_[2], l_[3], h_[0], h_[1], h_[2], h_[3]}; o[dt] = mfma32(a, pa[ks], o[dt]); } \
            SCHED_BAR(); } } while (0)
#define ATT_HEAD(i) if ((i) + 1 < ntile) { tnext = att_tile<ukind>(F, sb, hd, (i) + 1, cp); att_load<ukind>(F, tnext, hd, R, tid); }
#define ATT_TAIL(i) do { if ((i) + 1 < ntile) att_store<ukind>(F, hd, tnext, R, L + A_K0 + (((i) + 1) & 1) * A_KBUF, L + A_V0 + (((i) + 1) % 3) * A_VBUF, tid); tcur = tnext; BAR_LDS(); } while (0)
#define ATT_TAIL2_MAIN(i, RS) do { { const AttTile tn_ = att_tile<ukind>(F, sb, hd, (i) + 1, cp); att_store<ukind, false>(F, hd, tn_, RS, L + A_K0 + (((i) + 1) & 1) * A_KBUF, L + A_V0 + (((i) + 1) % 3) * A_VBUF, tid); } \
        const unsigned pq0_ = PT_NOW(); \
        { const AttTile tf_ = att_tile<ukind>(F, sb, hd, (i) + 3, cp); att_load_fast(F, tf_, hd, RS, tid); } \
        const unsigned pq1_ = PT_NOW(); \
        BAR_LDS(); const unsigned pq2_ = PT_NOW(); PT_ADD(4, pq0_, pq1_); PT_ADD(5, pq1_, pq2_); } while (0)
#define ATT_TAIL2_LAST(i, RS) do { if ((i) + 1 < ntile) { const AttTile tn_ = att_tile<ukind>(F, sb, hd, (i) + 1, cp); att_store<ukind, true>(F, hd, tn_, RS, L + A_K0 + (((i) + 1) & 1) * A_KBUF, L + A_V0 + (((i) + 1) % 3) * A_VBUF, tid); } \
        BAR_LDS(); } while (0)
#define ATT_PVLOOP(j, WITH_EXP) do { \
        const LAS unsigned char* vt = L + A_V0 + ((j) % 3) * A_VBUF + (4 * hh + ((lane & 15) >> 2)) * VN_P + (16 * ((lane >> 4) & 1) + 4 * (lane & 3)) * 2; \
        s16x4 lo[2][2], hi[2][2];                  \
        _Pragma("unroll") for (int k2 = 0; k2 < 2; ++k2) { TR_RD(lo[0][k2], vt, (16 * k2) * VN_P); TR_RD(hi[0][k2], vt, (16 * k2 + 8) * VN_P); } \
        _Pragma("unroll") for (int hs = 0; hs < 8; ++hs) { const int dt = hs >> 1, kb2 = 2 * (hs & 1), bu = hs & 1; \
            TR4_WAIT(lo[bu][0], lo[bu][1], hi[bu][0], hi[bu][1]); \
            if (hs < 7) { const int dn = (hs + 1) >> 1, kn = 2 * ((hs + 1) & 1); \
                _Pragma("unroll") for (int k2 = 0; k2 < 2; ++k2) { TR_RD(lo[bu ^ 1][k2], vt, (16 * (kn + k2)) * VN_P + 64 * dn); TR_RD(hi[bu ^ 1][k2], vt, (16 * (kn + k2) + 8) * VN_P + 64 * dn); } } \
            _Pragma("unroll") for (int k2 = 0; k2 < 2; ++k2) { const s16x4 l_ = lo[bu][k2], h_ = hi[bu][k2]; \
                const bf16x8 a = {l_[0], l_[1], l_[2], l_[3], h_[0], h_[1], h_[2], h_[3]}; o[dt] = mfma32(a, pa[kb2 + k2], o[dt]); \
                if (WITH_EXP) { p0[2 * hs + k2] = EXP2(p0[2 * hs + k2]); p1[2 * hs + k2] = EXP2(p1[2 * hs + k2]); } \
                SCHED_BAR(); } } } while (0)
#define ATT_FUSED(i) do { \
        const bool doS_ = (i) < myvis, doPV_ = (i) >= 1 && (i) - 1 < myvis; \
        f32x16 p0, p1; float fsc_ = 1.f; bool resc_ = false; \
        if (doS_) { \
            { const float nm = -mref; _Pragma("unroll") for (int r = 0; r < 16; ++r) { p0[r] = nm; p1[r] = nm; } } \
            const LAS unsigned char* kb = L + A_K0 + ((i) & 1) * A_KBUF + l31 * KT_P + (64 * comp + 8 * hh) * 2; \
            { bf16x8 ka[4]; \
              _Pragma("unroll") for (int d0 = 0; d0 < 4; ++d0) ka[d0] = rd16(kb + d0 * 32); \
              bf16x8 qv[4]; _Pragma("unroll") for (int d0 = 0; d0 < 4; ++d0) qv[d0] = rd16(qf_l + 1024 * d0); \
              SCHED_BAR(); \
              _Pragma("unroll") for (int d0 = 0; d0 < 4; ++d0) p0 = mfma32(ka[d0], qv[d0], p0); \
              _Pragma("unroll") for (int d0 = 0; d0 < 4; ++d0) ka[d0] = rd16(kb + 32 * KT_P + d0 * 32); \
              SCHED_BAR(); \
              _Pragma("unroll") for (int d0 = 0; d0 < 4; ++d0) p1 = mfma32(ka[d0], qv[d0], p1); } \
            SCHED_BAR(); \
            const int kmax = tcur.kpos0 + tcur.nvalid - 1; \
            if (kmax - qpos0 > -128) { \
                const LAS float* tab_l = (const LAS float*)(L + A_BIAS) + (tcur.kpos0 - (qpos0 + l31) + 255 + 4 * hh); \
                _Pragma("unroll") for (int r = 0; r < 16; ++r) { p0[r] += tab_l[(r & 3) + 8 * (r >> 2)]; p1[r] += tab_l[(r & 3) + 8 * (r >> 2) + 32]; } } \
            if (tcur.nvalid < 64) { \
                _Pragma("unroll") for (int r = 0; r < 16; ++r) { if (crow(r, hh) >= tcur.nvalid) p0[r] = -INFINITY; if (crow(r, hh) + 32 >= tcur.nvalid) p1[r] = -INFINITY; } } \
            float mx = max3_(p0[0], p1[0], p0[1]), mx2 = max3_(p1[1], p0[2], p1[2]); \
            _Pragma("unroll") for (int r = 3; r < 15; r += 2) { mx = max3_(mx, p0[r], p1[r]); mx2 = max3_(mx2, p0[r + 1], p1[r + 1]); } \
            mx = max3_(mx, mx2, max3_(p0[15], p1[15], p0[15])); \
            mx = fmaxf(mx, __shfl_xor(mx, 32)); \
            if ((i) == 0 || wave_any(mx > ATT_THR)) { \
                const float dl = (i) == 0 ? mx : fmaxf(mx, 0.f); fsc_ = EXP2(-dl); mref += dl; resc_ = true; \
                _Pragma("unroll") for (int r = 0; r < 16; ++r) { p0[r] -= dl; p1[r] -= dl; } } \
            SCHED_BAR(); } \
        if (doPV_) { if (doS_) ATT_PVLOOP((i) - 1, true); else ATT_PVLOOP((i) - 1, false); } \
        else if (doS_) { _Pragma("unroll") for (int r = 0; r < 16; ++r) { p0[r] = EXP2(p0[r]); p1[r] = EXP2(p1[r]); } } \
        if (doS_) { \
            if (resc_) { lsum *= fsc_; _Pragma("unroll") for (int r = 0; r < 16; ++r) { _Pragma("unroll") for (int dt = 0; dt < 4; ++dt) o[dt][r] *= fsc_; } } \
            float ps = 0.f; \
            _Pragma("unroll") for (int r = 0; r < 16; ++r) ps += p0[r] + p1[r]; \
            lsum += ps; \
            pa[0] = pack_step(p0, 0); pa[1] = pack_step(p0, 1); pa[2] = pack_step(p1, 0); pa[3] = pack_step(p1, 1); } \
        SCHED_BAR(); } while (0)
    if (ukind == 1) {
        constexpr int NC = PAST / 64; static_assert(NC % 2 == 0 && NC >= 2, "cache tiles");
#define ATT_ITS(i) do { tcur = att_tile<ukind>(F, sb, hd, (i), cp); if (active) { bf16x8 pa[4]; ATT_SCORE(i); ATT_PV(i); } } while (0)
#define ATT_TAILS(i, RS, LOADNEXT) do { { const AttTile tn_ = att_tile<ukind>(F, sb, hd, (i) + 1, cp); att_store<ukind, true>(F, hd, tn_, RS, L + A_K0 + (((i) + 1) & 1) * A_KBUF, L + A_V0 + (((i) + 1) % 3) * A_VBUF, tid); } \
        if (LOADNEXT) { const AttTile tf_ = att_tile<ukind>(F, sb, hd, (i) + 3, cp); att_load_cache(tf_, RS, tid); } \
        BAR_LDS(); } while (0)
        { const AttTile t1 = att_tile<ukind>(F, sb, hd, 1, cp); att_load_cache(t1, RB, tid); }
        { const AttTile t2 = att_tile<ukind>(F, sb, hd, 2, cp); att_load_cache(t2, R, tid); }
        BAR_LDS();
        int i = 0;
        for (; i + 3 <= NC; i += 2) { ATT_ITS(i); ATT_TAILS(i, RB, true); ATT_ITS(i + 1); ATT_TAILS(i + 1, R, true); }
        ATT_ITS(i); { const AttTile tn_ = att_tile<ukind>(F, sb, hd, i + 1, cp); att_store<ukind, true>(F, hd, tn_, RB, L + A_K0 + ((i + 1) & 1) * A_KBUF, L + A_V0 + ((i + 1) % 3) * A_VBUF, tid); }
        { const AttTile tf_ = att_tile<ukind>(F, sb, hd, NC + 1, cp); att_load<ukind>(F, tf_, hd, RB, tid); } BAR_LDS();
        ATT_ITS(i + 1); ATT_TAILS(i + 1, R, false);
        ATT_ITS(i + 2); ATT_TAILS(i + 2, RB, false);
        ATT_ITS(i + 3); BAR_LDS();
#undef ATT_ITS
#undef ATT_TAILS
    } else if (ATT_FUSE) {
        bf16x8 pa[4];
#pragma unroll
        for (int ks = 0; ks < 4; ++ks) pa[ks] = (bf16x8){0, 0, 0, 0, 0, 0, 0, 0};
        for (int i = 0; i <= ntile; ++i) { ATT_HEAD(i); ATT_FUSED(i); ATT_TAIL(i); }
    } else if (ATT_STAGGER == 0 || comp == 0) {
#define ATT_IT0(i, RS, TAILM) do { tcur = att_tile<ukind>(F, sb, hd, (i), cp); if ((i) < myvis) { bf16x8 pa[4]; ATT_SCORE(i); ATT_PV(i); } TAILM(i, RS); } while (0)
        int i = 0;
        for (; i + 3 < ntile; i += 2) { ATT_IT0(i, RB, ATT_TAIL2_MAIN); ATT_IT0(i + 1, R, ATT_TAIL2_MAIN); }
        ATT_IT0(i, RB, ATT_TAIL2_LAST); ATT_IT0(i + 1, R, ATT_TAIL2_LAST); ATT_IT0(i + 2, RB, ATT_TAIL2_LAST);
        if (ATT_STAGGER) BAR_LDS();
#undef ATT_IT0
    } else {
        bf16x8 pa[4];
#pragma unroll
        for (int ks = 0; ks < 4; ++ks) pa[ks] = (bf16x8){0, 0, 0, 0, 0, 0, 0, 0};
#define ATT_IT1(i, RS, TAILM) do { tcur = att_tile<ukind>(F, sb, hd, (i) < ntile ? (i) : 0, cp); if ((i) >= 1 && (i) - 1 < myvis) ATT_PV((i) - 1); if ((i) < myvis) ATT_SCORE(i); TAILM(i, RS); } while (0)
        int i = 0;
        for (; i + 3 < ntile; i += 2) { ATT_IT1(i, RB, ATT_TAIL2_MAIN); ATT_IT1(i + 1, R, ATT_TAIL2_MAIN); }
        ATT_IT1(i, RB, ATT_TAIL2_LAST); ATT_IT1(i + 1, R, ATT_TAIL2_LAST); ATT_IT1(i + 2, RB, ATT_TAIL2_LAST); ATT_IT1(i + 3, R, ATT_TAIL2_LAST);
#undef ATT_IT1
    }
#undef ATT_HEAD
#undef ATT_TAIL
#undef ATT_TAIL2_MAIN
#undef ATT_TAIL2_LAST
#undef ATT_SCORE
#undef ATT_PV
#undef ATT_FUSED
#undef ATT_PVLOOP
    SETPRIO(0);
    const int lane_e = opaque_v(F.lane()), l31x = lane_e & 31, hhx = lane_e >> 5;
    if (active) { const float l = lsum + __shfl_xor(lsum, 32), inv = RCP(l);
#pragma unroll
        for (int dt = 0; dt < 4; ++dt)
#pragma unroll
            for (int r = 0; r < 16; ++r) o[dt][r] *= inv; }
    LAS float* xo_l = (LAS float*)L + (qb * 128 + 4 * hhx) * 32 + l31x;
    if (active && comp == 1) {
#pragma unroll
        for (int dt = 0; dt < 4; ++dt)
#pragma unroll
            for (int r = 0; r < 16; ++r) xo_l[(32 * dt + (r & 3) + 8 * (r >> 2)) * 32] = o[dt][r]; }
    BAR_LDS();
    if (active && comp == 0) { float ss = 0.f;
        const float lam = ((const LAS float*)(L + A_BIAS))[320];
#pragma unroll
        for (int dt = 0; dt < 4; ++dt)
#pragma unroll
            for (int r = 0; r < 16; ++r) { const float v = o[dt][r] - lam * xo_l[(32 * dt + (r & 3) + 8 * (r >> 2)) * 32]; o[dt][r] = v; ss += v * v; }
        ss += __shfl_xor(ss, 32);
        const float rstd = RSQ(ss * (1.f / 128.f) + EPS) * 0.8f;
        const int l31e = l31x;
        const int qrow_e = ukind == 0 ? sb * SEQ + 128 * cp + 32 * qb + l31e : MP + DSEQ * sb + l31e;
        bf16* orow = F.O() + qrow_e * D + 128 * hd;
#pragma unroll
        for (int kp = 0; kp < 8; ++kp) { v2u ov[2];
#pragma unroll
            for (int u = 0; u < 2; ++u) { const int k = 2 * kp + u, dt = k >> 2, q4 = k & 3, d0 = 32 * dt + 8 * q4 + 4 * hhx; const f32x4 gn = *(const LAS f32x4*)((const LAS float*)(L + A_QF) + d0);
                ov[u].x = pk2(o[dt][4 * q4] * rstd * gn.x, o[dt][4 * q4 + 1] * rstd * gn.y); ov[u].y = pk2(o[dt][4 * q4 + 2] * rstd * gn.z, o[dt][4 * q4 + 3] * rstd * gn.w); }
            unsigned ax = ov[0].x, ay = ov[0].y, bx = ov[1].x, by = ov[1].y;
            swap32_(ax, bx); swap32_(ay, by);
            v4u wv; wv.x = ax; wv.y = ay; wv.z = bx; wv.w = by;
            *(v4u*)(orow + 16 * kp + 8 * hhx) = wv; } }
}

DEV f32x4 bf4_(v2u w) { f32x4 r; r.x = bflo(w.x); r.y = bfhi(w.x); r.z = bflo(w.y); r.w = bfhi(w.y); return r; }
struct RowRegs { v2u t[4], u[4]; f32x4 b[4]; };
DEV void row_load(const Frame& F, int second, int m, int lane, RowRegs& R) {
    const v2u* tr = (const v2u*)(F.T1() + (size_t)m * D) + lane; const v2u* ur = (const v2u*)(F.T2() + (size_t)m * D) + lane; const f32x4* br = (const f32x4*)x_row_ptr(F, m) + lane;
#pragma unroll
    for (int jj = 0; jj < 4; ++jj) { R.t[jj] = tr[64 * jj]; R.b[jj] = br[64 * jj]; if (second) R.u[jj] = ur[64 * jj]; }
}
DEV void row_proc(Frame& F, int second, int m, int lane, RowRegs& R) {
    const LAS f32x4* g1 = (const LAS f32x4*)(F.lds + RING_OFF) + lane;
    f32x4 tf[4]; float s = 0.f;
#pragma unroll
    for (int jj = 0; jj < 4; ++jj) { tf[jj] = bf4_(R.t[jj]); s += (tf[jj].x * tf[jj].x + tf[jj].y * tf[jj].y) + (tf[jj].z * tf[jj].z + tf[jj].w * tf[jj].w); }
    const float r = RSQ(wave_sum(s) * (1.f / D) + EPS); float s2 = 0.f;
    f32x4 bv[4];
#pragma unroll
    for (int jj = 0; jj < 4; ++jj) { const f32x4 g = g1[64 * jj]; bv[jj] = R.b[jj] + tf[jj] * r * g; s2 += (bv[jj].x * bv[jj].x + bv[jj].y * bv[jj].y) + (bv[jj].z * bv[jj].z + bv[jj].w * bv[jj].w); }
    if (!second) {
        const float r2 = RSQ(wave_sum(s2) * (1.f / D) + EPS); const LAS f32x4* g2 = (const LAS f32x4*)(F.lds + RING_OFF) + D / 4 + lane;
        unsigned long long* o8 = (unsigned long long*)(F.XN() + (size_t)m * D) + lane;
#pragma unroll
        for (int jj = 0; jj < 4; ++jj) { const f32x4 g = g2[64 * jj]; o8[64 * jj] = (unsigned long long)pk2(bv[jj].x * r2 * g.x, bv[jj].y * r2 * g.y) | ((unsigned long long)pk2(bv[jj].z * r2 * g.z, bv[jj].w * r2 * g.w) << 32); }
    } else {
        f32x4 uf[4]; float s3 = 0.f;
#pragma unroll
        for (int jj = 0; jj < 4; ++jj) { uf[jj] = bf4_(R.u[jj]); s3 += (uf[jj].x * uf[jj].x + uf[jj].y * uf[jj].y) + (uf[jj].z * uf[jj].z + uf[jj].w * uf[jj].w); }
        const float r3 = RSQ(wave_sum(s3) * (1.f / D) + EPS); const LAS f32x4* g3 = (const LAS f32x4*)(F.lds + RING_OFF) + 2 * (D / 4) + lane;
        f32x4* orow = (f32x4*)(F.out + (size_t)m * D) + lane;
#pragma unroll
        for (int jj = 0; jj < 4; ++jj) orow[64 * jj] = bv[jj] + uf[jj] * r3 * g3[64 * jj];
    }
}
DEV void row_phase(Frame& F, int second) {
    const int gw = F.vcu * NWAVES + F.wave, NGW = F.G * NWAVES, lane = F.lane();
    { LAS float* GL = (LAS float*)(F.lds + RING_OFF); const int tid = F.tid();
      for (int k = tid; k < D; k += NWAVES * 64) { GL[k] = F.in[I_NPOST][k]; GL[D + k] = F.in[I_NFFN][k]; GL[2 * D + k] = F.in[I_NFFNP][k]; }
      __syncthreads(); }
    RowRegs A, B; int m = gw;
    if (m < MMAIN) row_load(F, second, m, lane, A);
    while (m < MMAIN) {
        const int m1 = m + NGW, m2 = m + 2 * NGW;
        row_load(F, second, m1 < MMAIN ? m1 : MMAIN - 1, lane, B); SCHED_BAR();
        row_proc(F, second, m, lane, A); SCHED_BAR();
        if (m1 >= MMAIN) break;
        row_load(F, second, m2 < MMAIN ? m2 : MMAIN - 1, lane, A); SCHED_BAR();
        row_proc(F, second, m1, lane, B); SCHED_BAR();
        m = m2;
    }
}
struct Args { const float* in[29]; float* out; unsigned char* ws; int ph_lo, ph_hi, li, pad; };
#ifndef EMU
#define RLX_AGENT __ATOMIC_RELAXED, __HIP_MEMORY_SCOPE_AGENT
#define XB_TMO      128
#define XB_XCNT(j)  (256  + 64 * (j))
#define XB_XSUB(j)  (1280 + 64 * (j))
#define XB_XGEN(j)  (2304 + 64 * (j))
#define XB_TOP      3328
#define XB_TOPGEN   3392
#define XCD_BAR_WORDS 3456
#define XB_SPIN_CAP (1u << 18)

__device__ __forceinline__ unsigned xb_ld(unsigned* p)              { return __hip_atomic_load(p, __ATOMIC_RELAXED, __HIP_MEMORY_SCOPE_AGENT); }
__device__ __forceinline__ unsigned xb_add(unsigned* p, unsigned v) { return __hip_atomic_fetch_add(p, v, __ATOMIC_RELAXED, __HIP_MEMORY_SCOPE_AGENT); }
__device__ __forceinline__ unsigned xb_xcc_id() { return (unsigned)__builtin_amdgcn_s_getreg((3 << 11) | 20) & 0xFu; }
#define XB_SPIN(cond, bar) do { unsigned _sp = 0; while (cond) { __builtin_amdgcn_s_sleep(1); \
    if ((++_sp & 255u) == 0u) { if (xb_ld(&(bar)[XB_TMO])) break; if (_sp > XB_SPIN_CAP) { atomicAdd(&(bar)[XB_TMO], 1u); break; } } } } while (0)

struct XcdBarrier {
    unsigned* bar; unsigned x;
    volatile LAS unsigned* st;
};

__device__ __forceinline__ XcdBarrier xcd_barrier_post(unsigned* bar, volatile LAS unsigned* st) {
    XcdBarrier b; b.bar = bar; b.x = xb_xcc_id(); b.st = st;
    if (threadIdx.x == 0) (void)xb_add(&bar[XB_XCNT(b.x)], 1u);
    return b;
}
__device__ __forceinline__ void xcd_barrier_complete(unsigned* bar, unsigned x, unsigned& nloc, unsigned& nx) {
    const unsigned G = gridDim.x * gridDim.y * gridDim.z;
    unsigned sum, cnt, mine, sp = 0u;
    for (;;) {
        sum = 0u; cnt = 0u; mine = 0u;
#pragma unroll
        for (unsigned j = 0; j < 16; ++j) { const unsigned c = xb_ld(&bar[XB_XCNT(j)]); sum += c; cnt += (c > 0u) ? 1u : 0u; mine = (j == x) ? c : mine; }
        if (sum == G) break;
        __builtin_amdgcn_s_sleep(1);
        if ((++sp & 255u) == 0u) { if (xb_ld(&bar[XB_TMO])) break; if (sp > XB_SPIN_CAP) { atomicAdd(&bar[XB_TMO], 1u); break; } }
    }
    nloc = mine > 0u ? mine : 1u; nx = cnt > 0u ? cnt : 1u;
}

__device__ __forceinline__ void xcd_barrier(const XcdBarrier& b) {
    asm volatile("s_waitcnt vmcnt(0)" ::: "memory");
    __syncthreads();
    if (threadIdx.x == 0) {
        unsigned* bar = b.bar;
        __builtin_amdgcn_s_waitcnt(0);
        unsigned nloc = b.st[0], nx = b.st[1];
        if (nloc == 0u) { xcd_barrier_complete(bar, b.x, nloc, nx); b.st[0] = nloc; b.st[1] = nx; }
        const unsigned old = xb_add(&bar[XB_XSUB(b.x)], 1u);
        const unsigned gen = old / nloc;
        if (old + 1u == (gen + 1u) * nloc) {
            __builtin_amdgcn_fence(__ATOMIC_RELEASE, "agent");
            asm volatile("s_waitcnt vmcnt(0)" ::: "memory");
            const unsigned og = xb_add(&bar[XB_TOP], 1u);
            const unsigned tg = og / nx;
            if (og + 1u == (tg + 1u) * nx) xb_add(&bar[XB_TOPGEN], 1u);
            else XB_SPIN(xb_ld(&bar[XB_TOPGEN]) == tg, bar);
            __builtin_amdgcn_fence(__ATOMIC_ACQUIRE, "agent");
            xb_add(&bar[XB_XGEN(b.x)], 1u);
            asm volatile("s_waitcnt vmcnt(0)" ::: "memory");
        } else {
            XB_SPIN(xb_ld(&bar[XB_XGEN(b.x)]) == gen, bar);
            __builtin_amdgcn_fence(__ATOMIC_ACQUIRE, "agent");
            asm volatile("s_waitcnt vmcnt(0)" ::: "memory");
        }
    }
    __syncthreads();
}

#endif

__global__ void __launch_bounds__(NWAVES * 64, 2) skel_fwd(Args args) {
#ifdef EMU
    unsigned char* lds = emu::B->lds;
#else
    extern __shared__ __attribute__((aligned(16))) unsigned char lds[];
#endif
    Frame F;
    F.lds = (LAS unsigned char*)lds;
    F.wave = RDFL((int)(threadIdx.x >> 6)); F.tacc = 0u;
    F.G = gridDim.x; { const int bx = blockIdx.x; F.vcu = (F.G % 8 == 0) ? (bx % 8) * (F.G / 8) + bx / 8 : bx; }
    unsigned char* ws = args.ws; F.ws = ws; F.out = args.out;
    F.in = args.in;
    F.ctl = (unsigned*)(ws + WS_CTL);
    for (int u = (int)threadIdx.x; u < (LDS_BYTES - LDSCTL_OFF) / 4; u += NWAVES * 64) ((LAS unsigned*)(F.lds + LDSCTL_OFF))[u] = 0u;
    __syncthreads();
#ifndef EMU
    volatile LAS unsigned* MISC = (volatile LAS unsigned*)(F.lds + MISC_OFF);
    XcdBarrier bar = xcd_barrier_post((unsigned*)(F.ctl + CW_BAR) + args.li * XCD_BAR_WORDS, MISC + 8);
#define GRID_BAR() do { xcd_barrier(bar); if (PROBE_DUP & 256) xcd_barrier(bar); } while (0)
#else
#define GRID_BAR() do {} while (0)
#endif
#ifdef EMU
#define PHASE_STAGGER(ticks) do {} while (0)
#else
#define PHASE_STAGGER(ticks) do { const unsigned long long t0_ = __builtin_amdgcn_s_memrealtime(), dl_ = (unsigned long long)((F.vcu & 31) * (ticks)); \
        while (__builtin_amdgcn_s_memrealtime() - t0_ < dl_) __builtin_amdgcn_s_sleep(8); } while (0)
#endif
#if !defined(EMU) && defined(PROBE_SEC)
    const unsigned long long pc0_ = __builtin_readcyclecounter(), pt0_ = __builtin_amdgcn_s_memrealtime();
#endif
    const int lo = args.ph_lo, hi = args.ph_hi;
#define IN(k) (lo <= (k) && (k) < hi)
#define BOTH(k) (IN(k) && IN((k) + 1))

    if (IN(0)) { p0_prologue(F);
#if PROBE_DUP & 32
        VM_WAIT(); __syncthreads(); p0_prologue(F);
#endif
        if (BOTH(0)) GRID_BAR(); }

    if (IN(1)) {
        pg8::Gemm g{F.XN(), F.WinT(), MALL, NPROJ, D}; pg8::StaticOrder S; S.init(MALL, NPROJ, F.G, (int)blockIdx.x); S.wid = F.wave;
        pg8::EpiProj E{F.Z(), F.XBC(), F.Q(), F.K(), F.V(), F.GS(), F.GA(), F.DT(), F.in[I_DTB], F.out};
        pg8::gemm_phase<pg8::EpiProj, pg8::StaticOrder, PG8_ALIGN, PG8_SP2>(F.lds + RING_OFF, g, S, E);
#if PROBE_DUP & 1
        VM_WAIT(); __syncthreads();
        pg8::gemm_phase<pg8::EpiProj, pg8::StaticOrder, PG8_ALIGN, PG8_SP2>(F.lds + RING_OFF, g, S, E);
#endif
        if (BOTH(1)) GRID_BAR();
    }

    if (IN(2)) {
        att_lambda_setup(F);
        { constexpr int NCP = SEQ / 128; const int cls = F.vcu & 3, sample_slot = cls == 0 ? -1 : (cls == 1 ? 0 : (cls == 2 ? (NCP * 11) / 16 : NCP));
          for (int sl = -1; sl <= NCP; ++sl) {
              if (sl == 0) {
                  for (int u = F.vcu; u < BATCH * NGRP; u += F.G) ssd_unit(F, 0, u / NGRP, u % NGRP);
                  for (int u = F.vcu; u < DECB * NGRP; u += F.G) ssd_unit(F, 1, u / NGRP, u % NGRP);
#if PROBE_DUP & 8
                  for (int u = F.vcu; u < BATCH * NGRP; u += F.G) ssd_unit(F, 0, u / NGRP, u % NGRP);
                  for (int u = F.vcu; u < DECB * NGRP; u += F.G) ssd_unit(F, 1, u / NGRP, u % NGRP);
#endif
              }
              if (sl == sample_slot) for (int u = F.vcu; u < DECB * NAH; u += F.G) { att_head_setup(F, u % NAH); att_unit<1>(F, u / NAH, u % NAH, 0); }
              if (sl >= 0 && sl < NCP) for (int u = F.vcu; u < BATCH * NAH; u += F.G) { if (sl == 0 || sl == sample_slot || BATCH * NAH > F.G) att_head_setup(F, u % NAH); att_unit<0>(F, u / NAH, u % NAH, sl); }
          } }
#if !defined(EMU) && defined(PROBE_SEC)
        if (F.wave == 0) { const unsigned long long t0_ = __builtin_amdgcn_s_memrealtime(), dl_ = (unsigned long long)F.tacc * PROBE_AMP; while (__builtin_amdgcn_s_memrealtime() - t0_ < dl_) __builtin_amdgcn_s_sleep(8); }
#endif
        __syncthreads();
        if (BOTH(2)) GRID_BAR();
    }

    if (IN(3)) {
        { pg8::Gemm g{F.U(), F.WssdT(), MMAIN, D, DIN}; pg8::StaticOrder S; S.init(MMAIN, D, F.G, (int)blockIdx.x); S.wid = F.wave;
          pg8::EpiGate<0> E{F.GS(), nullptr, F.TMP()};
          pg8::gemm_phase<pg8::EpiGate<0>, pg8::StaticOrder, PG8_ALIGN, PG8_SP2>(F.lds + RING_OFF, g, S, E); }
        VM_WAIT(); __syncthreads();
        { pg8::Gemm g{F.O(), F.WattT(), MMAIN, D, D}; pg8::StaticOrder S; S.init(MMAIN, D, F.G, (int)blockIdx.x); S.wid = F.wave;
          pg8::EpiGate<1> E{F.GA(), F.TMP(), F.MIX()};
          pg8::gemm_phase<pg8::EpiGate<1>, pg8::StaticOrder, PG8_ALIGN, PG8_SP2>(F.lds + RING_OFF, g, S, E); }
#if PROBE_DUP & 2
        VM_WAIT(); __syncthreads();
        { pg8::Gemm g{F.U(), F.WssdT(), MMAIN, D, DIN}; pg8::StaticOrder S; S.init(MMAIN, D, F.G, (int)blockIdx.x); S.wid = F.wave;
          pg8::EpiGate<0> E{F.GS(), nullptr, F.TMP()};
          pg8::gemm_phase<pg8::EpiGate<0>, pg8::StaticOrder, PG8_ALIGN, PG8_SP2>(F.lds + RING_OFF, g, S, E); }
        VM_WAIT(); __syncthreads();
        { pg8::Gemm g{F.O(), F.WattT(), MMAIN, D, D}; pg8::StaticOrder S; S.init(MMAIN, D, F.G, (int)blockIdx.x); S.wid = F.wave;
          pg8::EpiGate<1> E{F.GA(), F.TMP(), F.MIX()};
          pg8::gemm_phase<pg8::EpiGate<1>, pg8::StaticOrder, PG8_ALIGN, PG8_SP2>(F.lds + RING_OFF, g, S, E); }
#endif
        if (BOTH(3)) GRID_BAR();
    }

    if (IN(4)) {
        pg8::Gemm g{F.MIX(), F.WoT(), MMAIN, D, D}; pg8::StaticOrder S; S.init(MMAIN, D, F.G, (int)blockIdx.x); S.wid = F.wave;
        pg8::EpiT E{F.T1(), D};
        pg8::gemm_phase<pg8::EpiT, pg8::StaticOrder, PG8_ALIGN, PG8_SP2>(F.lds + RING_OFF, g, S, E);
#if PROBE_DUP & 2
        VM_WAIT(); __syncthreads();
        pg8::gemm_phase<pg8::EpiT, pg8::StaticOrder, PG8_ALIGN, PG8_SP2>(F.lds + RING_OFF, g, S, E);
#endif
        if (BOTH(4)) GRID_BAR();
    }
    if (IN(5)) { row_phase(F, 0);
#if PROBE_DUP & 64
        VM_WAIT(); __syncthreads(); row_phase(F, 0);
#endif
        if (BOTH(5)) GRID_BAR(); }

    if (IN(6)) {
        pg8::Gemm g{F.XN(), F.WffT(), MMAIN, 2 * DFF, D}; pg8::StaticOrder S; S.init(MMAIN, 2 * DFF, F.G, (int)blockIdx.x); S.wid = F.wave;
        pg8::EpiSwiglu E{F.HB()};
        pg8::gemm_phase<pg8::EpiSwiglu, pg8::StaticOrder, PG8_ALIGN, PG8_SP2>(F.lds + RING_OFF, g, S, E);
#if PROBE_DUP & 4
        VM_WAIT(); __syncthreads();
        pg8::gemm_phase<pg8::EpiSwiglu, pg8::StaticOrder, PG8_ALIGN, PG8_SP2>(F.lds + RING_OFF, g, S, E);
#endif
        if (BOTH(6)) GRID_BAR();
    }
    if (IN(7)) {
        pg8::Gemm g{F.HB(), F.Wff2T(), MMAIN, D, DFF}; pg8::StaticOrder S; S.init(MMAIN, D, F.G, (int)blockIdx.x); S.wid = F.wave;
        pg8::EpiT E{F.T2(), D};
        pg8::gemm_phase<pg8::EpiT, pg8::StaticOrder, PG8_ALIGN, PG8_SP2>(F.lds + RING_OFF, g, S, E);
#if PROBE_DUP & 4
        VM_WAIT(); __syncthreads();
        pg8::gemm_phase<pg8::EpiT, pg8::StaticOrder, PG8_ALIGN, PG8_SP2>(F.lds + RING_OFF, g, S, E);
#endif
        if (BOTH(7)) GRID_BAR();
    }
#if !defined(EMU) && defined(PROBE_SEC)
    if (PROBE_SEC == 9 && F.wave == 0) {
        const unsigned long long pc1_ = __builtin_readcyclecounter(), pt1_ = __builtin_amdgcn_s_memrealtime();
        const unsigned long long dl_ = (pc1_ - pc0_) * 1000ull * PROBE_AMP / (pt1_ - pt0_ + 1ull), t0_ = __builtin_amdgcn_s_memrealtime();
        while (__builtin_amdgcn_s_memrealtime() - t0_ < dl_) __builtin_amdgcn_s_sleep(8); }
    __syncthreads();
#endif
    if (IN(8)) { row_phase(F, 1); }
#undef IN
#undef BOTH
}

extern "C" void kernel_launch(void* const* d_in, const int* in_sizes, int n_in, void* d_out, int out_size, void* d_ws, size_t ws_size, hipStream_t stream) {
    if (n_in != 29 || (size_t)out_size != OUT_END || ws_size < WS_END) { fprintf(stderr, "kernel_launch: shape mismatch: n_in %d out %d (want %zu) ws %zu (want %zu)\n", n_in, out_size, (size_t)OUT_END, ws_size, (size_t)WS_END); return; }
    Args a{};
    for (int i = 0; i < 29; ++i) a.in[i] = (const float*)d_in[i];
    a.out = (float*)d_out; a.ws = (unsigned char*)d_ws;
#ifdef EMU
    memset((char*)d_ws + WS_CTL, 0, CTL_ZERO_BYTES);
    const int first = getenv("EMU_PH_LO") ? atoi(getenv("EMU_PH_LO")) : 0, last = getenv("EMU_PH_HI") ? atoi(getenv("EMU_PH_HI")) : NPHASE;
    const int grid = getenv("EMU_GRID") ? atoi(getenv("EMU_GRID")) : 8;
    for (int ph = first; ph < last; ++ph) { a.ph_lo = ph; a.ph_hi = ph + 1; a.li = 0; fprintf(stderr, "[emu] phase %d\n", ph); emu::launch(grid, NWAVES * 64, LDS_BYTES, [=] { skel_fwd(a); }); }
#else
    static int grid = 0;
    if (grid == 0) {
        int dev = 0, cus = 0, per_cu = 0;
        if (hipGetDevice(&dev) != hipSuccess || hipDeviceGetAttribute(&cus, hipDeviceAttributeMultiprocessorCount, dev) != hipSuccess) { fprintf(stderr, "kernel_launch: device query failed\n"); grid = -1; return; }
        if (hipFuncSetAttribute((const void*)skel_fwd, hipFuncAttributeMaxDynamicSharedMemorySize, LDS_BYTES) != hipSuccess) { fprintf(stderr, "kernel_launch: hipFuncSetAttribute failed\n"); grid = -1; return; }
        if (hipOccupancyMaxActiveBlocksPerMultiprocessor(&per_cu, (const void*)skel_fwd, NWAVES * 64, LDS_BYTES) != hipSuccess || per_cu < 1) { fprintf(stderr, "kernel_launch: occupancy query says %d blocks per CU\n", per_cu); (void)hipGetLastError(); per_cu = 1; }
        grid = cus;
    }
    if (grid < 0) return;
    if (hipMemsetAsync((char*)d_ws + WS_CTL, 0, CTL_ZERO_BYTES, stream) != hipSuccess) { fprintf(stderr, "kernel_launch: memset failed\n"); return; }
    constexpr int NL = MK_N_LAUNCHES;
    for (int li = 0; li < NL; ++li) {
        a.ph_lo = NL == 1 ? 0 : li; a.ph_hi = NL == 1 ? NPHASE : li + 1; a.li = li;
        hipLaunchKernelGGL(skel_fwd, dim3(grid), dim3(NWAVES * 64), LDS_BYTES, stream, a);
        const hipError_t le = hipPeekAtLastError();
        if (le != hipSuccess) { fprintf(stderr, "kernel_launch: launch %d failed: %s\n", li, hipGetErrorName(le)); break; }
    }
#endif
}
```

```cpp
#ifndef EMU
#include <hip/hip_runtime.h>
#endif
#include <cstdio>
#include <cstdint>
#include <cmath>

#ifdef EMU
#define PG8_LAS
#define LAS
#define GAS
#define WAVE_LDS_SYNC() emu::wave_sync()
#define RDFL(x) (x)
#else
#define PG8_LAS __attribute__((address_space(3)))
#define LAS __attribute__((address_space(3)))
#define GAS __attribute__((address_space(1)))
#define WAVE_LDS_SYNC() asm volatile("s_waitcnt lgkmcnt(0)" ::: "memory")
#define RDFL(x) __builtin_amdgcn_readfirstlane(x)
#endif
#ifndef PROBE_DUP
#define PROBE_DUP 0
#endif
namespace pg8 {
typedef unsigned short bf16_t;
typedef short bf16x8 __attribute__((ext_vector_type(8)));
typedef float f32x4 __attribute__((ext_vector_type(4)));
typedef unsigned u32x4 __attribute__((ext_vector_type(4)));
constexpr int BM = 256, BK = 64, HALF = 128, HTB = HALF * BK * 2  , STAGE_BYTES = 8 * HTB, NXCD = 8, WGM = 8;

__host__ __device__ __forceinline__ int lds_byte(int r, int c) { const int st = (r >> 4) * 2 + (c >> 5), rr = r & 15, cc = c & 31, ob = rr * 64 + cc * 2; return st * 1024 + (ob ^ (((ob >> 9) & 1) << 5)); }
__host__ __device__ __forceinline__ void stage_rc(int b, int& R, int& C) { const int st = b / 1024, sb = b % 1024, swz = sb ^ (((sb >> 9) & 1) << 5); R = (st >> 1) * 16 + swz / 64; C = (st & 1) * 32 + (swz % 64) / 2; }
__host__ __device__ __forceinline__ int perm32(int rho) { const int n = rho >> 4, i = rho & 15; return 8 * (i >> 2) + 4 * n + (i & 3); }

struct Unit { int pm, pn; };
struct Gemm { const bf16_t* A; const bf16_t* Bt; int M, N, K; };

struct StaticOrder {
    int nM, nN, nwg, G, c, wid;
    __host__ __device__ void init(int M, int N, int G_, int c_) { nM = M / BM; nN = N / BM; nwg = nM * nN; G = G_; c = c_; }
    __host__ __device__ bool next(int i, Unit& u) const {
        const long L = (long)i * G + c; if (L >= nwg) return false;
        int wgid = (int)L; { const int q = nwg / NXCD, r = nwg % NXCD, xcd = wgid % NXCD, off = wgid / NXCD; wgid = (xcd < r ? xcd * (q + 1) : r * (q + 1) + (xcd - r) * q) + off; }
        const int nig = WGM * nN, gid = wgid / nig, fm = gid * WGM, gsz = (nM - fm) < WGM ? (nM - fm) : WGM;
        u.pm = fm + ((wgid % nig) % gsz); u.pn = (wgid % nig) / gsz; return true;
    }
    __device__ __forceinline__ void a_ready(const Unit&) const {}
    __device__ __forceinline__ void done(const Unit&) const {}
};
typedef float f32x2 __attribute__((ext_vector_type(2)));
#ifdef EMU
__device__ __forceinline__ unsigned cvt_pk_bf16(float lo, float hi) { return (unsigned)emu_f2bf(lo) | ((unsigned)emu_f2bf(hi) << 16); }
inline void emu_host_tile(const Gemm& g, const Unit& u, float* C) {
    const int K = g.K; std::vector<float> a((size_t)256 * K), b((size_t)256 * K);
    for (int r = 0; r < 256; ++r) for (int k = 0; k < K; ++k) { a[(size_t)r * K + k] = emu_bf2f(g.A[(size_t)(u.pm * 256 + r) * K + k]); b[(size_t)r * K + k] = emu_bf2f(g.Bt[(size_t)(u.pn * 256 + r) * K + k]); }
    for (int r = 0; r < 256; ++r) for (int c = 0; c < 256; ++c) { const float* ap = &a[(size_t)r * K]; const float* bp = &b[(size_t)c * K]; float s0 = 0.f, s1 = 0.f, s2 = 0.f, s3 = 0.f;
        for (int k = 0; k < K; k += 4) { s0 += ap[k] * bp[k]; s1 += ap[k + 1] * bp[k + 1]; s2 += ap[k + 2] * bp[k + 2]; s3 += ap[k + 3] * bp[k + 3]; } C[r * 256 + c] = (s0 + s1) + (s2 + s3); }
}
template <class Epi, class Sched, bool ALIGN_EPI = false, bool SP2 = false>
inline void gemm_phase(unsigned char* lds, const Gemm g, const Sched& S, const Epi& E) {
    const int tid = threadIdx.x, wid = tid >> 6, lane = tid & 63, wr = wid >> 2, wc = wid & 3, fr = lane & 15, fq = lane >> 4;
    Unit cur;
    for (int ui = 0; S.next(ui, cur); ++ui) {
        __syncthreads();
        if (tid == 0) emu_host_tile(g, cur, emu::B->gemm_tile);
        __syncthreads();
        f32x4 acc[2][2][4][2];
        for (int ai = 0; ai < 2; ++ai) for (int bj = 0; bj < 2; ++bj) for (int m = 0; m < 4; ++m) for (int n = 0; n < 2; ++n) for (int e = 0; e < 4; ++e) {
            const int row = 128 * ai + 64 * wr + 16 * m + fr, col = 128 * bj + 32 * wc + (Epi::PERM ? 8 * fq + 4 * n + e : 16 * n + 4 * fq + e);
            acc[ai][bj][m][n][e] = emu::B->gemm_tile[row * 256 + col]; }
        E(acc, cur, wr, wc, fr, fq);
    }
    __syncthreads();
}
#else
__device__ __forceinline__ int pg8_lane_id() { int x; asm volatile("v_mbcnt_lo_u32_b32 %0, -1, 0\n\tv_mbcnt_hi_u32_b32 %0, -1, %0" : "=v"(x)); return x; }
__device__ __forceinline__ unsigned cvt_pk_bf16(float lo, float hi) { unsigned r; asm volatile("v_cvt_pk_bf16_f32 %0, %1, %2" : "=v"(r) : "v"(lo), "v"(hi)); return r; }
template <class Epi, class Sched, bool ALIGN_EPI = false, bool SP2 = false>
__device__ __forceinline__ void gemm_phase(PG8_LAS unsigned char* lds, const Gemm g, const Sched& S, const Epi& E) {
    const int wid = S.wid, lane = pg8_lane_id(), tid = wid * 64 + lane, wr = wid >> 2, wc = wid & 3, fr = lane & 15, fq = lane >> 4;
    const int K = g.K, nt = K / BK;
    unsigned voffA[2], voffB[2];
#pragma unroll
    for (int i = 0; i < 2; ++i) { int R, C; stage_rc(tid * 16 + i * 8192, R, C); const int Rb = Epi::PERM ? ((R & ~31) + perm32(R & 31)) : R;
        voffA[i] = (unsigned)(R * K + C) * 2u; voffB[i] = (unsigned)(Rb * K + C) * 2u; }
    const size_t kstep = (size_t)(BK * 2);
    const size_t hstep = (size_t)HALF * K * 2;
    const size_t tstep = 2 * hstep;
    const unsigned ldsw = (unsigned)wid * 1024u;
    const int aoff = lds_byte(wr * 64 + fr, fq * 8), boff = lds_byte(wc * 32 + fr, fq * 8);
#define PG8_SA(b, h) (((b) * 2 + (h)) * HTB)
#define PG8_SB(b, h) ((4 + (b) * 2 + (h)) * HTB)
#define PG8_STAGE(bufoff, gbase, voff) do { _Pragma("unroll") for (int _i = 0; _i < 2; ++_i) \
        __builtin_amdgcn_global_load_lds((const unsigned*)((const char*)(gbase) + (voff)[_i]), (PG8_LAS unsigned*)(lds + (bufoff) + ldsw + _i * 8192), 16, 0, 0); } while (0)
#define PG8_LDA(dst, b, h) do { _Pragma("unroll") for (int m = 0; m < 4; ++m) _Pragma("unroll") for (int k = 0; k < 2; ++k) dst[m][k] = *(const PG8_LAS bf16x8*)(lds + PG8_SA(b, h) + aoff + m * 2048 + k * 1024); } while (0)
#define PG8_LDB(dst, b, h) do { _Pragma("unroll") for (int n = 0; n < 2; ++n) _Pragma("unroll") for (int k = 0; k < 2; ++k) dst[n][k] = *(const PG8_LAS bf16x8*)(lds + PG8_SB(b, h) + boff + n * 2048 + k * 1024); } while (0)
#define PG8_MMA(ai, bj, At, Bt) do { __builtin_amdgcn_s_setprio(1); _Pragma("unroll") for (int m = 0; m < 4; ++m) _Pragma("unroll") for (int n = 0; n < 2; ++n) _Pragma("unroll") for (int k = 0; k < 2; ++k) \
        acc[ai][bj][m][n] = __builtin_amdgcn_mfma_f32_16x16x32_bf16(Bt[n][k], At[m][k], acc[ai][bj][m][n], 0, 0, 0); __builtin_amdgcn_s_setprio(0); } while (0)
#define PG8_WAIT_V(n) asm volatile("s_waitcnt vmcnt(" #n ")" ::: "memory")
#define PG8_WAIT_L(n) asm volatile("s_waitcnt lgkmcnt(" #n ")" ::: "memory")
#define PG8_BAR __builtin_amdgcn_s_barrier()
#define PG8_SCHED __builtin_amdgcn_sched_barrier(0)
    Unit cur, nxt; int ui = 0;
    if (!S.next(0, cur)) return;
    f32x4 acc[2][2][4][2];
#pragma unroll
    for (int a = 0; a < 2; ++a)
#pragma unroll
        for (int b = 0; b < 2; ++b)
#pragma unroll
            for (int m = 0; m < 4; ++m)
#pragma unroll
                for (int n = 0; n < 2; ++n) acc[a][b][m][n] = (f32x4){0.f, 0.f, 0.f, 0.f};
    bf16x8 At[4][2], B0[2][2], B1[2][2];
    const char* cA = (const char*)g.A + (size_t)cur.pm * tstep; const char* cB = (const char*)g.Bt + (size_t)cur.pn * tstep;
    S.a_ready(cur);
    if constexpr (SP2) {
        PG8_STAGE(PG8_SB(0, 0), cB, voffB); PG8_STAGE(PG8_SB(0, 1), cB + hstep, voffB); PG8_STAGE(PG8_SA(0, 0), cA, voffA); PG8_STAGE(PG8_SA(0, 1), cA + hstep, voffA);
        if (wr == 1) PG8_BAR;
        PG8_WAIT_V(2); PG8_BAR;
        PG8_STAGE(PG8_SB(1, 0), cB + kstep, voffB); PG8_STAGE(PG8_SA(1, 0), cA + kstep, voffA); PG8_STAGE(PG8_SB(1, 1), cB + hstep + kstep, voffB);
        PG8_WAIT_V(6); PG8_BAR;
    } else {
        PG8_STAGE(PG8_SB(0, 0), cB, voffB); PG8_STAGE(PG8_SA(0, 0), cA, voffA); PG8_STAGE(PG8_SB(0, 1), cB + hstep, voffB); PG8_STAGE(PG8_SA(0, 1), cA + hstep, voffA);
        if (wr == 1) PG8_BAR;
        PG8_WAIT_V(4); PG8_BAR;
        PG8_STAGE(PG8_SB(1, 0), cB + kstep, voffB); PG8_STAGE(PG8_SA(1, 0), cA + kstep, voffA); PG8_STAGE(PG8_SB(1, 1), cB + hstep + kstep, voffB);
        PG8_WAIT_V(6); PG8_BAR;
    }
    for (;;) {
        const bool has_next = S.next(ui + 1, nxt);
        const char* nA = has_next ? (const char*)g.A + (size_t)nxt.pm * tstep : cA; const char* nB = has_next ? (const char*)g.Bt + (size_t)nxt.pn * tstep : cB;
        for (int t = 0; t < nt; t += 2) {
            const bool last = (t == nt - 2);
            const char* a1 = cA + (size_t)(t + 1) * kstep;
            const char* a2 = last ? nA : cA + (size_t)(t + 2) * kstep; const char* b2 = last ? nB : cB + (size_t)(t + 2) * kstep;
            const char* a3 = a2 + kstep; const char* b3 = b2 + kstep;
            if (last && has_next) S.a_ready(nxt);
            if constexpr (SP2) {
            PG8_LDB(B0, 0, 0); PG8_LDB(B1, 0, 1); PG8_SCHED; PG8_LDA(At, 0, 0); PG8_STAGE(PG8_SA(1, 1), a1 + hstep, voffA);
            PG8_WAIT_V(8); PG8_WAIT_L(0); PG8_BAR; PG8_MMA(0, 0, At, B0); PG8_MMA(0, 1, At, B1); PG8_BAR; PG8_SCHED;
            PG8_LDA(At, 0, 1); PG8_STAGE(PG8_SB(0, 0), b2, voffB); PG8_STAGE(PG8_SB(0, 1), b2 + hstep, voffB); PG8_STAGE(PG8_SA(0, 0), a2, voffA);
            PG8_WAIT_V(8); PG8_WAIT_L(0); PG8_BAR; PG8_MMA(1, 0, At, B0); PG8_MMA(1, 1, At, B1); PG8_BAR; PG8_SCHED;
            PG8_LDB(B0, 1, 0); PG8_LDB(B1, 1, 1); PG8_SCHED; PG8_LDA(At, 1, 0); PG8_STAGE(PG8_SA(0, 1), a2 + hstep, voffA);
            PG8_WAIT_V(8); PG8_WAIT_L(0); PG8_BAR; PG8_MMA(0, 0, At, B0); PG8_MMA(0, 1, At, B1); PG8_BAR; PG8_SCHED;
            PG8_LDA(At, 1, 1); PG8_STAGE(PG8_SB(1, 0), b3, voffB); PG8_STAGE(PG8_SB(1, 1), b3 + hstep, voffB); PG8_STAGE(PG8_SA(1, 0), a3, voffA);
            PG8_WAIT_V(8); PG8_WAIT_L(0); PG8_BAR; PG8_MMA(1, 0, At, B0); PG8_MMA(1, 1, At, B1); PG8_BAR; PG8_SCHED;
            } else {
            PG8_LDB(B0, 0, 0); PG8_SCHED; PG8_LDA(At, 0, 0); PG8_STAGE(PG8_SA(1, 1), a1 + hstep, voffA);
            PG8_WAIT_L(8); PG8_BAR; PG8_WAIT_L(0); PG8_MMA(0, 0, At, B0); PG8_BAR; PG8_SCHED;
            PG8_LDB(B1, 0, 1); PG8_STAGE(PG8_SB(0, 0), b2, voffB);
            PG8_BAR; PG8_WAIT_L(0); PG8_MMA(0, 1, At, B1); PG8_BAR;
            PG8_LDA(At, 0, 1); PG8_STAGE(PG8_SA(0, 0), a2, voffA);
            PG8_BAR; PG8_WAIT_L(0); PG8_MMA(1, 0, At, B0); PG8_BAR; PG8_SCHED;
            PG8_STAGE(PG8_SB(0, 1), b2 + hstep, voffB);
            PG8_WAIT_V(6); PG8_BAR; PG8_MMA(1, 1, At, B1); PG8_BAR;
            PG8_LDB(B0, 1, 0); PG8_SCHED; PG8_LDA(At, 1, 0); PG8_STAGE(PG8_SA(0, 1), a2 + hstep, voffA);
            PG8_WAIT_L(8); PG8_BAR; PG8_WAIT_L(0); PG8_MMA(0, 0, At, B0); PG8_BAR; PG8_SCHED;
            PG8_LDB(B1, 1, 1); PG8_STAGE(PG8_SB(1, 0), b3, voffB);
            PG8_BAR; PG8_WAIT_L(0); PG8_MMA(0, 1, At, B1); PG8_BAR;
            PG8_LDA(At, 1, 1); PG8_STAGE(PG8_SA(1, 0), a3, voffA);
            PG8_BAR; PG8_WAIT_L(0); PG8_MMA(1, 0, At, B0); PG8_BAR; PG8_SCHED;
            PG8_STAGE(PG8_SB(1, 1), b3 + hstep, voffB);
            PG8_WAIT_V(6); PG8_BAR; PG8_MMA(1, 1, At, B1); PG8_BAR;
            }
        }
        if constexpr (ALIGN_EPI) { if (wr == 0) PG8_BAR; }
        if constexpr (!Epi::AFTER_DRAIN) { E(acc, cur, wr, wc, fr, fq); if (PROBE_DUP & 128) { asm volatile("" ::: "memory"); E(acc, cur, wr, wc, fr, fq); } S.done(cur); }
        if (!has_next) break;
#pragma unroll
        for (int a = 0; a < 2; ++a)
#pragma unroll
            for (int b = 0; b < 2; ++b)
#pragma unroll
                for (int m = 0; m < 4; ++m)
#pragma unroll
                    for (int n = 0; n < 2; ++n) acc[a][b][m][n] = (f32x4){0.f, 0.f, 0.f, 0.f};
        cur = nxt; cA = nA; cB = nB; ++ui;
        if constexpr (ALIGN_EPI) { if (wr == 1) PG8_BAR; }
    }
    PG8_WAIT_V(0);
    if constexpr (!ALIGN_EPI) { if (wr == 0) PG8_BAR; }
    PG8_BAR;
    if constexpr (Epi::AFTER_DRAIN) { E.fused(acc, cur, wr, wc, fr, fq, lds, wid, lane); S.done(cur); }
#undef PG8_SA
#undef PG8_SB
#undef PG8_STAGE
#undef PG8_LDA
#undef PG8_LDB
#undef PG8_MMA
#undef PG8_WAIT_V
#undef PG8_WAIT_L
#undef PG8_BAR
#undef PG8_SCHED
}
#endif
}
#ifndef PG8_SP2
#define PG8_SP2 true
#endif
#ifndef PG8_ALIGN
#define PG8_ALIGN true
#endif

#ifndef CFG_BATCH
#define CFG_BATCH 32
#endif
#ifndef CFG_SEQ
#define CFG_SEQ 2048
#endif
#ifndef CFG_DECB
#define CFG_DECB 32
#endif
#ifndef CFG_PAST
#define CFG_PAST 4096
#endif
#ifndef STAGGER_P1
#define STAGGER_P1 100
#endif
#ifndef STAGGER_P6
#define STAGGER_P6 85
#endif
#ifndef MK_N_LAUNCHES
#define MK_N_LAUNCHES 1
#endif
constexpr int NWAVES = 8, NPHASE = 9;
constexpr int BATCH = CFG_BATCH, SEQ = CFG_SEQ, DECB = CFG_DECB, DSEQ = 32, PAST = CFG_PAST;
constexpr int D = 1024, NMETA = 16, DIN = 2048, CONVD = 4096, NSH = 32, NGRP = 8, DST = 128, NAH = 8, DFF = 2816;
constexpr int MP = BATCH * SEQ, MS = DECB * DSEQ, MMAIN = MP + MS, MALL = MMAIN + 256;
constexpr int NPROJ = 45 * 256, LEXT = NMETA + SEQ;
static_assert(MP % 256 == 0 && MS % 256 == 0 && SEQ % 128 == 0 && PAST % 64 == 0, "row panels");
constexpr float EPS = 1e-6f, LOG2E = 1.4426950408889634f, LN2 = 0.6931471805599453f, QSCALE = 0.125f * LOG2E;
constexpr size_t OUT_Y = 0, OUT_YS = OUT_Y + (size_t)MP * D, OUT_KP = OUT_YS + (size_t)MS * D, OUT_VP = OUT_KP + (size_t)BATCH * LEXT * 1024,
    OUT_CP = OUT_VP + (size_t)BATCH * LEXT * 1024, OUT_SP = OUT_CP + (size_t)BATCH * 3 * CONVD, OUT_KS = OUT_SP + (size_t)BATCH * NSH * 64 * DST,
    OUT_VS = OUT_KS + (size_t)MS * 1024, OUT_CS = OUT_VS + (size_t)MS * 1024, OUT_SS = OUT_CS + (size_t)DECB * 3 * CONVD, OUT_END = OUT_SS + (size_t)DECB * NSH * 64 * DST;
constexpr size_t MiB = 1u << 20;
constexpr size_t al(size_t x) { return (x + MiB - 1) & ~(MiB - 1); }
constexpr size_t WS_CTL = 0, CTL_ZERO_BYTES = 64 * 1024;
constexpr size_t WS_WIN = MiB, WS_WSSD = WS_WIN + al((size_t)NPROJ * D * 2), WS_WATT = WS_WSSD + al((size_t)D * DIN * 2), WS_WO = WS_WATT + al((size_t)D * D * 2),
    WS_WFF = WS_WO + al((size_t)D * D * 2), WS_WFF2 = WS_WFF + al((size_t)2 * DFF * D * 2), WS_XN = WS_WFF2 + al((size_t)D * DFF * 2);
constexpr size_t WS_Z = WS_XN + al((size_t)MALL * D * 2), WS_XBC = WS_Z + al((size_t)MALL * DIN * 2), WS_DT = WS_XBC + al((size_t)MALL * CONVD * 2), WS_Q = WS_DT + al((size_t)MALL * 32 * 4),
    WS_K = WS_Q + al((size_t)MALL * D * 2), WS_V = WS_K + al((size_t)MALL * D * 2), WS_GS = WS_V + al((size_t)MALL * D * 2), WS_GA = WS_GS + al((size_t)MALL * D * 2), WS_U = WS_GA + al((size_t)MALL * D * 2), WS_O = WS_U + al((size_t)MALL * DIN * 2), WS_END = WS_O + al((size_t)MALL * D * 2);
constexpr size_t WS_MIX = WS_XBC, WS_TMP = WS_XBC + (size_t)MMAIN * D * 2, WS_HB = WS_XBC, WS_T1 = WS_Q, WS_T2 = WS_Z;
static_assert(WS_TMP + (size_t)MMAIN * D * 2 <= WS_DT && WS_HB + (size_t)MMAIN * DFF * 2 <= WS_DT && WS_T2 + (size_t)MMAIN * D * 4 <= WS_XBC, "overlays");
static_assert(WS_END <= ((size_t)2048 << 20), "workspace map fits 2 GiB");
constexpr int CW_TMO = 0, CW_BAR = 4096;
constexpr int RING_OFF = 0, RING_BYTES = 131072, LDSCTL_OFF = RING_BYTES, MISC_OFF = LDSCTL_OFF + 320, LDS_BYTES = 147456;

typedef unsigned short bf16;
typedef unsigned v4u __attribute__((ext_vector_type(4)));
typedef unsigned v2u __attribute__((ext_vector_type(2)));
typedef float f32x4 __attribute__((ext_vector_type(4)));
typedef float f32x16 __attribute__((ext_vector_type(16)));
typedef short bf16x8 __attribute__((ext_vector_type(8)));
typedef short s16x4 __attribute__((ext_vector_type(4)));

#ifdef EMU
#define DEV inline
DEV float EXP2(float x) { return exp2f(x); }
DEV float LOG2(float x) { return log2f(x); }
DEV float RCP(float x) { return 1.0f / x; }
DEV float RSQ(float x) { return 1.0f / sqrtf(x); }
DEV unsigned pk2(float lo, float hi) { return (unsigned)emu_f2bf(lo) | ((unsigned)emu_f2bf(hi) << 16); }
DEV f32x16 mfma32(bf16x8 a, bf16x8 b, f32x16 c) { return emu_mfma32(a, b, c); }
DEV float uaf(unsigned u) { float f; memcpy(&f, &u, 4); return f; }
#define LDS_WAIT() do {} while (0)
#define SCHED_BAR() do {} while (0)
#define BAR_LDS() __syncthreads()
DEV int opaque_v(int x) { return x; }
#define VM_WAIT() do {} while (0)
#else
#define DEV __device__ __forceinline__
DEV float EXP2(float x) { return __builtin_amdgcn_exp2f(x); }
DEV float LOG2(float x) { return __builtin_amdgcn_logf(x); }
DEV float RCP(float x) { return __builtin_amdgcn_rcpf(x); }
DEV float RSQ(float x) { return __builtin_amdgcn_rsqf(x); }
typedef float f32x2_t __attribute__((ext_vector_type(2))); typedef __bf16 bf16x2_t __attribute__((ext_vector_type(2)));
DEV unsigned pk2(float lo, float hi) { f32x2_t v = {lo, hi}; bf16x2_t b = __builtin_convertvector(v, bf16x2_t); return __builtin_bit_cast(unsigned, b); }
DEV f32x16 mfma32(bf16x8 a, bf16x8 b, f32x16 c) { return __builtin_amdgcn_mfma_f32_32x32x16_bf16(a, b, c, 0, 0, 0); }
DEV float uaf(unsigned u) { return __uint_as_float(u); }
#define LDS_WAIT() asm volatile("s_waitcnt lgkmcnt(0)" ::: "memory")
#define SCHED_BAR() __builtin_amdgcn_sched_barrier(0)
#define BAR_LDS() asm volatile("s_waitcnt lgkmcnt(0)\n\ts_barrier" ::: "memory")
DEV int opaque_v(int x) { asm volatile("" : "+v"(x)); return x; }
#define VM_WAIT() asm volatile("s_waitcnt vmcnt(0)" ::: "memory")
#endif
#ifdef EMU
DEV int lane_id_() { return (int)(threadIdx.x & 63); }
#else
DEV int lane_id_() { int x; asm volatile("v_mbcnt_lo_u32_b32 %0, -1, 0\n\tv_mbcnt_hi_u32_b32 %0, -1, %0" : "=v"(x)); return x; }
#endif
#ifdef EMU
DEV float rdfl_f(float x) { return x; }
#else
DEV float rdfl_f(float x) { return __builtin_bit_cast(float, __builtin_amdgcn_readfirstlane(__builtin_bit_cast(int, x))); }
#endif
DEV float bflo(unsigned w) { return uaf(w << 16); }
DEV float bfhi(unsigned w) { return uaf(w & 0xffff0000u); }
DEV float bf2f(bf16 b) { return uaf((unsigned)b << 16); }
DEV float sigmoidf_(float x) { return RCP(1.0f + EXP2(-x * LOG2E)); }
DEV float siluf_(float x) { return x * sigmoidf_(x); }
DEV float softplusf_(float x) { return fmaxf(x, 0.f) + LN2 * LOG2(1.0f + EXP2(-fabsf(x) * LOG2E)); }
DEV int crow(int reg, int h) { return (reg & 3) + 8 * (reg >> 2) + 4 * h; }
DEV float wave_sum(float v) {
#pragma unroll
    for (int o = 1; o < 64; o <<= 1) v += __shfl_xor(v, o);
    return v;
}
DEV bf16x8 pack_step(const f32x16& x, int s) {
    v4u p; p.x = pk2(x[8 * s], x[8 * s + 1]); p.y = pk2(x[8 * s + 2], x[8 * s + 3]); p.z = pk2(x[8 * s + 4], x[8 * s + 5]); p.w = pk2(x[8 * s + 6], x[8 * s + 7]);
    return __builtin_bit_cast(bf16x8, p);
}
DEV bf16x8 rd16(const LAS unsigned char* p) { return *(const LAS bf16x8*)p; }
DEV bf16x8 rd8x2(const LAS unsigned char* p) {
    const v2u a = *(const LAS v2u*)p, b = *(const LAS v2u*)(p + 16); v4u r; r.x = a.x; r.y = a.y; r.z = b.x; r.w = b.y; return __builtin_bit_cast(bf16x8, r);
}

struct Frame {
    LAS unsigned char* lds;
    unsigned* ctl;
    int wave, G, vcu; unsigned tacc;
    DEV int lane() const { return lane_id_(); }
    DEV int tid() const { return wave * 64 + lane_id_(); }
    const float* const* in; float* out; unsigned char* ws;
#define WSP(T, NAME, OFF) DEV T* NAME() const { return (T*)(ws + OFF); }
    WSP(bf16, WinT, WS_WIN) WSP(bf16, WssdT, WS_WSSD) WSP(bf16, WattT, WS_WATT) WSP(bf16, WoT, WS_WO) WSP(bf16, WffT, WS_WFF) WSP(bf16, Wff2T, WS_WFF2)
    WSP(bf16, XN, WS_XN) WSP(bf16, Z, WS_Z) WSP(bf16, XBC, WS_XBC) WSP(bf16, Q, WS_Q) WSP(bf16, K, WS_K) WSP(bf16, V, WS_V) WSP(bf16, GS, WS_GS) WSP(bf16, GA, WS_GA) WSP(bf16, U, WS_U) WSP(bf16, O, WS_O)
    WSP(bf16, MIX, WS_MIX) WSP(bf16, TMP, WS_TMP) WSP(bf16, HB, WS_HB) WSP(float, DT, WS_DT) WSP(bf16, T1, WS_T1) WSP(bf16, T2, WS_T2)
#undef WSP
};
enum { I_XP = 0, I_XS, I_CK, I_CV, I_SSM, I_SCONV, I_META, I_RELB, I_NPRE, I_WIN, I_CONVW, I_CONVB, I_DTB, I_ALOG, I_DSKIP, I_SSDN, I_WSSD, I_LQ1, I_LK1, I_LQ2, I_LK2, I_SUBLN, I_WATT, I_WO, I_NPOST, I_NFFN, I_WFF, I_WFF2, I_NFFNP };

#if !defined(EMU) && defined(PROBE_SEC)
#define PT_NOW() ((unsigned)__builtin_amdgcn_s_memrealtime())
#define PT_ADD(sec, t0, t1) do { if (PROBE_SEC == (sec) && F.wave == 0) F.tacc += (t1) - (t0); } while (0)
#else
#define PT_NOW() 0u
#define PT_ADD(sec, t0, t1) do {} while (0)
#endif
DEV void p0_transpose_item(const float* W, int K, int N, int src_col0, bf16* WT, int dst_row0, LAS float* scr, int kb, int lane) {
    const int k0 = 64 * kb;
    float wv[32];
#pragma unroll
    for (int i = 0; i < 32; ++i) { const int kk = 2 * i + (lane >> 5); wv[i] = src_col0 >= 0 ? W[(size_t)(k0 + kk) * N + src_col0 + (lane & 31)] : 0.f; }
#pragma unroll
    for (int i = 0; i < 32; ++i) { const int kk = 2 * i + (lane >> 5); scr[kk * 33 + (lane & 31)] = wv[i]; }
    WAVE_LDS_SYNC();
    const int c = lane & 7;
#pragma unroll
    for (int j = 0; j < 4; ++j) { const int n = (lane >> 3) + 8 * j; const LAS float* s = scr + (8 * c) * 33 + n;
        v4u o; o.x = pk2(s[0 * 33], s[1 * 33]); o.y = pk2(s[2 * 33], s[3 * 33]); o.z = pk2(s[4 * 33], s[5 * 33]); o.w = pk2(s[6 * 33], s[7 * 33]);
        *(v4u*)(WT + (size_t)(dst_row0 + n) * K + k0 + 8 * c) = o; }
    WAVE_LDS_SYNC();
}
DEV void rms_row_to_bf16(const float* xrow, const float* gain, bf16* orow, int lane) {
    unsigned long long* o8 = (unsigned long long*)orow + lane;
    if (!xrow) {
#pragma unroll
        for (int j = 0; j < 4; ++j) o8[64 * j] = 0ull;
        return; }
    const f32x4* xr = (const f32x4*)xrow + lane; const f32x4* gr = (const f32x4*)gain + lane;
    f32x4 v[4]; float s = 0.f;
#pragma unroll
    for (int j = 0; j < 4; ++j) { v[j] = xr[64 * j]; s += (v[j].x * v[j].x + v[j].y * v[j].y) + (v[j].z * v[j].z + v[j].w * v[j].w); }
    const float r = RSQ(wave_sum(s) * (1.f / D) + EPS);
#pragma unroll
    for (int j = 0; j < 4; ++j) { const f32x4 g = gr[64 * j]; o8[64 * j] = (unsigned long long)pk2(v[j].x * r * g.x, v[j].y * r * g.y) | ((unsigned long long)pk2(v[j].z * r * g.z, v[j].w * r * g.w) << 32); }
}
DEV const float* x_row_ptr(const Frame& F, int m) {
    if (m < MP) return F.in[I_XP] + (size_t)m * D;
    if (m < MMAIN) return F.in[I_XS] + (size_t)(m - MP) * D;
    if (m < MMAIN + NMETA) return F.in[I_META] + (size_t)(m - MMAIN) * D;
    return nullptr;
}
constexpr int P0_GAIN_OFF = LDSCTL_OFF + 1024;
DEV void p0_prologue(Frame& F) {
    LAS float* scr = (LAS float*)(F.lds + RING_OFF + F.wave * 16384);
    { LAS float* GL = (LAS float*)(F.lds + P0_GAIN_OFF); for (int k = F.tid(); k < D; k += NWAVES * 64) GL[k] = F.in[I_NPRE][k]; __syncthreads(); }
    const int gw = F.vcu * NWAVES + F.wave, NGW = F.G * NWAVES;
    constexpr int I_IN = (D / 64) * (NPROJ / 32), I_SSD = (DIN / 64) * (D / 32), I_ATT = (D / 64) * (D / 32), I_O = I_ATT, I_FF = (D / 64) * (2 * DFF / 32), I_FF2 = (DFF / 64) * (D / 32);
    constexpr int NITEMS = I_IN + I_SSD + I_ATT + I_O + I_FF + I_FF2;
    for (int it = gw; it < NITEMS; it += NGW) {
        int r = it;
        if (r < I_IN) {
            const int nblk = NPROJ / 32, kb = r / nblk, n0 = 32 * (r % nblk);
            const int src = n0 < 6144 ? n0 : (n0 < 11264 ? n0 + 32 : (n0 == 11264 ? 6144 : -1));
            p0_transpose_item(F.in[I_WIN], D, 11296, src, F.WinT(), n0, scr, kb, F.lane()); continue; } r -= I_IN;
        if (r < I_SSD) { const int nblk = D / 32; p0_transpose_item(F.in[I_WSSD], DIN, D, 32 * (r % nblk), F.WssdT(), 32 * (r % nblk), scr, r / nblk, F.lane()); continue; } r -= I_SSD;
        if (r < I_ATT) { const int nblk = D / 32; p0_transpose_item(F.in[I_WATT], D, D, 32 * (r % nblk), F.WattT(), 32 * (r % nblk), scr, r / nblk, F.lane()); continue; } r -= I_ATT;
        if (r < I_O) { const int nblk = D / 32; p0_transpose_item(F.in[I_WO], D, D, 32 * (r % nblk), F.WoT(), 32 * (r % nblk), scr, r / nblk, F.lane()); continue; } r -= I_O;
        if (r < I_FF) {
            const int nblk = 2 * DFF / 32, kb = r / nblk, n0 = 32 * (r % nblk), t = n0 / 256, w = n0 % 256;
            const int src = w < 128 ? 128 * t + w : DFF + 128 * t + (w - 128);
            p0_transpose_item(F.in[I_WFF], D, 2 * DFF, src, F.WffT(), n0, scr, kb, F.lane()); continue; } r -= I_FF;
        { const int nblk = D / 32; p0_transpose_item(F.in[I_WFF2], DFF, D, 32 * (r % nblk), F.Wff2T(), 32 * (r % nblk), scr, r / nblk, F.lane()); }
    }
    for (int m = gw; m < MALL; m += 2 * NGW) {
        const int m2 = m + NGW; const float* x1 = x_row_ptr(F, m); const float* x2 = m2 < MALL ? x_row_ptr(F, m2) : nullptr;
        const LAS f32x4* gr = (const LAS f32x4*)(F.lds + P0_GAIN_OFF) + F.lane(); f32x4 v1[4], v2[4]; float s1 = 0.f, s2 = 0.f;
#pragma unroll
        for (int jj = 0; jj < 4; ++jj) { const f32x4 z = {0.f, 0.f, 0.f, 0.f}; v1[jj] = x1 ? ((const f32x4*)x1 + F.lane())[64 * jj] : z; v2[jj] = x2 ? ((const f32x4*)x2 + F.lane())[64 * jj] : z; }
#pragma unroll
        for (int jj = 0; jj < 4; ++jj) { s1 += (v1[jj].x * v1[jj].x + v1[jj].y * v1[jj].y) + (v1[jj].z * v1[jj].z + v1[jj].w * v1[jj].w); s2 += (v2[jj].x * v2[jj].x + v2[jj].y * v2[jj].y) + (v2[jj].z * v2[jj].z + v2[jj].w * v2[jj].w); }
        const float r1 = RSQ(wave_sum(s1) * (1.f / D) + EPS), r2 = RSQ(wave_sum(s2) * (1.f / D) + EPS);
        unsigned long long* o1 = (unsigned long long*)(F.XN() + (size_t)m * D) + F.lane(); unsigned long long* o2 = (unsigned long long*)(F.XN() + (size_t)m2 * D) + F.lane();
#pragma unroll
        for (int jj = 0; jj < 4; ++jj) { const f32x4 gq = gr[64 * jj];
            o1[64 * jj] = (unsigned long long)pk2(v1[jj].x * r1 * gq.x, v1[jj].y * r1 * gq.y) | ((unsigned long long)pk2(v1[jj].z * r1 * gq.z, v1[jj].w * r1 * gq.w) << 32);
            if (m2 < MALL) o2[64 * jj] = (unsigned long long)pk2(v2[jj].x * r2 * gq.x, v2[jj].y * r2 * gq.y) | ((unsigned long long)pk2(v2[jj].z * r2 * gq.z, v2[jj].w * r2 * gq.w) << 32); }
    }
}

#ifdef EMU
#define NT_STORE16(p, v) (*(p) = (v))
#else
#define NT_STORE16(p, v) __builtin_nontemporal_store((v), (p))
#endif
namespace pg8 {
struct EpiProj {
    static constexpr bool PERM = true, AFTER_DRAIN = false;
    bf16 *Z, *XBC, *Q, *K, *V, *GS, *GA; float* DT; const float* dtb; float* out;
    __device__ __forceinline__ void operator()(const f32x4 (&acc)[2][2][4][2], const Unit& u, int wr, int wc, int fr, int fq) const {
        const int t = u.pn;
        if (t == 44) {
            if (wc != 0) return;
            const f32x4 b0 = *(const f32x4*)(dtb + 8 * fq), b1 = *(const f32x4*)(dtb + 8 * fq + 4);
#pragma unroll
            for (int ai = 0; ai < 2; ++ai)
#pragma unroll
                for (int m = 0; m < 4; ++m) { const int r = u.pm * 256 + ai * 128 + wr * 64 + m * 16 + fr; f32x4 v0 = acc[ai][0][m][0] + b0, v1 = acc[ai][0][m][1] + b1;
#pragma unroll
                    for (int e = 0; e < 4; ++e) { v0[e] = softplusf_(v0[e]); v1[e] = softplusf_(v1[e]); }
                    *(f32x4*)(DT + (size_t)r * 32 + 8 * fq) = v0; *(f32x4*)(DT + (size_t)r * 32 + 8 * fq + 4) = v1; }
            return; }
        bf16* base; int ld, c0; int kind;
        if (t < 8) { base = Z; ld = DIN; c0 = 256 * t; kind = 0; }
        else if (t < 24) { base = XBC; ld = CONVD; c0 = 256 * (t - 8); kind = 1; }
        else if (t < 28) { base = Q; ld = D; c0 = 256 * (t - 24); kind = 2; }
        else if (t < 32) { base = K; ld = D; c0 = 256 * (t - 28); kind = 3; }
        else if (t < 36) { base = V; ld = D; c0 = 256 * (t - 32); kind = 4; }
        else if (t < 40) { base = GS; ld = D; c0 = 256 * (t - 36); kind = 5; }
        else { base = GA; ld = D; c0 = 256 * (t - 40); kind = 5; }
#pragma unroll
        for (int ai = 0; ai < 2; ++ai)
#pragma unroll
            for (int m = 0; m < 4; ++m) { const int r = u.pm * 256 + ai * 128 + wr * 64 + m * 16 + fr;
#pragma unroll
                for (int bj = 0; bj < 2; ++bj) { const int col = c0 + bj * 128 + wc * 32 + 8 * fq; f32x4 v0 = acc[ai][bj][m][0], v1 = acc[ai][bj][m][1];
                    if (kind == 1) {
                        float* dst = nullptr;
                        if (r < MP) { const int tt = r % SEQ; if (tt >= SEQ - 3) dst = out + OUT_CP + ((size_t)(r / SEQ) * 3 + (tt - (SEQ - 3))) * CONVD + col; }
                        else if (r < MMAIN) { const int tt = (r - MP) % DSEQ; if (tt >= DSEQ - 3) dst = out + OUT_CS + ((size_t)((r - MP) / DSEQ) * 3 + (tt - (DSEQ - 3))) * CONVD + col; }
                        if (dst) { *(f32x4*)dst = v0; *(f32x4*)(dst + 4) = v1; } }
                    if (kind == 2) { v0 = v0 * QSCALE; v1 = v1 * QSCALE; }
                    if (kind == 5) {
#pragma unroll
                        for (int e = 0; e < 4; ++e) { v0[e] = sigmoidf_(v0[e]); v1[e] = sigmoidf_(v1[e]); } }
                    u32x4 w; w.x = cvt_pk_bf16(v0[0], v0[1]); w.y = cvt_pk_bf16(v0[2], v0[3]); w.z = cvt_pk_bf16(v1[0], v1[1]); w.w = cvt_pk_bf16(v1[2], v1[3]);
                    *(u32x4*)(base + (size_t)r * ld + col) = w; } }
    }
};
template <int SECOND> struct EpiGate {
    static constexpr bool PERM = true, AFTER_DRAIN = false;
    const bf16* G; const bf16* T; bf16* O;
    __device__ __forceinline__ void operator()(const f32x4 (&acc)[2][2][4][2], const Unit& u, int wr, int wc, int fr, int fq) const {
#pragma unroll
        for (int ai = 0; ai < 2; ++ai) {
            u32x4 gv[4][2], tv[4][2];
#pragma unroll
            for (int m = 0; m < 4; ++m)
#pragma unroll
                for (int bj = 0; bj < 2; ++bj) { const size_t off = (size_t)(u.pm * 256 + ai * 128 + wr * 64 + m * 16 + fr) * D + u.pn * 256 + bj * 128 + wc * 32 + 8 * fq;
                    gv[m][bj] = *(const u32x4*)(G + off); if (SECOND) tv[m][bj] = *(const u32x4*)(T + off); }
            SCHED_BAR();
#pragma unroll
            for (int m = 0; m < 4; ++m)
#pragma unroll
                for (int bj = 0; bj < 2; ++bj) { const size_t off = (size_t)(u.pm * 256 + ai * 128 + wr * 64 + m * 16 + fr) * D + u.pn * 256 + bj * 128 + wc * 32 + 8 * fq;
                    const u32x4 g = gv[m][bj]; const f32x4 a0 = acc[ai][bj][m][0], a1 = acc[ai][bj][m][1];
                    float v[8] = {a0[0] * bflo(g.x), a0[1] * bfhi(g.x), a0[2] * bflo(g.y), a0[3] * bfhi(g.y), a1[0] * bflo(g.z), a1[1] * bfhi(g.z), a1[2] * bflo(g.w), a1[3] * bfhi(g.w)};
                    if (SECOND) { const u32x4 tq = tv[m][bj];
                        v[0] += bflo(tq.x); v[1] += bfhi(tq.x); v[2] += bflo(tq.y); v[3] += bfhi(tq.y); v[4] += bflo(tq.z); v[5] += bfhi(tq.z); v[6] += bflo(tq.w); v[7] += bfhi(tq.w); }
                    u32x4 w; w.x = cvt_pk_bf16(v[0], v[1]); w.y = cvt_pk_bf16(v[2], v[3]); w.z = cvt_pk_bf16(v[4], v[5]); w.w = cvt_pk_bf16(v[6], v[7]);
                    *(u32x4*)(O + off) = w; }
            SCHED_BAR(); }
    }
};
struct EpiF32 {
    static constexpr bool PERM = false, AFTER_DRAIN = false;
    float* O; int ldc;
    __device__ __forceinline__ void operator()(const f32x4 (&acc)[2][2][4][2], const Unit& u, int wr, int wc, int fr, int fq) const {
#pragma unroll
        for (int ai = 0; ai < 2; ++ai)
#pragma unroll
            for (int m = 0; m < 4; ++m) { float* rowp = O + (size_t)(u.pm * 256 + ai * 128 + wr * 64 + m * 16 + fr) * ldc + u.pn * 256 + wc * 32 + 4 * fq;
#pragma unroll
                for (int bj = 0; bj < 2; ++bj)
#pragma unroll
                    for (int n = 0; n < 2; ++n) *(f32x4*)(rowp + bj * 128 + n * 16) = acc[ai][bj][m][n]; }
    }
};
struct EpiT {
    static constexpr bool PERM = true, AFTER_DRAIN = false;
    bf16* O; int ldc;
    __device__ __forceinline__ void operator()(const f32x4 (&acc)[2][2][4][2], const Unit& u, int wr, int wc, int fr, int fq) const {
#pragma unroll
        for (int ai = 0; ai < 2; ++ai)
#pragma unroll
            for (int m = 0; m < 4; ++m) { bf16* rowp = O + (size_t)(u.pm * 256 + ai * 128 + wr * 64 + m * 16 + fr) * ldc + u.pn * 256 + wc * 32 + 8 * fq;
#pragma unroll
                for (int bj = 0; bj < 2; ++bj) { const f32x4 v0 = acc[ai][bj][m][0], v1 = acc[ai][bj][m][1];
                    u32x4 w; w.x = cvt_pk_bf16(v0[0], v0[1]); w.y = cvt_pk_bf16(v0[2], v0[3]); w.z = cvt_pk_bf16(v1[0], v1[1]); w.w = cvt_pk_bf16(v1[2], v1[3]);
                    *(u32x4*)(rowp + bj * 128) = w; } }
    }
};
struct EpiSwiglu {
    static constexpr bool PERM = true, AFTER_DRAIN = false;
    bf16* O;
    __device__ __forceinline__ void operator()(const f32x4 (&acc)[2][2][4][2], const Unit& u, int wr, int wc, int fr, int fq) const {
#pragma unroll
        for (int ai = 0; ai < 2; ++ai)
#pragma unroll
            for (int m = 0; m < 4; ++m) { const int r = u.pm * 256 + ai * 128 + wr * 64 + m * 16 + fr;
                const f32x4 g0 = acc[ai][0][m][0], g1 = acc[ai][0][m][1], u0 = acc[ai][1][m][0], u1 = acc[ai][1][m][1]; float v[8];
#pragma unroll
                for (int e = 0; e < 4; ++e) { v[e] = siluf_(g0[e]) * u0[e]; v[4 + e] = siluf_(g1[e]) * u1[e]; }
                u32x4 w; w.x = cvt_pk_bf16(v[0], v[1]); w.y = cvt_pk_bf16(v[2], v[3]); w.z = cvt_pk_bf16(v[4], v[5]); w.w = cvt_pk_bf16(v[6], v[7]);
                *(u32x4*)(O + (size_t)r * DFF + u.pn * 128 + wc * 32 + 8 * fq) = w; }
    }
};
}
constexpr int S_XT = 0, S_BM = 36864, S_BT = S_BM + 17408, S_CM = S_BT + 18432, S_ZU = S_CM + 17408, S_ACS = S_ZU + 33792, S_DTV = S_ACS + 1024, S_WSC = S_DTV + 1024, S_SSQ = S_WSC + 1024, S_END = S_SSQ + 2048;
constexpr int XT_P = 144, BM_P = 272, ZU_P = 528;
static_assert(S_END <= RING_BYTES, "SSD LDS map");
constexpr int S_CW = LDSCTL_OFF + 1024;
constexpr int S_GN = S_CW + 5 * 512 * 4;
static_assert(S_GN + 1024 <= LDS_BYTES, "conv weight table");
struct SsdChunk { int row0; int t0, t1, halo; bool store_y; };

DEV v4u ssd_raw_row(const Frame& F, const SsdChunk& ck, int sb, int tp, int col) {
    const v4u zero = {0u, 0u, 0u, 0u};
    if (tp >= ck.t0 && tp < ck.t1) return *(const v4u*)(F.XBC() + (int)(ck.row0 + tp) * CONVD + col);
    if (tp < ck.t0 && tp >= ck.t0 - 3) {
        if (ck.halo == 1) return *(const v4u*)(F.XBC() + (int)(ck.row0 + tp) * CONVD + col);
        if (ck.halo == 2) return *(const v4u*)(F.XBC() + (int)(MMAIN + NMETA + (tp - ck.t0)) * CONVD + col);
        if (ck.halo == 3) { const float* s = F.in[I_SCONV] + ((int)sb * 3 + (3 + tp - ck.t0)) * CONVD + col; const f32x4 a = *(const f32x4*)s, b = *(const f32x4*)(s + 4);
            v4u r; r.x = pk2(a.x, a.y); r.y = pk2(a.z, a.w); r.z = pk2(b.x, b.y); r.w = pk2(b.z, b.w); return r; }
    }
    return zero;
}
typedef float f32x2v __attribute__((ext_vector_type(2)));
DEV unsigned hw_(unsigned w, int h) { return h ? (w >> 16) : (w & 0xffffu); }

DEV void ssd_prefetch(const Frame& F, const SsdChunk& ck, int sb, int g, int lane, int tid, int w, v4u (&raw)[11], v4u (&zr)[4], float& dtv) {
    const int cg = lane, to = w;
    const int col = cg < 32 ? 256 * g + 8 * cg : (cg < 48 ? 2048 + 128 * g + 8 * (cg - 32) : 3072 + 128 * g + 8 * (cg - 48));
#pragma unroll
    for (int i = 0; i < 11; ++i) raw[i] = ssd_raw_row(F, ck, sb, 8 * to - 3 + i, col);
    { const int t = tid >> 3, seg = tid & 7; const bool valid = ck.store_y && t >= ck.t0 && t < ck.t1; const v4u zero = {0u, 0u, 0u, 0u};
#pragma unroll
      for (int i = 0; i < 4; ++i) zr[i] = valid ? *(const v4u*)(F.Z() + (int)(ck.row0 + t) * DIN + 256 * g + 32 * seg + 8 * i) : zero; }
    dtv = 0.f;
    if (w < 4) { const int t = lane; if (t >= ck.t0 && t < ck.t1) dtv = F.DT()[(int)(ck.row0 + t) * 32 + 4 * g + w]; }
}
DEV void ssd_chunk(Frame& F, const SsdChunk& ck, bool has_next, const SsdChunk& ckn, int sb, int g, f32x16 (&hacc)[4], v4u (&raw)[11], v4u (&zr)[4], float& dtv, const float a_coef, const float Dh) {
    LAS unsigned char* L = F.lds + RING_OFF;
    const int lane = opaque_v(F.lane()), tid = opaque_v(F.tid()), w = F.wave, l31 = lane & 31, hh = lane >> 5, h = w >> 1, j = w & 1;
    BAR_LDS();
    const unsigned pt0_ = PT_NOW();
    if (w < 4) {
        const int t = lane;
        const float a = a_coef;
        float x = dtv * a;
#pragma unroll
        for (int d = 1; d < 64; d <<= 1) { const float v = __shfl_up(x, d); if (lane >= d) x += v; }
        const float last = __shfl(x, 63);
        ((LAS float*)(L + S_ACS))[w * 64 + t] = x; ((LAS float*)(L + S_DTV))[w * 64 + t] = dtv; ((LAS float*)(L + S_WSC))[w * 64 + t] = EXP2((last - x) * LOG2E) * dtv;
    }
    SCHED_BAR();
    {
        const int cg = lane, to = w;
        const int col = cg < 32 ? 256 * g + 8 * cg : (cg < 48 ? 2048 + 128 * g + 8 * (cg - 32) : 3072 + 128 * g + 8 * (cg - 48));
        const LAS float* cwl = (const LAS float*)(F.lds + S_CW) + cg;
        unsigned pk[8][4];
#pragma unroll
        for (int e2 = 0; e2 < 4; ++e2) {
            f32x2v wgt[4], bias, xr[11];
#pragma unroll
            for (int i = 0; i < 4; ++i) wgt[i] = (f32x2v){cwl[(8 * i + 2 * e2) * 64], cwl[(8 * i + 2 * e2 + 1) * 64]};
            bias = (f32x2v){cwl[(32 + 2 * e2) * 64], cwl[(32 + 2 * e2 + 1) * 64]};
#pragma unroll
            for (int i = 0; i < 11; ++i) { const unsigned rw = raw[i][e2]; xr[i] = (f32x2v){bflo(rw), bfhi(rw)}; }
#pragma unroll
            for (int tt = 0; tt < 8; ++tt) { f32x2v a = bias;
#pragma unroll
                for (int i = 0; i < 4; ++i) a = wgt[i] * xr[tt + i] + a;
                const f32x2v e = (f32x2v){EXP2(a.x * -LOG2E), EXP2(a.y * -LOG2E)} + 1.0f;
                pk[tt][e2] = pk2(a.x * RCP(e.x), a.y * RCP(e.y)); }
            SCHED_BAR();
        }
        if (cg < 48) {
            LAS unsigned char* base = cg < 32 ? L + S_XT + (8 * cg) * XT_P : L + S_BT + (8 * (cg - 32)) * XT_P;
#pragma unroll
            for (int e = 0; e < 8; ++e) { v4u o;
                o.x = hw_(pk[0][e >> 1], e & 1) | (hw_(pk[1][e >> 1], e & 1) << 16); o.y = hw_(pk[2][e >> 1], e & 1) | (hw_(pk[3][e >> 1], e & 1) << 16);
                o.z = hw_(pk[4][e >> 1], e & 1) | (hw_(pk[5][e >> 1], e & 1) << 16); o.w = hw_(pk[6][e >> 1], e & 1) | (hw_(pk[7][e >> 1], e & 1) << 16);
                *(LAS v4u*)(base + e * XT_P + 16 * to) = o; }
        }
        if (cg >= 32) {
            LAS unsigned char* base = cg < 48 ? L + S_BM + 16 * (cg - 32) : L + S_CM + 16 * (cg - 48);
#pragma unroll
            for (int tt = 0; tt < 8; ++tt) { v4u o; o.x = pk[tt][0]; o.y = pk[tt][1]; o.z = pk[tt][2]; o.w = pk[tt][3]; *(LAS v4u*)(base + (8 * to + tt) * BM_P) = o; }
        }
    }
    SCHED_BAR();
    {
        const int t = tid >> 3, seg = tid & 7;
#pragma unroll
        for (int i = 0; i < 4; ++i) *(LAS v4u*)(L + S_ZU + t * ZU_P + seg * 64 + 16 * i) = zr[i];
    }
    SCHED_BAR();
    if (has_next) ssd_prefetch(F, ckn, sb, g, lane, tid, w, raw, zr, dtv);
    const unsigned pt1_ = PT_NOW();
    BAR_LDS();
    const unsigned pt2_ = PT_NOW(); PT_ADD(11, pt0_, pt1_); PT_ADD(12, pt1_, pt2_);
    const LAS float* ACS = (const LAS float*)(L + S_ACS) + h * 64; const LAS float* DTV = (const LAS float*)(L + S_DTV) + h * 64; const LAS float* WSC = (const LAS float*)(L + S_WSC) + h * 64;
    const LAS float* acs_l = ACS + l31;
    const LAS float* acs_h = ACS + 4 * hh;  const LAS float* dtv_h = DTV + 4 * hh;
    const LAS float* wsc_h = WSC + 8 * hh;
    const LAS unsigned char* cm4 = L + S_CM + l31 * BM_P + 8 * hh;
    const LAS unsigned char* cm8 = L + S_CM + l31 * BM_P + 16 * hh;
    const LAS unsigned char* bm8 = L + S_BM + l31 * BM_P + 16 * hh;
    const LAS unsigned char* xt4 = L + S_XT + (64 * h + 32 * j + l31) * XT_P + 8 * hh;
    const LAS unsigned char* xt8 = L + S_XT + (64 * h + 32 * j + l31) * XT_P + 16 * hh;
    const LAS unsigned char* bt8 = L + S_BT + l31 * XT_P + 16 * hh;
    f32x16 yacc[2];
#pragma unroll
    for (int tb = 0; tb < 2; ++tb)
#pragma unroll
        for (int r = 0; r < 16; ++r) yacc[tb][r] = 0.f;
    {
        bf16x8 cf[2][2][2];
#define LD_CF(buf, nb) do { _Pragma("unroll") for (int ss = 0; ss < 2; ++ss) _Pragma("unroll") for (int tb = 0; tb < 2; ++tb) cf[buf][ss][tb] = rd8x2(cm4 + 32 * tb * BM_P + (32 * (nb) + 16 * ss) * 2); } while (0)
        LD_CF(0, 0);
#pragma unroll
        for (int nb = 0; nb < 4; ++nb) {
            SCHED_BAR();
            if (nb < 3) LD_CF((nb + 1) & 1, nb + 1);
#pragma unroll
            for (int ss = 0; ss < 2; ++ss) { const bf16x8 a = pack_step(hacc[nb], ss);
#pragma unroll
                for (int tb = 0; tb < 2; ++tb) yacc[tb] = mfma32(a, cf[nb & 1][ss][tb], yacc[tb]); }
        }
#undef LD_CF
        SCHED_BAR();
    }
    float acs_t[2];
#pragma unroll
    for (int tb = 0; tb < 2; ++tb) { acs_t[tb] = acs_l[32 * tb]; const float e = EXP2(acs_t[tb] * LOG2E);
#pragma unroll
        for (int r = 0; r < 16; ++r) yacc[tb][r] *= e; }
    const int dl = l31 - 4 * hh;
    {
        bf16x8 fa[2][2], fb[2][2];
#define LD_G(buf, grp) do { const int t_ = (grp) >> 2, sb_ = t_ == 2 ? 1 : 0, tb_ = t_ == 0 ? 0 : 1, k0_ = 2 * ((grp) & 3); \
        _Pragma("unroll") for (int q = 0; q < 2; ++q) { fa[buf][q] = rd16(bm8 + 32 * sb_ * BM_P + 32 * (k0_ + q)); fb[buf][q] = rd16(cm8 + 32 * tb_ * BM_P + 32 * (k0_ + q)); } } while (0)
        LD_G(0, 0);
        f32x16 gt;
#pragma unroll
        for (int grp = 0; grp < 12; ++grp) { const int tile = grp >> 2, sb2 = tile == 2 ? 1 : 0, tb = tile == 0 ? 0 : 1;
            SCHED_BAR();
            if (grp < 11) LD_G((grp + 1) & 1, grp + 1);
            if ((grp & 3) == 0) {
#pragma unroll
                for (int r = 0; r < 16; ++r) gt[r] = 0.f; }
#pragma unroll
            for (int q = 0; q < 2; ++q) gt = mfma32(fa[grp & 1][q], fb[grp & 1][q], gt);
            if ((grp & 3) == 3) {
                SCHED_BAR();
                const bf16x8 xa0 = rd8x2(xt4 + (32 * sb2) * 2), xa1 = rd8x2(xt4 + (32 * sb2 + 16) * 2);
#pragma unroll
                for (int r = 0; r < 16; ++r) { const int so = 32 * sb2 + (r & 3) + 8 * (r >> 2); const float v = gt[r] * EXP2((acs_t[tb] - acs_h[so]) * LOG2E) * dtv_h[so];
                    gt[r] = (tile == 1 || (r & 3) + 8 * (r >> 2) <= dl) ? v : 0.f; }
                yacc[tb] = mfma32(xa0, pack_step(gt, 0), yacc[tb]); yacc[tb] = mfma32(xa1, pack_step(gt, 1), yacc[tb]);
            }
        }
#undef LD_G
        SCHED_BAR();
    }
    { const float dec = EXP2(ACS[63] * LOG2E);
#pragma unroll
      for (int nb = 0; nb < 4; ++nb)
#pragma unroll
          for (int r = 0; r < 16; ++r) hacc[nb][r] *= dec;
      bf16x8 ba[2][4]; v4u xr[2]; f32x4 w0[2], w1[2];
#define LD_S(buf, ks) do { xr[buf] = __builtin_bit_cast(v4u, rd16(xt8 + 32 * (ks))); w0[buf] = *(const LAS f32x4*)(wsc_h + 16 * (ks)); w1[buf] = *(const LAS f32x4*)(wsc_h + 16 * (ks) + 4); \
        _Pragma("unroll") for (int nb = 0; nb < 4; ++nb) ba[buf][nb] = rd16(bt8 + 32 * nb * XT_P + 32 * (ks)); } while (0)
      LD_S(0, 0);
#pragma unroll
      for (int ks = 0; ks < 4; ++ks) { const int bu = ks & 1;
          SCHED_BAR();
          if (ks < 3) LD_S((ks + 1) & 1, ks + 1);
          v4u xs; xs.x = pk2(bflo(xr[bu].x) * w0[bu].x, bfhi(xr[bu].x) * w0[bu].y); xs.y = pk2(bflo(xr[bu].y) * w0[bu].z, bfhi(xr[bu].y) * w0[bu].w);
          xs.z = pk2(bflo(xr[bu].z) * w1[bu].x, bfhi(xr[bu].z) * w1[bu].y); xs.w = pk2(bflo(xr[bu].w) * w1[bu].z, bfhi(xr[bu].w) * w1[bu].w);
          const bf16x8 b = __builtin_bit_cast(bf16x8, xs);
#pragma unroll
          for (int nb = 0; nb < 4; ++nb) hacc[nb] = mfma32(ba[bu][nb], b, hacc[nb]); }
#undef LD_S
    }
    SCHED_BAR();
    const unsigned pt3_ = PT_NOW(); PT_ADD(13, pt2_, pt3_);
    if (!ck.store_y) return;
    const LAS unsigned char* zu_l = L + S_ZU + l31 * ZU_P + (64 * h + 32 * j + 4 * hh) * 2;
    const LAS unsigned char* xt_l = L + S_XT + (64 * h + 32 * j + 4 * hh) * XT_P + l31 * 2;
    LAS float* ssq_l = (LAS float*)(L + S_SSQ) + l31;
    float ssq[2] = {0.f, 0.f};
#pragma unroll
    for (int tb = 0; tb < 2; ++tb) {
        v2u zw[4]; bf16 xv[16];
#pragma unroll
        for (int q4 = 0; q4 < 4; ++q4) { zw[q4] = *(const LAS v2u*)(zu_l + 32 * tb * ZU_P + 16 * q4);
#pragma unroll
            for (int e = 0; e < 4; ++e) xv[4 * q4 + e] = *(const LAS bf16*)(xt_l + (8 * q4 + e) * XT_P + 64 * tb); }
        SCHED_BAR();
#pragma unroll
        for (int q4 = 0; q4 < 4; ++q4) {
#pragma unroll
            for (int e = 0; e < 4; ++e) { const int r = 4 * q4 + e; const float x = bf2f(xv[r]);
                const unsigned zz = e < 2 ? zw[q4].x : zw[q4].y; const float z = (e & 1) ? bfhi(zz) : bflo(zz);
                const float u = (yacc[tb][r] + Dh * x) * siluf_(z); yacc[tb][r] = u; ssq[tb] += u * u; } }
        const float sq = ssq[tb] + __shfl_xor(ssq[tb], 32);
        if (hh == 0) ssq_l[64 * w + 32 * tb] = sq;
        SCHED_BAR(); }
    BAR_LDS();
    const LAS float* gn_l = (const LAS float*)(F.lds + S_GN) + 64 * h + 32 * j + 4 * hh;
#pragma unroll
    for (int tb = 0; tb < 2; ++tb) { float tot = 0.f;
#pragma unroll
        for (int ww = 0; ww < 8; ++ww) tot += ssq_l[64 * ww + 32 * tb];
        const float rstd = RSQ(tot * (1.f / 256.f) + EPS);
#pragma unroll
        for (int q4 = 0; q4 < 4; ++q4) { const f32x4 gn = *(const LAS f32x4*)(gn_l + 8 * q4);
            v2u o; o.x = pk2(yacc[tb][4 * q4] * rstd * gn.x, yacc[tb][4 * q4 + 1] * rstd * gn.y); o.y = pk2(yacc[tb][4 * q4 + 2] * rstd * gn.z, yacc[tb][4 * q4 + 3] * rstd * gn.w);
            *(LAS v2u*)((LAS unsigned char*)zu_l + 32 * tb * ZU_P + 16 * q4) = o; } }
    BAR_LDS();
    { const int t = tid >> 3, seg = tid & 7;
      if (t >= ck.t0 && t < ck.t1) {
#pragma unroll
          for (int i = 0; i < 4; ++i) *(v4u*)(F.U() + (int)(ck.row0 + t) * DIN + 256 * g + 32 * seg + 8 * i) = *(const LAS v4u*)(L + S_ZU + t * ZU_P + seg * 64 + 16 * i); } }
    { const unsigned pt4_ = PT_NOW(); PT_ADD(14, pt3_, pt4_); }
}
DEV void ssd_unit(Frame& F, int kind, int sb, int g) {
    const int w = F.wave, h = w >> 1, j = w & 1, head = 4 * g + h;
    f32x16 hacc[4];
    if (kind == 0) {
#pragma unroll
        for (int nb = 0; nb < 4; ++nb)
#pragma unroll
            for (int r = 0; r < 16; ++r) hacc[nb][r] = 0.f;
    } else {
        const int lane = opaque_v(F.lane()), l31 = lane & 31, hh = lane >> 5;
        const float* src = F.in[I_SSM] + (((int)sb * NSH + head) * 64 + 32 * j + l31) * DST;
#pragma unroll
        for (int nb = 0; nb < 4; ++nb)
#pragma unroll
            for (int q4 = 0; q4 < 4; ++q4) { const f32x4 v = *(const f32x4*)(src + 32 * nb + 8 * q4 + 4 * hh); hacc[nb][4 * q4] = v.x; hacc[nb][4 * q4 + 1] = v.y; hacc[nb][4 * q4 + 2] = v.z; hacc[nb][4 * q4 + 3] = v.w; }
    }
    v4u raw[11], zr[4]; float dtv;
    const int lane0 = opaque_v(F.lane()), tid0 = opaque_v(F.tid());
    const float a_coef = rdfl_f(-EXP2(F.in[I_ALOG][4 * g + (w & 3)] * LOG2E)), Dh = rdfl_f(F.in[I_DSKIP][4 * g + h]);
    { LAS float* CW = (LAS float*)(F.lds + S_CW);
      for (int idx = tid0; idx < 5 * 512; idx += NWAVES * 64) { const int i = idx >> 9, e = (idx >> 6) & 7, cg = idx & 63;
          const int col = cg < 32 ? 256 * g + 8 * cg : (cg < 48 ? 2048 + 128 * g + 8 * (cg - 32) : 3072 + 128 * g + 8 * (cg - 48));
          CW[idx] = i < 4 ? F.in[I_CONVW][i * CONVD + col + e] : F.in[I_CONVB][col + e]; }
      if (tid0 < 256) ((LAS float*)(F.lds + S_GN))[tid0] = F.in[I_SSDN][256 * g + tid0]; }
    if (kind == 0) {
        SsdChunk ck, ckn; ck.row0 = MMAIN - 48; ck.t0 = 48; ck.t1 = 64; ck.halo = 0; ck.store_y = false;
        ssd_prefetch(F, ck, sb, g, lane0, tid0, w, raw, zr, dtv);
        for (int c = -1; c < SEQ / 64; ++c) {
            ckn.row0 = sb * SEQ + 64 * (c + 1); ckn.t0 = 0; ckn.t1 = 64; ckn.halo = c + 1 == 0 ? 2 : 1; ckn.store_y = true;
            ssd_chunk(F, ck, c + 1 < SEQ / 64, ckn, sb, g, hacc, raw, zr, dtv, a_coef, Dh);
            ck = ckn;
        }
    } else {
        SsdChunk ck; ck.row0 = MP + DSEQ * sb; ck.t0 = 0; ck.t1 = DSEQ; ck.halo = 3; ck.store_y = true;
        ssd_prefetch(F, ck, sb, g, lane0, tid0, w, raw, zr, dtv);
        ssd_chunk(F, ck, false, ck, sb, g, hacc, raw, zr, dtv, a_coef, Dh);
    }
    const int lane = opaque_v(F.lane()), l31 = lane & 31, hh = lane >> 5;
    float* dst = F.out + (kind == 0 ? OUT_SP : OUT_SS) + (((int)sb * NSH + head) * 64 + 32 * j + l31) * DST;
#pragma unroll
    for (int nb = 0; nb < 4; ++nb)
#pragma unroll
        for (int q4 = 0; q4 < 4; ++q4) { f32x4 v; v.x = hacc[nb][4 * q4]; v.y = hacc[nb][4 * q4 + 1]; v.z = hacc[nb][4 * q4 + 2]; v.w = hacc[nb][4 * q4 + 3]; *(f32x4*)(dst + 32 * nb + 8 * q4 + 4 * hh) = v; }
}
constexpr int KT_P = 272, VN_P = 320, A_KBUF = 64 * KT_P, A_VBUF = 64 * VN_P, A_K0 = 0, A_V0 = 2 * A_KBUF, A_BIAS = A_V0 + 3 * A_VBUF, A_QF = A_BIAS + 1280 + 64, A_END = A_QF + 32768;
constexpr float ATT_THR = 8.0f;
#ifndef ATT_STAGGER
#define ATT_STAGGER 1
#endif
#ifndef ATT_FUSE
#define ATT_FUSE 0
#endif
static_assert(A_END <= RING_BYTES && 4 * 128 * 32 * 4 <= A_BIAS, "attention LDS map");
struct AttTile { int kind; int row0; const float* ck; const float* cv; int nvalid, kpos0; int orow; int osample; };
struct AttRegs { v4u r0, r1, r2, r3, r4, r5, r6, r7; };
#ifdef EMU
DEV void swap32_(unsigned& a, unsigned& b) { const unsigned oa = __shfl_xor(a, 32), ob = __shfl_xor(b, 32); const bool up = (emu::me().tid.x & 63) >= 32; const unsigned na = up ? ob : a, nb = up ? b : oa; a = na; b = nb; }
#define SETPRIO(n) do {} while (0)
DEV float max3_(float a, float b, float c) { return fmaxf(fmaxf(a, b), c); }
DEV bool wave_any(bool p) { int v = p ? 1 : 0;
    for (int o = 1; o < 64; o <<= 1) v |= __shfl_xor(v, o);
    return v != 0; }
DEV s16x4 tr_read(const unsigned char* p) {
    const int w = emu::me().tid.x >> 6, l = emu::me().tid.x & 63; memcpy(emu::B->xch[w][l], p, 8); emu::wave_sync();
    s16x4 r; const int g0 = l & ~15, i = l & 15;
    for (int j = 0; j < 4; ++j) r[j] = ((const short*)emu::B->xch[w][g0 + 4 * j + (i >> 2)])[i & 3];
    emu::wave_sync(); return r; }
#else
DEV bool wave_any(bool p) { return __any(p); }
DEV void swap32_(unsigned& a, unsigned& b) { auto r = __builtin_amdgcn_permlane32_swap(a, b, false, false); a = r[0]; b = r[1]; }
#define SETPRIO(n) __builtin_amdgcn_s_setprio(n)
DEV float max3_(float a, float b, float c) { float r; asm("v_max3_f32 %0, %1, %2, %3" : "=v"(r) : "v"(a), "v"(b), "v"(c)); return r; }
#endif
#ifdef EMU
#define TR_RD(dst, base, OFF) dst = tr_read((base) + (OFF))
#define TR8_WAIT(a0, a1, a2, a3, b0, b1, b2, b3) do {} while (0)
#define TR4_WAIT(a0, a1, b0, b1) do {} while (0)
#else
#define TR_RD(dst, base, OFF) asm volatile("ds_read_b64_tr_b16 %0, %1 offset:%c2" : "=&v"(dst) : "v"((unsigned)(size_t)(base)), "i"(OFF) : "memory")
#define TR4_WAIT(a0, a1, b0, b1) asm volatile("s_waitcnt lgkmcnt(0)" : "+v"(a0), "+v"(a1), "+v"(b0), "+v"(b1) :: "memory")
#define TR8_WAIT(a0, a1, a2, a3, b0, b1, b2, b3) asm volatile("s_waitcnt lgkmcnt(0)" : "+v"(a0), "+v"(a1), "+v"(a2), "+v"(a3), "+v"(b0), "+v"(b1), "+v"(b2), "+v"(b3) :: "memory")
#endif

template <int ukind> DEV AttTile att_tile(const Frame& F, int sb, int hd, int i, int cp) {
    AttTile t; t.ck = nullptr; t.cv = nullptr; t.kind = 0; t.orow = -1; t.osample = 0;
    if (i == 0) { t.row0 = MMAIN; t.nvalid = NMETA; t.kpos0 = 0; if (ukind == 0 && cp == 0) t.orow = sb * LEXT; return t; }
    const int f = i - 1;
    if (ukind == 0) { t.row0 = sb * SEQ + 64 * f; t.nvalid = 64; t.kpos0 = NMETA + 64 * f; if ((f >> 1) == cp) t.orow = sb * LEXT + NMETA + 64 * f; return t; }
    if (f < PAST / 64) { t.kind = 1; t.row0 = 0; t.ck = F.in[I_CK] + ((size_t)sb * PAST + 64 * f) * 1024 + 128 * hd; t.cv = F.in[I_CV] + ((size_t)sb * PAST + 64 * f) * 1024 + 128 * hd; t.nvalid = 64; t.kpos0 = NMETA + 64 * f; return t; }
    t.row0 = MP + DSEQ * sb; t.nvalid = DSEQ; t.kpos0 = NMETA + PAST; t.orow = DSEQ * sb; t.osample = 1; return t;
}
template <int ukind> DEV void att_load(const Frame& F, const AttTile& t, int hd, AttRegs& R, int tid) {
    tid = opaque_v(tid);
    const int kv = tid >> 3, seg = tid & 7; const v4u zero = {0u, 0u, 0u, 0u}; const bool ok = kv < t.nvalid;
    R.r0 = zero; R.r1 = zero; R.r2 = zero; R.r3 = zero; if (ukind == 1) { R.r4 = zero; R.r5 = zero; R.r6 = zero; R.r7 = zero; }
    if (ukind == 0 || t.kind == 0) {
        const int off = (t.row0 + kv) * D + 128 * hd + 16 * seg; const bf16* kp = F.K() + off; const bf16* vp = F.V() + off;
        if (ok) { R.r0 = *(const v4u*)(kp); R.r1 = *(const v4u*)(kp + 8); R.r2 = *(const v4u*)(vp); R.r3 = *(const v4u*)(vp + 8); }
    } else {
        const float* kp = t.ck + kv * 1024 + 16 * seg; const float* vp = t.cv + kv * 1024 + 16 * seg;
        if (ok) { R.r0 = *(const v4u*)(kp); R.r1 = *(const v4u*)(kp + 4); R.r2 = *(const v4u*)(kp + 8); R.r3 = *(const v4u*)(kp + 12);
                  R.r4 = *(const v4u*)(vp); R.r5 = *(const v4u*)(vp + 4); R.r6 = *(const v4u*)(vp + 8); R.r7 = *(const v4u*)(vp + 12); }
    }
}
DEV void att_load_fast(const Frame& F, const AttTile& t, int hd, AttRegs& R, int tid) {
    tid = opaque_v(tid);
    const int kv = tid >> 3, seg = tid & 7, off = (t.row0 + kv) * D + 128 * hd + 16 * seg; const bf16* kp = F.K() + off; const bf16* vp = F.V() + off;
    R.r0 = *(const v4u*)kp; R.r1 = *(const v4u*)(kp + 8); R.r2 = *(const v4u*)vp; R.r3 = *(const v4u*)(vp + 8);
}
DEV void att_load_cache(const AttTile& t, AttRegs& R, int tid) {
    tid = opaque_v(tid);
    const int kv = tid >> 3, seg = tid & 7; const float* kp = t.ck + kv * 1024 + 16 * seg; const float* vp = t.cv + kv * 1024 + 16 * seg;
    R.r0 = *(const v4u*)(kp); R.r1 = *(const v4u*)(kp + 4); R.r2 = *(const v4u*)(kp + 8); R.r3 = *(const v4u*)(kp + 12);
    R.r4 = *(const v4u*)(vp); R.r5 = *(const v4u*)(vp + 4); R.r6 = *(const v4u*)(vp + 8); R.r7 = *(const v4u*)(vp + 12);
}
DEV v4u pack8_(const v4u a, const v4u b) { v4u o; o.x = pk2(uaf(a.x), uaf(a.y)); o.y = pk2(uaf(a.z), uaf(a.w)); o.z = pk2(uaf(b.x), uaf(b.y)); o.w = pk2(uaf(b.z), uaf(b.w)); return o; }
template <int ukind, int OUTS = 1> DEV void att_store(const Frame& F, int hd, const AttTile& t, AttRegs& R, LAS unsigned char* kbuf, LAS unsigned char* vbuf, int tid) {
    tid = opaque_v(tid);
    const int kv = tid >> 3, seg = tid & 7;
    v4u bk[2], bv[2];
    if (ukind == 1 && t.kind == 1) { bk[0] = pack8_(R.r0, R.r1); bk[1] = pack8_(R.r2, R.r3); bv[0] = pack8_(R.r4, R.r5); bv[1] = pack8_(R.r6, R.r7); }
    else { bk[0] = R.r0; bk[1] = R.r1; bv[0] = R.r2; bv[1] = R.r3; }
#pragma unroll
    for (int i = 0; i < 2; ++i) { *(LAS v4u*)(kbuf + kv * KT_P + seg * 32 + 16 * i) = bk[i]; *(LAS v4u*)(vbuf + kv * VN_P + seg * 32 + 16 * i) = bv[i]; }
    if (OUTS == 2 || (OUTS == 1 && t.orow >= 0 && kv < t.nvalid)) {
        const int off = (t.orow + kv) * 1024 + 128 * hd + 16 * seg;
        float* ko = F.out + (t.osample ? OUT_KS : OUT_KP) + off; float* vo = F.out + (t.osample ? OUT_VS : OUT_VP) + off;
#pragma unroll
        for (int i = 0; i < 2; ++i) {
            f32x4 a; a.x = bflo(bk[i].x); a.y = bfhi(bk[i].x); a.z = bflo(bk[i].y); a.w = bfhi(bk[i].y); *(f32x4*)(ko + 8 * i) = a;
            a.x = bflo(bk[i].z); a.y = bfhi(bk[i].z); a.z = bflo(bk[i].w); a.w = bfhi(bk[i].w); *(f32x4*)(ko + 8 * i + 4) = a;
            a.x = bflo(bv[i].x); a.y = bfhi(bv[i].x); a.z = bflo(bv[i].y); a.w = bfhi(bv[i].y); *(f32x4*)(vo + 8 * i) = a;
            a.x = bflo(bv[i].z); a.y = bfhi(bv[i].z); a.z = bflo(bv[i].w); a.w = bfhi(bv[i].w); *(f32x4*)(vo + 8 * i + 4) = a; }
    }
}
constexpr int A_LAM_OFF = LDSCTL_OFF + 1024 + 5 * 512 * 4 + 1024;
static_assert(A_LAM_OFF + 129 * 4 <= LDS_BYTES, "lambda words");
DEV void att_lambda_setup(Frame& F) {
    LAS float* T = (LAS float*)(F.lds + A_LAM_OFF); const int tid = F.tid();
    if (tid < 64) { T[tid] = F.in[I_LQ1][tid] * F.in[I_LK1][tid]; T[64 + tid] = F.in[I_LQ2][tid] * F.in[I_LK2][tid]; }
    __syncthreads();
    if (tid == 0) { float sa = 0.f, sb2 = 0.f;
        for (int k = 0; k < 64; ++k) { sa += T[k]; sb2 += T[64 + k]; }
        T[128] = EXP2(sa * LOG2E) - EXP2(sb2 * LOG2E) + 0.2f; }
    __syncthreads();
}
DEV void att_head_setup(Frame& F, int hd) {
    LAS unsigned char* L = F.lds + RING_OFF; const int tid = opaque_v(F.tid()), lane = tid & 63;
    BAR_LDS();
    if (tid < 320) { const int rel = tid - 255, n = rel < 0 ? -rel : rel; int bk;
        if (n < 8) bk = n; else { bk = 8 + (int)(2.0f * LOG2((float)n * 0.125f) + 1e-4f); bk = bk > 15 ? 15 : bk; }
        if (rel > 0) bk += 16;
        ((LAS float*)(L + A_BIAS))[tid] = (F.in[I_RELB][bk * NAH + hd] - F.in[I_RELB][15 * NAH + hd]) * LOG2E; }
    if (tid == 448) ((LAS float*)(L + A_BIAS))[320] = ((const LAS float*)(F.lds + A_LAM_OFF))[128];
    if (tid >= 320 && tid < 448) ((LAS float*)(L + A_QF))[tid - 320] = F.in[I_SUBLN][tid - 320];
}
template <int ukind> DEV void att_unit(Frame& F, int sb, int hd, int cp) {
    LAS unsigned char* L = F.lds + RING_OFF;
    const int lane = opaque_v(F.lane()), tid = opaque_v(F.tid()), w = F.wave, l31 = lane & 31, hh = lane >> 5, comp = w >> 2, qb = w & 3;
    const bool active = ukind == 0 || qb == 0;
    const int ntile = ukind == 0 ? 2 * cp + 3 : PAST / 64 + 2;
    const int myvis = ukind == 0 ? 2 * cp + 2 + (qb >> 1) : ntile;
    const int qrow = ukind == 0 ? sb * SEQ + 128 * cp + 32 * qb + l31 : MP + DSEQ * sb + l31;
    const int qpos0 = ukind == 0 ? NMETA + 128 * cp + 32 * qb : NMETA + PAST;
    BAR_LDS();
    bf16x8 qf[4];
    LAS unsigned char* qf_l = L + A_QF + (w * 256 + lane) * 16;
#pragma unroll
    for (int d0 = 0; d0 < 4; ++d0) { const v4u z = {0u, 0u, 0u, 0u}; const v4u qv_ = active ? *(const v4u*)(F.Q() + qrow * D + 128 * hd + 64 * comp + 16 * d0 + 8 * hh) : z;
        if (ukind == 0 && ATT_FUSE) *(LAS v4u*)(qf_l + 1024 * d0) = qv_; else qf[d0] = __builtin_bit_cast(bf16x8, qv_); }
    f32x16 o[4];
#pragma unroll
    for (int r = 0; r < 16; ++r) {
#pragma unroll
        for (int dt = 0; dt < 4; ++dt) o[dt][r] = 0.f; }
    float mref = 0.f, lsum = 0.f;
    if (w >= 4) SETPRIO(1);
    AttRegs R, RB; AttTile tcur = att_tile<ukind>(F, sb, hd, 0, cp), tnext = tcur;
    if (ukind == 0 && !ATT_FUSE) {
        AttRegs RM; att_load<ukind>(F, tcur, hd, RM, tid);
        { const AttTile t1 = att_tile<ukind>(F, sb, hd, 1, cp); att_load_fast(F, t1, hd, RB, tid); }
        { const AttTile t2 = att_tile<ukind>(F, sb, hd, 2, cp); att_load_fast(F, t2, hd, R, tid); }
        SCHED_BAR();
        att_store<ukind>(F, hd, tcur, RM, L + A_K0, L + A_V0, tid);
    } else { att_load<ukind>(F, tcur, hd, R, tid); att_store<ukind>(F, hd, tcur, R, L + A_K0, L + A_V0, tid); }
    BAR_LDS();
#define ATT_SCORE(i) do { \
        f32x16 p0, p1; { const float nm = -mref; _Pragma("unroll") for (int r = 0; r < 16; ++r) { p0[r] = nm; p1[r] = nm; } } \
        const LAS unsigned char* kb = L + A_K0 + ((i) & 1) * A_KBUF + l31 * KT_P + (64 * comp + 8 * hh) * 2; \
        bf16x8 ka[4], kc[4];                     \
        _Pragma("unroll") for (int d0 = 0; d0 < 4; ++d0) { ka[d0] = rd16(kb + d0 * 32); kc[d0] = rd16(kb + 32 * KT_P + d0 * 32); } \
        SCHED_BAR(); \
        _Pragma("unroll") for (int d0 = 0; d0 < 4; ++d0) { p0 = mfma32(ka[d0], qf[d0], p0); p1 = mfma32(kc[d0], qf[d0], p1); } \
        SCHED_BAR(); \
        const int kmax = tcur.kpos0 + tcur.nvalid - 1; \
        if (kmax - qpos0 > -128) {             \
            const LAS float* tab_l = (const LAS float*)(L + A_BIAS) + (tcur.kpos0 - (qpos0 + l31) + 255 + 4 * hh); \
            _Pragma("unroll") for (int r = 0; r < 16; ++r) { p0[r] += tab_l[(r & 3) + 8 * (r >> 2)]; p1[r] += tab_l[(r & 3) + 8 * (r >> 2) + 32]; } } \
        if (tcur.nvalid < 64) { \
            _Pragma("unroll") for (int r = 0; r < 16; ++r) { if (crow(r, hh) >= tcur.nvalid) p0[r] = -INFINITY; if (crow(r, hh) + 32 >= tcur.nvalid) p1[r] = -INFINITY; } } \
        float mx = max3_(p0[0], p1[0], p0[1]), mx2 = max3_(p1[1], p0[2], p1[2]); \
        _Pragma("unroll") for (int r = 3; r < 15; r += 2) { mx = max3_(mx, p0[r], p1[r]); mx2 = max3_(mx2, p0[r + 1], p1[r + 1]); } \
        mx = max3_(mx, mx2, max3_(p0[15], p1[15], p0[15])); \
        mx = fmaxf(mx, __shfl_xor(mx, 32)); \
        if ((i) == 0 || wave_any(mx > ATT_THR)) {        \
            const float dl = (i) == 0 ? mx : fmaxf(mx, 0.f), f = EXP2(-dl); mref += dl; lsum *= f; \
            _Pragma("unroll") for (int r = 0; r < 16; ++r) { p0[r] -= dl; p1[r] -= dl; \
                _Pragma("unroll") for (int dt = 0; dt < 4; ++dt) o[dt][r] *= f; } } \
        float ps = 0.f; \
        _Pragma("unroll") for (int r = 0; r < 16; ++r) { p0[r] = EXP2(p0[r]); p1[r] = EXP2(p1[r]); ps += p0[r] + p1[r]; } \
        lsum += ps; \
        pa[0] = pack_step(p0, 0); pa[1] = pack_step(p0, 1); pa[2] = pack_step(p1, 0); pa[3] = pack_step(p1, 1); \
        SCHED_BAR(); } while (0)
#define ATT_PV(j) do { \
        const LAS unsigned char* vt = L + A_V0 + ((j) % 3) * A_VBUF + (4 * hh + ((lane & 15) >> 2)) * VN_P + (16 * ((lane >> 4) & 1) + 4 * (lane & 3)) * 2;     \
        s16x4 lo[2][4], hi[2][4];                \
        _Pragma("unroll") for (int dt = 0; dt < 4; ++dt) { TR_RD(lo[0][dt], vt, 64 * dt); TR_RD(hi[0][dt], vt, 8 * VN_P + 64 * dt); } \
        _Pragma("unroll") for (int ks = 0; ks < 4; ++ks) { \
            TR8_WAIT(lo[ks & 1][0], lo[ks & 1][1], lo[ks & 1][2], lo[ks & 1][3], hi[ks & 1][0], hi[ks & 1][1], hi[ks & 1][2], hi[ks & 1][3]); \
            if (ks < 3) { _Pragma("unroll") for (int dt = 0; dt < 4; ++dt) { TR_RD(lo[(ks + 1) & 1][dt], vt, (16 * (ks + 1)) * VN_P + 64 * dt); TR_RD(hi[(ks + 1) & 1][dt], vt, (16 * (ks + 1) + 8) * VN_P + 64 * dt); } } \
            _Pragma("unroll") for (int dt = 0; dt < 4; ++dt) { const s16x4 l_ = lo[ks & 1][dt], h_ = hi[ks & 1][dt]; \
                const bf16x8 a = {l_[0], l_[1], l_[2], l_[3], h_[0], h_[1], h_[2], h_[3]}; o[dt] = mfma32(a, pa[ks], o[dt]); } \
            SCHED_BAR(); } } while (0)
#define ATT_HEAD(i) if ((i) + 1 < ntile) { tnext = att_tile<ukind>(F, sb, hd, (i) + 1, cp); att_load<ukind>(F, tnext, hd, R, tid); }
#define ATT_TAIL(i) do { if ((i) + 1 < ntile) att_store<ukind>(F, hd, tnext, R, L + A_K0 + (((i) + 1) & 1) * A_KBUF, L + A_V0 + (((i) + 1) % 3) * A_VBUF, tid); tcur = tnext; BAR_LDS(); } while (0)
#define ATT_TAIL2_MAIN(i, RS) do { { const AttTile tn_ = att_tile<ukind>(F, sb, hd, (i) + 1, cp); att_store<ukind, 0>(F, hd, tn_, RS, L + A_K0 + (((i) + 1) & 1) * A_KBUF, L + A_V0 + (((i) + 1) % 3) * A_VBUF, tid); } \
        const unsigned pq0_ = PT_NOW(); \
        { const AttTile tf_ = att_tile<ukind>(F, sb, hd, (i) + 3, cp); att_load_fast(F, tf_, hd, RS, tid); } \
        const unsigned pq1_ = PT_NOW(); \
        BAR_LDS(); const unsigned pq2_ = PT_NOW(); PT_ADD(4, pq0_, pq1_); PT_ADD(5, pq1_, pq2_); } while (0)
#define ATT_TAIL2_LASTS(i, RS) do { { const AttTile tn_ = att_tile<ukind>(F, sb, hd, (i) + 1, cp); att_store<ukind, 2>(F, hd, tn_, RS, L + A_K0 + (((i) + 1) & 1) * A_KBUF, L + A_V0 + (((i) + 1) % 3) * A_VBUF, tid); } \
        BAR_LDS(); } while (0)
#define ATT_TAIL2_LASTN(i, RS) do { BAR_LDS(); } while (0)
#define ATT_PVLOOP(j, WITH_EXP) do { \
        const LAS unsigned char* vt = L + A_V0 + ((j) % 3) * A_VBUF + (4 * hh + ((lane & 15) >> 2)) * VN_P + (16 * ((lane >> 4) & 1) + 4 * (lane & 3)) * 2; \
        s16x4 lo[2][2], hi[2][2];                  \
        _Pragma("unroll") for (int k2 = 0; k2 < 2; ++k2) { TR_RD(lo[0][k2], vt, (16 * k2) * VN_P); TR_RD(hi[0][k2], vt, (16 * k2 + 8) * VN_P); } \
        _Pragma("unroll") for (int hs = 0; hs < 8; ++hs) { const int dt = hs >> 1, kb2 = 2 * (hs & 1), bu = hs & 1; \
            TR4_WAIT(lo[bu][0], lo[bu][1], hi[bu][0], hi[bu][1]); \
            if (hs < 7) { const int dn = (hs + 1) >> 1, kn = 2 * ((hs + 1) & 1); \
                _Pragma("unroll") for (int k2 = 0; k2 < 2; ++k2) { TR_RD(lo[bu ^ 1][k2], vt, (16 * (kn + k2)) * VN_P + 64 * dn); TR_RD(hi[bu ^ 1][k2], vt, (16 * (kn + k2) + 8) * VN_P + 64 * dn); } } \
            _Pragma("unroll") for (int k2 = 0; k2 < 2; ++k2) { const s16x4 l_ = lo[bu][k2], h_ = hi[bu][k2]; \
                const bf16x8 a = {l_[0], l_[1], l_[2], l_[3], h_[0], h_[1], h_[2], h_[3]}; o[dt] = mfma32(a, pa[kb2 + k2], o[dt]); \
                if (WITH_EXP) { p0[2 * hs + k2] = EXP2(p0[2 * hs + k2]); p1[2 * hs + k2] = EXP2(p1[2 * hs + k2]); } \
                SCHED_BAR(); } } } while (0)
#define ATT_FUSED(i) do { \
        const bool doS_ = (i) < myvis, doPV_ = (i) >= 1 && (i) - 1 < myvis; \
        f32x16 p0, p1; float fsc_ = 1.f; bool resc_ = false; \
        if (doS_) { \
            { const float nm = -mref; _Pragma("unroll") for (int r = 0; r < 16; ++r) { p0[r] = nm; p1[r] = nm; } } \
            const LAS unsigned char* kb = L + A_K0 + ((i) & 1) * A_KBUF + l31 * KT_P + (64 * comp + 8 * hh) * 2; \
            { bf16x8 ka[4]; \
              _Pragma("unroll") for (int d0 = 0; d0 < 4; ++d0) ka[d0] = rd16(kb + d0 * 32); \
              bf16x8 qv[4]; _Pragma("unroll") for (int d0 = 0; d0 < 4; ++d0) qv[d0] = rd16(qf_l + 1024 * d0); \
              SCHED_BAR(); \
              _Pragma("unroll") for (int d0 = 0; d0 < 4; ++d0) p0 = mfma32(ka[d0], qv[d0], p0); \
              _Pragma("unroll") for (int d0 = 0; d0 < 4; ++d0) ka[d0] = rd16(kb + 32 * KT_P + d0 * 32); \
              SCHED_BAR(); \
              _Pragma("unroll") for (int d0 = 0; d0 < 4; ++d0) p1 = mfma32(ka[d0], qv[d0], p1); } \
            SCHED_BAR(); \
            const int kmax = tcur.kpos0 + tcur.nvalid - 1; \
            if (kmax - qpos0 > -128) { \
                const LAS float* tab_l = (const LAS float*)(L + A_BIAS) + (tcur.kpos0 - (qpos0 + l31) + 255 + 4 * hh); \
                _Pragma("unroll") for (int r = 0; r < 16; ++r) { p0[r] += tab_l[(r & 3) + 8 * (r >> 2)]; p1[r] += tab_l[(r & 3) + 8 * (r >> 2) + 32]; } } \
            if (tcur.nvalid < 64) { \
                _Pragma("unroll") for (int r = 0; r < 16; ++r) { if (crow(r, hh) >= tcur.nvalid) p0[r] = -INFINITY; if (crow(r, hh) + 32 >= tcur.nvalid) p1[r] = -INFINITY; } } \
            float mx = max3_(p0[0], p1[0], p0[1]), mx2 = max3_(p1[1], p0[2], p1[2]); \
            _Pragma("unroll") for (int r = 3; r < 15; r += 2) { mx = max3_(mx, p0[r], p1[r]); mx2 = max3_(mx2, p0[r + 1], p1[r + 1]); } \
            mx = max3_(mx, mx2, max3_(p0[15], p1[15], p0[15])); \
            mx = fmaxf(mx, __shfl_xor(mx, 32)); \
            if ((i) == 0 || wave_any(mx > ATT_THR)) { \
                const float dl = (i) == 0 ? mx : fmaxf(mx, 0.f); fsc_ = EXP2(-dl); mref += dl; resc_ = true; \
                _Pragma("unroll") for (int r = 0; r < 16; ++r) { p0[r] -= dl; p1[r] -= dl; } } \
            SCHED_BAR(); } \
        if (doPV_) { if (doS_) ATT_PVLOOP((i) - 1, true); else ATT_PVLOOP((i) - 1, false); } \
        else if (doS_) { _Pragma("unroll") for (int r = 0; r < 16; ++r) { p0[r] = EXP2(p0[r]); p1[r] = EXP2(p1[r]); } } \
        if (doS_) { \
            if (resc_) { lsum *= fsc_; _Pragma("unroll") for (int r = 0; r < 16; ++r) { _Pragma("unroll") for (int dt = 0; dt < 4; ++dt) o[dt][r] *= fsc_; } } \
            float ps = 0.f; \
            _Pragma("unroll") for (int r = 0; r < 16; ++r) ps += p0[r] + p1[r]; \
            lsum += ps; \
            pa[0] = pack_step(p0, 0); pa[1] = pack_step(p0, 1); pa[2] = pack_step(p1, 0); pa[3] = pack_step(p1, 1); } \
        SCHED_BAR(); } while (0)
    if (ukind == 1) {
        constexpr int NC = PAST / 64; static_assert(NC % 2 == 0 && NC >= 2, "cache tiles");
#define ATT_ITS(i) do { tcur = att_tile<ukind>(F, sb, hd, (i), cp); if (active) { bf16x8 pa[4]; ATT_SCORE(i); ATT_PV(i); } } while (0)
#define ATT_TAILS(i, RS, LOADNEXT) do { { const AttTile tn_ = att_tile<ukind>(F, sb, hd, (i) + 1, cp); att_store<ukind, 1>(F, hd, tn_, RS, L + A_K0 + (((i) + 1) & 1) * A_KBUF, L + A_V0 + (((i) + 1) % 3) * A_VBUF, tid); } \
        if (LOADNEXT) { const AttTile tf_ = att_tile<ukind>(F, sb, hd, (i) + 3, cp); att_load_cache(tf_, RS, tid); } \
        BAR_LDS(); } while (0)
        { const AttTile t1 = att_tile<ukind>(F, sb, hd, 1, cp); att_load_cache(t1, RB, tid); }
        { const AttTile t2 = att_tile<ukind>(F, sb, hd, 2, cp); att_load_cache(t2, R, tid); }
        BAR_LDS();
        int i = 0;
        for (; i + 3 <= NC; i += 2) { ATT_ITS(i); ATT_TAILS(i, RB, true); ATT_ITS(i + 1); ATT_TAILS(i + 1, R, true); }
        ATT_ITS(i); { const AttTile tn_ = att_tile<ukind>(F, sb, hd, i + 1, cp); att_store<ukind, 1>(F, hd, tn_, RB, L + A_K0 + ((i + 1) & 1) * A_KBUF, L + A_V0 + ((i + 1) % 3) * A_VBUF, tid); }
        { const AttTile tf_ = att_tile<ukind>(F, sb, hd, NC + 1, cp); att_load<ukind>(F, tf_, hd, RB, tid); } BAR_LDS();
        ATT_ITS(i + 1); ATT_TAILS(i + 1, R, false);
        ATT_ITS(i + 2); ATT_TAILS(i + 2, RB, false);
        ATT_ITS(i + 3); BAR_LDS();
#undef ATT_ITS
#undef ATT_TAILS
    } else if (ATT_FUSE) {
        bf16x8 pa[4];
#pragma unroll
        for (int ks = 0; ks < 4; ++ks) pa[ks] = (bf16x8){0, 0, 0, 0, 0, 0, 0, 0};
        for (int i = 0; i <= ntile; ++i) { ATT_HEAD(i); ATT_FUSED(i); ATT_TAIL(i); }
    } else if (ATT_STAGGER == 0 || comp == 0) {
#define ATT_IT0(i, RS, TAILM) do { tcur = att_tile<ukind>(F, sb, hd, (i), cp); if ((i) < myvis) { bf16x8 pa[4]; ATT_SCORE(i); ATT_PV(i); } TAILM(i, RS); } while (0)
        int i = 0;
        for (; i + 3 < ntile; i += 2) { ATT_IT0(i, RB, ATT_TAIL2_MAIN); ATT_IT0(i + 1, R, ATT_TAIL2_MAIN); }
        ATT_IT0(i, RB, ATT_TAIL2_LASTS); ATT_IT0(i + 1, R, ATT_TAIL2_LASTS); ATT_IT0(i + 2, RB, ATT_TAIL2_LASTN);
        if (ATT_STAGGER) BAR_LDS();
#undef ATT_IT0
    } else {
        bf16x8 pa[4];
#pragma unroll
        for (int ks = 0; ks < 4; ++ks) pa[ks] = (bf16x8){0, 0, 0, 0, 0, 0, 0, 0};
#define ATT_IT1(i, RS, TAILM) do { tcur = att_tile<ukind>(F, sb, hd, (i) < ntile ? (i) : 0, cp); if ((i) >= 1 && (i) - 1 < myvis) ATT_PV((i) - 1); if ((i) < myvis) ATT_SCORE(i); TAILM(i, RS); } while (0)
        int i = 0;
        for (; i + 3 < ntile; i += 2) { ATT_IT1(i, RB, ATT_TAIL2_MAIN); ATT_IT1(i + 1, R, ATT_TAIL2_MAIN); }
        ATT_IT1(i, RB, ATT_TAIL2_LASTS); ATT_IT1(i + 1, R, ATT_TAIL2_LASTS); ATT_IT1(i + 2, RB, ATT_TAIL2_LASTN); ATT_IT1(i + 3, R, ATT_TAIL2_LASTN);
#undef ATT_IT1
    }
#undef ATT_HEAD
#undef ATT_TAIL
#undef ATT_TAIL2_MAIN
#undef ATT_TAIL2_LASTS
#undef ATT_TAIL2_LASTN
#undef ATT_SCORE
#undef ATT_PV
#undef ATT_FUSED
#undef ATT_PVLOOP
    SETPRIO(0);
    const int lane_e = opaque_v(F.lane()), l31x = lane_e & 31, hhx = lane_e >> 5;
    if (active) { const float l = lsum + __shfl_xor(lsum, 32), inv = RCP(l);
#pragma unroll
        for (int dt = 0; dt < 4; ++dt)
#pragma unroll
            for (int r = 0; r < 16; ++r) o[dt][r] *= inv; }
    LAS float* xo_l = (LAS float*)L + (qb * 128 + 4 * hhx) * 32 + l31x;
    if (active && comp == 1) {
#pragma unroll
        for (int dt = 0; dt < 4; ++dt)
#pragma unroll
            for (int r = 0; r < 16; ++r) xo_l[(32 * dt + (r & 3) + 8 * (r >> 2)) * 32] = o[dt][r]; }
    BAR_LDS();
    if (active && comp == 0) { float ss = 0.f;
        const float lam = ((const LAS float*)(L + A_BIAS))[320];
#pragma unroll
        for (int dt = 0; dt < 4; ++dt)
#pragma unroll
            for (int r = 0; r < 16; ++r) { const float v = o[dt][r] - lam * xo_l[(32 * dt + (r & 3) + 8 * (r >> 2)) * 32]; o[dt][r] = v; ss += v * v; }
        ss += __shfl_xor(ss, 32);
        const float rstd = RSQ(ss * (1.f / 128.f) + EPS) * 0.8f;
        const int l31e = l31x;
        const int qrow_e = ukind == 0 ? sb * SEQ + 128 * cp + 32 * qb + l31e : MP + DSEQ * sb + l31e;
        bf16* orow = F.O() + qrow_e * D + 128 * hd;
#pragma unroll
        for (int kp = 0; kp < 8; ++kp) { v2u ov[2];
#pragma unroll
            for (int u = 0; u < 2; ++u) { const int k = 2 * kp + u, dt = k >> 2, q4 = k & 3, d0 = 32 * dt + 8 * q4 + 4 * hhx; const f32x4 gn = *(const LAS f32x4*)((const LAS float*)(L + A_QF) + d0);
                ov[u].x = pk2(o[dt][4 * q4] * rstd * gn.x, o[dt][4 * q4 + 1] * rstd * gn.y); ov[u].y = pk2(o[dt][4 * q4 + 2] * rstd * gn.z, o[dt][4 * q4 + 3] * rstd * gn.w); }
            unsigned ax = ov[0].x, ay = ov[0].y, bx = ov[1].x, by = ov[1].y;
            swap32_(ax, bx); swap32_(ay, by);
            v4u wv; wv.x = ax; wv.y = ay; wv.z = bx; wv.w = by;
            *(v4u*)(orow + 16 * kp + 8 * hhx) = wv; } }
}

DEV f32x4 bf4_(v2u w) { f32x4 r; r.x = bflo(w.x); r.y = bfhi(w.x); r.z = bflo(w.y); r.w = bfhi(w.y); return r; }
struct RowRegs { v2u t[4], u[4]; f32x4 b[4]; };
DEV void row_load(const Frame& F, int second, int m, int lane, RowRegs& R) {
    const v2u* tr = (const v2u*)(F.T1() + (size_t)m * D) + lane; const v2u* ur = (const v2u*)(F.T2() + (size_t)m * D) + lane; const f32x4* br = (const f32x4*)x_row_ptr(F, m) + lane;
#pragma unroll
    for (int jj = 0; jj < 4; ++jj) { R.t[jj] = tr[64 * jj]; R.b[jj] = br[64 * jj]; if (second) R.u[jj] = ur[64 * jj]; }
}
DEV void row_proc(Frame& F, int second, int m, int lane, RowRegs& R) {
    const LAS f32x4* g1 = (const LAS f32x4*)(F.lds + RING_OFF) + lane;
    f32x4 tf[4]; float s = 0.f;
#pragma unroll
    for (int jj = 0; jj < 4; ++jj) { tf[jj] = bf4_(R.t[jj]); s += (tf[jj].x * tf[jj].x + tf[jj].y * tf[jj].y) + (tf[jj].z * tf[jj].z + tf[jj].w * tf[jj].w); }
    const float r = RSQ(wave_sum(s) * (1.f / D) + EPS); float s2 = 0.f;
    f32x4 bv[4];
#pragma unroll
    for (int jj = 0; jj < 4; ++jj) { const f32x4 g = g1[64 * jj]; bv[jj] = R.b[jj] + tf[jj] * r * g; s2 += (bv[jj].x * bv[jj].x + bv[jj].y * bv[jj].y) + (bv[jj].z * bv[jj].z + bv[jj].w * bv[jj].w); }
    if (!second) {
        const float r2 = RSQ(wave_sum(s2) * (1.f / D) + EPS); const LAS f32x4* g2 = (const LAS f32x4*)(F.lds + RING_OFF) + D / 4 + lane;
        unsigned long long* o8 = (unsigned long long*)(F.XN() + (size_t)m * D) + lane;
#pragma unroll
        for (int jj = 0; jj < 4; ++jj) { const f32x4 g = g2[64 * jj]; o8[64 * jj] = (unsigned long long)pk2(bv[jj].x * r2 * g.x, bv[jj].y * r2 * g.y) | ((unsigned long long)pk2(bv[jj].z * r2 * g.z, bv[jj].w * r2 * g.w) << 32); }
    } else {
        f32x4 uf[4]; float s3 = 0.f;
#pragma unroll
        for (int jj = 0; jj < 4; ++jj) { uf[jj] = bf4_(R.u[jj]); s3 += (uf[jj].x * uf[jj].x + uf[jj].y * uf[jj].y) + (uf[jj].z * uf[jj].z + uf[jj].w * uf[jj].w); }
        const float r3 = RSQ(wave_sum(s3) * (1.f / D) + EPS); const LAS f32x4* g3 = (const LAS f32x4*)(F.lds + RING_OFF) + 2 * (D / 4) + lane;
        f32x4* orow = (f32x4*)(F.out + (size_t)m * D) + lane;
#pragma unroll
        for (int jj = 0; jj < 4; ++jj) orow[64 * jj] = bv[jj] + uf[jj] * r3 * g3[64 * jj];
    }
}
DEV void row_phase(Frame& F, int second) {
    const int gw = F.vcu * NWAVES + F.wave, NGW = F.G * NWAVES, lane = F.lane();
    { LAS float* GL = (LAS float*)(F.lds + RING_OFF); const int tid = F.tid();
      for (int k = tid; k < D; k += NWAVES * 64) { GL[k] = F.in[I_NPOST][k]; GL[D + k] = F.in[I_NFFN][k]; GL[2 * D + k] = F.in[I_NFFNP][k]; }
      __syncthreads(); }
    RowRegs A, B; int m = gw;
    if (m < MMAIN) row_load(F, second, m, lane, A);
    while (m < MMAIN) {
        const int m1 = m + NGW, m2 = m + 2 * NGW;
        row_load(F, second, m1 < MMAIN ? m1 : MMAIN - 1, lane, B); SCHED_BAR();
        row_proc(F, second, m, lane, A); SCHED_BAR();
        if (m1 >= MMAIN) break;
        row_load(F, second, m2 < MMAIN ? m2 : MMAIN - 1, lane, A); SCHED_BAR();
        row_proc(F, second, m1, lane, B); SCHED_BAR();
        m = m2;
    }
}
struct Args { const float* in[29]; float* out; unsigned char* ws; int ph_lo, ph_hi, li, pad; };
#ifndef EMU
#define RLX_AGENT __ATOMIC_RELAXED, __HIP_MEMORY_SCOPE_AGENT
#define XB_TMO      128
#define XB_XCNT(j)  (256  + 64 * (j))
#define XB_XSUB(j)  (1280 + 64 * (j))
#define XB_XGEN(j)  (2304 + 64 * (j))
#define XB_TOP      3328
#define XB_TOPGEN   3392
#define XCD_BAR_WORDS 3456
#define XB_SPIN_CAP (1u << 18)

__device__ __forceinline__ unsigned xb_ld(unsigned* p)              { return __hip_atomic_load(p, __ATOMIC_RELAXED, __HIP_MEMORY_SCOPE_AGENT); }
__device__ __forceinline__ unsigned xb_add(unsigned* p, unsigned v) { return __hip_atomic_fetch_add(p, v, __ATOMIC_RELAXED, __HIP_MEMORY_SCOPE_AGENT); }
__device__ __forceinline__ unsigned xb_xcc_id() { return (unsigned)__builtin_amdgcn_s_getreg((3 << 11) | 20) & 0xFu; }
#define XB_SPIN(cond, bar) do { unsigned _sp = 0; while (cond) { __builtin_amdgcn_s_sleep(1); \
    if ((++_sp & 255u) == 0u) { if (xb_ld(&(bar)[XB_TMO])) break; if (_sp > XB_SPIN_CAP) { atomicAdd(&(bar)[XB_TMO], 1u); break; } } } } while (0)

struct XcdBarrier {
    unsigned* bar; unsigned x;
    volatile LAS unsigned* st;
};

__device__ __forceinline__ XcdBarrier xcd_barrier_post(unsigned* bar, volatile LAS unsigned* st) {
    XcdBarrier b; b.bar = bar; b.x = xb_xcc_id(); b.st = st;
    if (threadIdx.x == 0) (void)xb_add(&bar[XB_XCNT(b.x)], 1u);
    return b;
}
__device__ __forceinline__ void xcd_barrier_complete(unsigned* bar, unsigned x, unsigned& nloc, unsigned& nx) {
    const unsigned G = gridDim.x * gridDim.y * gridDim.z;
    unsigned sum, cnt, mine, sp = 0u;
    for (;;) {
        sum = 0u; cnt = 0u; mine = 0u;
#pragma unroll
        for (unsigned j = 0; j < 16; ++j) { const unsigned c = xb_ld(&bar[XB_XCNT(j)]); sum += c; cnt += (c > 0u) ? 1u : 0u; mine = (j == x) ? c : mine; }
        if (sum == G) break;
        __builtin_amdgcn_s_sleep(1);
        if ((++sp & 255u) == 0u) { if (xb_ld(&bar[XB_TMO])) break; if (sp > XB_SPIN_CAP) { atomicAdd(&bar[XB_TMO], 1u); break; } }
    }
    nloc = mine > 0u ? mine : 1u; nx = cnt > 0u ? cnt : 1u;
}

__device__ __forceinline__ void xcd_barrier(const XcdBarrier& b) {
    asm volatile("s_waitcnt vmcnt(0)" ::: "memory");
    __syncthreads();
    if (threadIdx.x == 0) {
        unsigned* bar = b.bar;
        __builtin_amdgcn_s_waitcnt(0);
        unsigned nloc = b.st[0], nx = b.st[1];
        if (nloc == 0u) { xcd_barrier_complete(bar, b.x, nloc, nx); b.st[0] = nloc; b.st[1] = nx; }
        const unsigned old = xb_add(&bar[XB_XSUB(b.x)], 1u);
        const unsigned gen = old / nloc;
        if (old + 1u == (gen + 1u) * nloc) {
            __builtin_amdgcn_fence(__ATOMIC_RELEASE, "agent");
            asm volatile("s_waitcnt vmcnt(0)" ::: "memory");
            const unsigned og = xb_add(&bar[XB_TOP], 1u);
            const unsigned tg = og / nx;
            if (og + 1u == (tg + 1u) * nx) xb_add(&bar[XB_TOPGEN], 1u);
            else XB_SPIN(xb_ld(&bar[XB_TOPGEN]) == tg, bar);
            __builtin_amdgcn_fence(__ATOMIC_ACQUIRE, "agent");
            xb_add(&bar[XB_XGEN(b.x)], 1u);
            asm volatile("s_waitcnt vmcnt(0)" ::: "memory");
        } else {
            XB_SPIN(xb_ld(&bar[XB_XGEN(b.x)]) == gen, bar);
            __builtin_amdgcn_fence(__ATOMIC_ACQUIRE, "agent");
            asm volatile("s_waitcnt vmcnt(0)" ::: "memory");
        }
    }
    __syncthreads();
}

#endif

__global__ void __launch_bounds__(NWAVES * 64, 2) skel_fwd(Args args) {
#ifdef EMU
    unsigned char* lds = emu::B->lds;
#else
    extern __shared__ __attribute__((aligned(16))) unsigned char lds[];
#endif
    Frame F;
    F.lds = (LAS unsigned char*)lds;
    F.wave = RDFL((int)(threadIdx.x >> 6)); F.tacc = 0u;
    F.G = gridDim.x; { const int bx = blockIdx.x; F.vcu = (F.G % 8 == 0) ? (bx % 8) * (F.G / 8) + bx / 8 : bx; }
    unsigned char* ws = args.ws; F.ws = ws; F.out = args.out;
    F.in = args.in;
    F.ctl = (unsigned*)(ws + WS_CTL);
    for (int u = (int)threadIdx.x; u < (LDS_BYTES - LDSCTL_OFF) / 4; u += NWAVES * 64) ((LAS unsigned*)(F.lds + LDSCTL_OFF))[u] = 0u;
    __syncthreads();
#ifndef EMU
    volatile LAS unsigned* MISC = (volatile LAS unsigned*)(F.lds + MISC_OFF);
    XcdBarrier bar = xcd_barrier_post((unsigned*)(F.ctl + CW_BAR) + args.li * XCD_BAR_WORDS, MISC + 8);
#define GRID_BAR() do { xcd_barrier(bar); if (PROBE_DUP & 256) xcd_barrier(bar); } while (0)
#else
#define GRID_BAR() do {} while (0)
#endif
#ifdef EMU
#define PHASE_STAGGER(ticks) do {} while (0)
#else
#define PHASE_STAGGER(ticks) do { const unsigned long long t0_ = __builtin_amdgcn_s_memrealtime(), dl_ = (unsigned long long)((F.vcu & 31) * (ticks)); \
        while (__builtin_amdgcn_s_memrealtime() - t0_ < dl_) __builtin_amdgcn_s_sleep(8); } while (0)
#endif
#if !defined(EMU) && defined(PROBE_SEC)
    const unsigned long long pc0_ = __builtin_readcyclecounter(), pt0_ = __builtin_amdgcn_s_memrealtime();
#endif
    const int lo = args.ph_lo, hi = args.ph_hi;
#define IN(k) (lo <= (k) && (k) < hi)
#define BOTH(k) (IN(k) && IN((k) + 1))

    if (IN(0)) { p0_prologue(F);
#if PROBE_DUP & 32
        VM_WAIT(); __syncthreads(); p0_prologue(F);
#endif
        if (BOTH(0)) GRID_BAR(); }

    if (IN(1)) {
        pg8::Gemm g{F.XN(), F.WinT(), MALL, NPROJ, D}; pg8::StaticOrder S; S.init(MALL, NPROJ, F.G, (int)blockIdx.x); S.wid = F.wave;
        pg8::EpiProj E{F.Z(), F.XBC(), F.Q(), F.K(), F.V(), F.GS(), F.GA(), F.DT(), F.in[I_DTB], F.out};
        pg8::gemm_phase<pg8::EpiProj, pg8::StaticOrder, PG8_ALIGN, PG8_SP2>(F.lds + RING_OFF, g, S, E);
#if PROBE_DUP & 1
        VM_WAIT(); __syncthreads();
        pg8::gemm_phase<pg8::EpiProj, pg8::StaticOrder, PG8_ALIGN, PG8_SP2>(F.lds + RING_OFF, g, S, E);
#endif
        if (BOTH(1)) GRID_BAR();
    }

    if (IN(2)) {
        att_lambda_setup(F);
        { constexpr int NCP = SEQ / 128; const int cls = F.vcu & 3, sample_slot = cls == 0 ? -1 : (cls == 1 ? 0 : (cls == 2 ? (NCP * 11) / 16 : NCP));
          for (int sl = -1; sl <= NCP; ++sl) {
              if (sl == 0) {
                  for (int u = F.vcu; u < BATCH * NGRP; u += F.G) ssd_unit(F, 0, u / NGRP, u % NGRP);
                  for (int u = F.vcu; u < DECB * NGRP; u += F.G) ssd_unit(F, 1, u / NGRP, u % NGRP);
#if PROBE_DUP & 8
                  for (int u = F.vcu; u < BATCH * NGRP; u += F.G) ssd_unit(F, 0, u / NGRP, u % NGRP);
                  for (int u = F.vcu; u < DECB * NGRP; u += F.G) ssd_unit(F, 1, u / NGRP, u % NGRP);
#endif
              }
              if (sl == sample_slot) for (int u = F.vcu; u < DECB * NAH; u += F.G) { att_head_setup(F, u % NAH); att_unit<1>(F, u / NAH, u % NAH, 0); }
              if (sl >= 0 && sl < NCP) for (int u = F.vcu; u < BATCH * NAH; u += F.G) { if (sl == 0 || sl == sample_slot || BATCH * NAH > F.G) att_head_setup(F, u % NAH); att_unit<0>(F, u / NAH, u % NAH, sl); }
          } }
#if !defined(EMU) && defined(PROBE_SEC)
        if (F.wave == 0) { const unsigned long long t0_ = __builtin_amdgcn_s_memrealtime(), dl_ = (unsigned long long)F.tacc * PROBE_AMP; while (__builtin_amdgcn_s_memrealtime() - t0_ < dl_) __builtin_amdgcn_s_sleep(8); }
#endif
        __syncthreads();
        if (BOTH(2)) GRID_BAR();
    }

    if (IN(3)) {
        { pg8::Gemm g{F.U(), F.WssdT(), MMAIN, D, DIN}; pg8::StaticOrder S; S.init(MMAIN, D, F.G, (int)blockIdx.x); S.wid = F.wave;
          pg8::EpiGate<0> E{F.GS(), nullptr, F.TMP()};
          pg8::gemm_phase<pg8::EpiGate<0>, pg8::StaticOrder, PG8_ALIGN, PG8_SP2>(F.lds + RING_OFF, g, S, E); }
        VM_WAIT(); __syncthreads();
        { pg8::Gemm g{F.O(), F.WattT(), MMAIN, D, D}; pg8::StaticOrder S; S.init(MMAIN, D, F.G, (int)blockIdx.x); S.wid = F.wave;
          pg8::EpiGate<1> E{F.GA(), F.TMP(), F.MIX()};
          pg8::gemm_phase<pg8::EpiGate<1>, pg8::StaticOrder, PG8_ALIGN, PG8_SP2>(F.lds + RING_OFF, g, S, E); }
#if PROBE_DUP & 2
        VM_WAIT(); __syncthreads();
        { pg8::Gemm g{F.U(), F.WssdT(), MMAIN, D, DIN}; pg8::StaticOrder S; S.init(MMAIN, D, F.G, (int)blockIdx.x); S.wid = F.wave;
          pg8::EpiGate<0> E{F.GS(), nullptr, F.TMP()};
          pg8::gemm_phase<pg8::EpiGate<0>, pg8::StaticOrder, PG8_ALIGN, PG8_SP2>(F.lds + RING_OFF, g, S, E); }
        VM_WAIT(); __syncthreads();
        { pg8::Gemm g{F.O(), F.WattT(), MMAIN, D, D}; pg8::StaticOrder S; S.init(MMAIN, D, F.G, (int)blockIdx.x); S.wid = F.wave;
          pg8::EpiGate<1> E{F.GA(), F.TMP(), F.MIX()};
          pg8::gemm_phase<pg8::EpiGate<1>, pg8::StaticOrder, PG8_ALIGN, PG8_SP2>(F.lds + RING_OFF, g, S, E); }
#endif
        if (BOTH(3)) GRID_BAR();
    }

    if (IN(4)) {
        pg8::Gemm g{F.MIX(), F.WoT(), MMAIN, D, D}; pg8::StaticOrder S; S.init(MMAIN, D, F.G, (int)blockIdx.x); S.wid = F.wave;
        pg8::EpiT E{F.T1(), D};
        pg8::gemm_phase<pg8::EpiT, pg8::StaticOrder, PG8_ALIGN, PG8_SP2>(F.lds + RING_OFF, g, S, E);
#if PROBE_DUP & 2
        VM_WAIT(); __syncthreads();
        pg8::gemm_phase<pg8::EpiT, pg8::StaticOrder, PG8_ALIGN, PG8_SP2>(F.lds + RING_OFF, g, S, E);
#endif
        if (BOTH(4)) GRID_BAR();
    }
    if (IN(5)) { row_phase(F, 0);
#if PROBE_DUP & 64
        VM_WAIT(); __syncthreads(); row_phase(F, 0);
#endif
        if (BOTH(5)) GRID_BAR(); }

    if (IN(6)) {
        pg8::Gemm g{F.XN(), F.WffT(), MMAIN, 2 * DFF, D}; pg8::StaticOrder S; S.init(MMAIN, 2 * DFF, F.G, (int)blockIdx.x); S.wid = F.wave;
        pg8::EpiSwiglu E{F.HB()};
        pg8::gemm_phase<pg8::EpiSwiglu, pg8::StaticOrder, PG8_ALIGN, PG8_SP2>(F.lds + RING_OFF, g, S, E);
#if PROBE_DUP & 4
        VM_WAIT(); __syncthreads();
        pg8::gemm_phase<pg8::EpiSwiglu, pg8::StaticOrder, PG8_ALIGN, PG8_SP2>(F.lds + RING_OFF, g, S, E);
#endif
        if (BOTH(6)) GRID_BAR();
    }
    if (IN(7)) {
        pg8::Gemm g{F.HB(), F.Wff2T(), MMAIN, D, DFF}; pg8::StaticOrder S; S.init(MMAIN, D, F.G, (int)blockIdx.x); S.wid = F.wave;
        pg8::EpiT E{F.T2(), D};
        pg8::gemm_phase<pg8::EpiT, pg8::StaticOrder, PG8_ALIGN, PG8_SP2>(F.lds + RING_OFF, g, S, E);
#if PROBE_DUP & 4
        VM_WAIT(); __syncthreads();
        pg8::gemm_phase<pg8::EpiT, pg8::StaticOrder, PG8_ALIGN, PG8_SP2>(F.lds + RING_OFF, g, S, E);
#endif
        if (BOTH(7)) GRID_BAR();
    }
#if !defined(EMU) && defined(PROBE_SEC)
    if (PROBE_SEC == 9 && F.wave == 0) {
        const unsigned long long pc1_ = __builtin_readcyclecounter(), pt1_ = __builtin_amdgcn_s_memrealtime();
        const unsigned long long dl_ = (pc1_ - pc0_) * 1000ull * PROBE_AMP / (pt1_ - pt0_ + 1ull), t0_ = __builtin_amdgcn_s_memrealtime();
        while (__builtin_amdgcn_s_memrealtime() - t0_ < dl_) __builtin_amdgcn_s_sleep(8); }
    __syncthreads();
#endif
    if (IN(8)) { row_phase(F, 1); }
#undef IN
#undef BOTH
}

extern "C" void kernel_launch(void* const* d_in, const int* in_sizes, int n_in, void* d_out, int out_size, void* d_ws, size_t ws_size, hipStream_t stream) {
    if (n_in != 29 || (size_t)out_size != OUT_END || ws_size < WS_END) { fprintf(stderr, "kernel_launch: shape mismatch: n_in %d out %d (want %zu) ws %zu (want %zu)\n", n_in, out_size, (size_t)OUT_END, ws_size, (size_t)WS_END); return; }
    Args a{};
    for (int i = 0; i < 29; ++i) a.in[i] = (const float*)d_in[i];
    a.out = (float*)d_out; a.ws = (unsigned char*)d_ws;
#ifdef EMU
    memset((char*)d_ws + WS_CTL, 0, CTL_ZERO_BYTES);
    const int first = getenv("EMU_PH_LO") ? atoi(getenv("EMU_PH_LO")) : 0, last = getenv("EMU_PH_HI") ? atoi(getenv("EMU_PH_HI")) : NPHASE;
    const int grid = getenv("EMU_GRID") ? atoi(getenv("EMU_GRID")) : 8;
    for (int ph = first; ph < last; ++ph) { a.ph_lo = ph; a.ph_hi = ph + 1; a.li = 0; fprintf(stderr, "[emu] phase %d\n", ph); emu::launch(grid, NWAVES * 64, LDS_BYTES, [=] { skel_fwd(a); }); }
#else
    static int grid = 0;
    if (grid == 0) {
        int dev = 0, cus = 0, per_cu = 0;
        if (hipGetDevice(&dev) != hipSuccess || hipDeviceGetAttribute(&cus, hipDeviceAttributeMultiprocessorCount, dev) != hipSuccess) { fprintf(stderr, "kernel_launch: device query failed\n"); grid = -1; return; }
        if (hipFuncSetAttribute((const void*)skel_fwd, hipFuncAttributeMaxDynamicSharedMemorySize, LDS_BYTES) != hipSuccess) { fprintf(stderr, "kernel_launch: hipFuncSetAttribute failed\n"); grid = -1; return; }
        if (hipOccupancyMaxActiveBlocksPerMultiprocessor(&per_cu, (const void*)skel_fwd, NWAVES * 64, LDS_BYTES) != hipSuccess || per_cu < 1) { fprintf(stderr, "kernel_launch: occupancy query says %d blocks per CU\n", per_cu); (void)hipGetLastError(); per_cu = 1; }
        grid = cus;
    }
    if (grid < 0) return;
    if (hipMemsetAsync((char*)d_ws + WS_CTL, 0, CTL_ZERO_BYTES, stream) != hipSuccess) { fprintf(stderr, "kernel_launch: memset failed\n"); return; }
    constexpr int NL = MK_N_LAUNCHES;
    for (int li = 0; li < NL; ++li) {
        a.ph_lo = NL == 1 ? 0 : li; a.ph_hi = NL == 1 ? NPHASE : li + 1; a.li = li;
        hipLaunchKernelGGL(skel_fwd, dim3(grid), dim3(NWAVES * 64), LDS_BYTES, stream, a);
        const hipError_t le = hipPeekAtLastError();
        if (le != hipSuccess) { fprintf(stderr, "kernel_launch: launch %d failed: %s\n", li, hipGetErrorName(le)); break; }
    }
#endif
}
```
